# Optimizing an MI355X kernel written in HIP

```python
import math
import jax, jax.numpy as jnp
from jax import lax
import numpy as np

D_MODEL = 2048
BATCH = 4
SEQ = 2048
DEPTH = 4

N_MIXERS = 3
HEAD_DIM = 128
N_HEADS = D_MODEL // HEAD_DIM
ATTN_WIDTH = N_HEADS * HEAD_DIM
BLOCK_Q = 128
D_FF = 4 * D_MODEL
MLA_Q_RANK = 3 * D_MODEL // 8
MLA_KV_RANK = D_MODEL // 4
MLA_NOPE = 128
MLA_ROPE = 64
MLA_V = 128
MLA_QK = MLA_NOPE + MLA_ROPE
ROPE_THETA = 10000.0
EPS = 1e-6
N_SB = (DEPTH + 2) // 3
N_FOX = (DEPTH + 1) // 3
N_MLA = DEPTH // 3

kernel_name = "interleaved_sb_fox_mla_trunk"


def rmsnorm(x, g):
    xf = x.astype(jnp.float32)
    y = xf * lax.rsqrt(jnp.mean(xf * xf, axis=-1, keepdims=True) + EPS)
    return (y * g.astype(jnp.float32)).astype(x.dtype)


def sweep_query_blocks(block_fn, seq_len):
    outs = [block_fn(qs, qs + BLOCK_Q) for qs in range(0, seq_len, BLOCK_Q)]
    return jnp.concatenate(outs, axis=2)


def split_heads_qkv(qkv, b, s):
    t = qkv.reshape(b, s, 3, N_HEADS, HEAD_DIM).transpose(2, 0, 3, 1, 4)
    return t[0], t[1], t[2]


def merge_heads(o):
    b, h, s, d = o.shape
    return o.transpose(0, 2, 1, 3).reshape(b, s, h * d)


def stick_breaking_block(q_blk, k_pre, v_pre, q_start):
    n_q, n_k = q_blk.shape[2], k_pre.shape[2]
    z = jnp.einsum('bhtd,bhsd->bhts', q_blk, k_pre).astype(jnp.float32) * (1.0 / math.sqrt(HEAD_DIM))
    strict = jnp.arange(n_k)[None, :] < (q_start + jnp.arange(n_q))[:, None]
    log_keep = jnp.where(strict, jax.nn.log_sigmoid(-z), 0.0)
    later = lax.cumsum(log_keep, axis=3, reverse=True) - log_keep
    a = jnp.where(strict, jnp.exp(jax.nn.log_sigmoid(z) + later), 0.0)
    return jnp.einsum('bhts,bhsd->bhtd', a.astype(v_pre.dtype), v_pre)


def causal_softmax_block(q_blk, k_pre, v_pre, q_start, scale, bias=None):
    n_q, n_k = q_blk.shape[2], k_pre.shape[2]
    logits = jnp.einsum('bhtd,bhsd->bhts', q_blk, k_pre).astype(jnp.float32) * scale
    if bias is not None:
        logits = logits + bias
    causal = jnp.arange(n_k)[None, :] <= (q_start + jnp.arange(n_q))[:, None]
    p = jax.nn.softmax(jnp.where(causal, logits, -jnp.inf), axis=-1)
    return jnp.einsum('bhts,bhsd->bhtd', p.astype(v_pre.dtype), v_pre)


def stick_breaking_mixer(h, w_in, w_out):
    b, s, _ = h.shape
    q, k, v = split_heads_qkv(h @ w_in, b, s)
    o = sweep_query_blocks(
        lambda qs, qe: stick_breaking_block(q[:, :, qs:qe], k[:, :, :qe], v[:, :, :qe], qs), s)
    return merge_heads(o) @ w_out


def forgetting_mixer(h, w_in, b_f, q_gain, k_gain, w_out):
    b, s, _ = h.shape
    proj = h @ w_in
    q, k, v = split_heads_qkv(proj[..., :3 * ATTN_WIDTH], b, s)
    log_f = jax.nn.log_sigmoid((proj[..., 3 * ATTN_WIDTH:] + b_f).astype(jnp.float32))
    cf = jnp.cumsum(log_f, axis=1).transpose(0, 2, 1)
    q = rmsnorm(q, q_gain)
    k = rmsnorm(k, k_gain)
    scale = 1.0 / math.sqrt(HEAD_DIM)

    def blk(qs, qe):
        bias = cf[:, :, qs:qe, None] - cf[:, :, None, :qe]
        return causal_softmax_block(q[:, :, qs:qe], k[:, :, :qe], v[:, :, :qe], qs, scale, bias)

    return merge_heads(sweep_query_blocks(blk, s)) @ w_out


def rope(x, positions):
    half = x.shape[-1] // 2
    inv_freq = ROPE_THETA ** (-jnp.arange(0, half, dtype=jnp.float32) * 2.0 / x.shape[-1])
    ang = positions.astype(jnp.float32)[..., None] * inv_freq
    if x.ndim == 4:
        ang = ang[:, :, None, :]
    cos, sin = jnp.cos(ang), jnp.sin(ang)
    xf = x.astype(jnp.float32)
    x1, x2 = xf[..., :half], xf[..., half:]
    return jnp.concatenate([x1 * cos - x2 * sin, x1 * sin + x2 * cos], axis=-1).astype(x.dtype)


def mla_mixer(h, positions, w_in, q_norm, kv_norm, w_uq, w_ukv, q_gain, k_gain, w_out):
    b, s, _ = h.shape
    down = h @ w_in
    c_q = rmsnorm(down[..., :MLA_Q_RANK], q_norm)
    c_kv = rmsnorm(down[..., MLA_Q_RANK:MLA_Q_RANK + MLA_KV_RANK], kv_norm)
    k_rope = rope(down[..., MLA_Q_RANK + MLA_KV_RANK:], positions)
    q = (c_q @ w_uq).reshape(b, s, N_HEADS, MLA_QK)
    q = jnp.concatenate([q[..., :MLA_NOPE], rope(q[..., MLA_NOPE:], positions)], axis=-1)
    kv = (c_kv @ w_ukv).reshape(b, s, N_HEADS, MLA_NOPE + MLA_V)
    k = jnp.concatenate(
        [kv[..., :MLA_NOPE], jnp.broadcast_to(k_rope[:, :, None, :], (b, s, N_HEADS, MLA_ROPE))], axis=-1)
    v = kv[..., MLA_NOPE:].transpose(0, 2, 1, 3)
    q = rmsnorm(q, q_gain).transpose(0, 2, 1, 3)
    k = rmsnorm(k, k_gain).transpose(0, 2, 1, 3)
    scale = 1.0 / math.sqrt(MLA_QK)
    o = sweep_query_blocks(
        lambda qs, qe: causal_softmax_block(q[:, :, qs:qe], k[:, :, :qe], v[:, :, :qe], qs, scale), s)
    return merge_heads(o) @ w_out


def sq_relu_mlp(h, w1, w2):
    a = jax.nn.relu(h @ w1)
    return (a * a) @ w2


def setup_inputs(seed: int = 0) -> dict:
    key = jax.random.key(seed)
    ks = jax.random.split(key, 24)
    f32 = jnp.float32

    def nrm(k, shape, fan_in):
        return jax.random.normal(k, shape, f32) * (fan_in ** -0.5)

    def gain(k, shape):
        return 1.0 + 0.02 * jax.random.normal(k, shape, f32)

    return {
        "x": jax.random.normal(ks[0], (BATCH, SEQ, D_MODEL), f32),
        "positions": jnp.broadcast_to(jnp.arange(SEQ, dtype=jnp.int32)[None, :], (BATCH, SEQ)),
        "mix_norm": gain(ks[1], (DEPTH, D_MODEL)),
        "mlp_norm": gain(ks[2], (DEPTH, D_MODEL)),
        "sb_w_in": nrm(ks[3], (N_SB, D_MODEL, 3 * ATTN_WIDTH), D_MODEL),
        "sb_w_out": nrm(ks[4], (N_SB, ATTN_WIDTH, D_MODEL), ATTN_WIDTH),
        "fox_w_in": nrm(ks[5], (N_FOX, D_MODEL, 3 * ATTN_WIDTH + N_HEADS), D_MODEL),
        "fox_b_f": jax.random.uniform(ks[6], (N_FOX, N_HEADS), f32, 1.0, 5.0),
        "fox_q_gain": gain(ks[7], (N_FOX, HEAD_DIM)),
        "fox_k_gain": gain(ks[8], (N_FOX, HEAD_DIM)),
        "fox_w_out": nrm(ks[9], (N_FOX, ATTN_WIDTH, D_MODEL), ATTN_WIDTH),
        "mla_w_in": nrm(ks[10], (N_MLA, D_MODEL, MLA_Q_RANK + MLA_KV_RANK + MLA_ROPE), D_MODEL),
        "mla_q_norm": gain(ks[11], (N_MLA, MLA_Q_RANK)),
        "mla_kv_norm": gain(ks[12], (N_MLA, MLA_KV_RANK)),
        "mla_w_uq": nrm(ks[13], (N_MLA, MLA_Q_RANK, N_HEADS * MLA_QK), MLA_Q_RANK),
        "mla_w_ukv": nrm(ks[14], (N_MLA, MLA_KV_RANK, N_HEADS * (MLA_NOPE + MLA_V)), MLA_KV_RANK),
        "mla_q_gain": gain(ks[15], (N_MLA, MLA_QK)),
        "mla_k_gain": gain(ks[16], (N_MLA, MLA_QK)),
        "mla_w_out": nrm(ks[17], (N_MLA, N_HEADS * MLA_V, D_MODEL), N_HEADS * MLA_V),
        "mlp_w1": nrm(ks[18], (DEPTH, D_MODEL, D_FF), D_MODEL),
        "mlp_w2": nrm(ks[19], (DEPTH, D_FF, D_MODEL), D_FF),
    }


def reference(x, positions, mix_norm, mlp_norm, sb_w_in, sb_w_out, fox_w_in, fox_b_f, fox_q_gain,
              fox_k_gain, fox_w_out, mla_w_in, mla_q_norm, mla_kv_norm, mla_w_uq, mla_w_ukv,
              mla_q_gain, mla_k_gain, mla_w_out, mlp_w1, mlp_w2):
    for i in range(DEPTH):
        kind, j = i % N_MIXERS, i // N_MIXERS
        h = rmsnorm(x, mix_norm[i])
        if kind == 0:
            y = stick_breaking_mixer(h, sb_w_in[j], sb_w_out[j])
        elif kind == 1:
            y = forgetting_mixer(h, fox_w_in[j], fox_b_f[j], fox_q_gain[j], fox_k_gain[j], fox_w_out[j])
        else:
            y = mla_mixer(h, positions, mla_w_in[j], mla_q_norm[j], mla_kv_norm[j], mla_w_uq[j],
                          mla_w_ukv[j], mla_q_gain[j], mla_k_gain[j], mla_w_out[j])
        x = x + y
        x = x + sq_relu_mlp(rmsnorm(x, mlp_norm[i]), mlp_w1[i], mlp_w2[i])
    return x
```

```cpp
#include <hip/hip_runtime.h>
#include <hip/hip_cooperative_groups.h>
#include <cstdio>
#include <cstdint>
namespace cg = cooperative_groups;

#ifndef COOP
#define COOP 1
#endif
#ifndef ONLY
#define ONLY -1
#endif
#ifndef ATT_DMA
#define ATT_DMA 1
#endif
#define TESTMODE2 0

#ifndef SKIP
#define SKIP -5
#endif
#define EN(x) ((ONLY < 0 || ONLY == (x)) && (x) != SKIP)

#define LAS __attribute__((address_space(3)))
typedef unsigned short bf16_t;
typedef short bf16x8 __attribute__((ext_vector_type(8)));
typedef short s16x4 __attribute__((ext_vector_type(4)));
typedef float f32x4 __attribute__((ext_vector_type(4)));
typedef float f32x16 __attribute__((ext_vector_type(16)));
typedef unsigned u32x4 __attribute__((ext_vector_type(4)));
typedef unsigned u32x2 __attribute__((ext_vector_type(2)));

constexpr int DM = 2048, NTOK = 8192, SEQ = 2048, NH = 16, HD = 128, DFF = 8192, DEPTH = 4;
constexpr int MLA_QR = 768, MLA_KVR = 512, MLA_ROPE = 64, MLA_QK = 192, MLA_DOWN = 1344, MLA_DOWN_PAD = 1536;
constexpr float EPS = 1e-6f;
constexpr float LOG2E = 1.4426950408889634f;

constexpr size_t SZ_QKVW = (size_t)6144 * 2048 * 2, SZ_SQW = (size_t)2048 * 2048 * 2, SZ_FFW = (size_t)8192 * 2048 * 2;
constexpr size_t W_SB_IN = 0;
constexpr size_t W_SB_OUT = W_SB_IN + 2 * SZ_QKVW;
constexpr size_t W_FOX_IN = W_SB_OUT + 2 * SZ_SQW;
constexpr size_t W_FOX_F = W_FOX_IN + SZ_QKVW;
constexpr size_t W_FOX_OUT = W_FOX_F + (size_t)128 * 2048 * 2;
constexpr size_t W_MLA_IN = W_FOX_OUT + SZ_SQW;
constexpr size_t W_MLA_UQ = W_MLA_IN + (size_t)1536 * 2048 * 2;
constexpr size_t W_MLA_UKV = W_MLA_UQ + (size_t)3072 * 768 * 2;
constexpr size_t W_MLA_OUT = W_MLA_UKV + (size_t)4096 * 512 * 2;
constexpr size_t W_W1 = W_MLA_OUT + SZ_SQW;
constexpr size_t W_W2 = W_W1 + 4 * SZ_FFW;
constexpr size_t WS_X = W_W2 + 4 * SZ_FFW;
constexpr size_t WS_H = WS_X + (size_t)NTOK * DM * 4;
constexpr size_t WS_AO = WS_H + (size_t)NTOK * DM * 2;
constexpr size_t WS_LOGF = WS_AO + (size_t)NTOK * DM * 2;
constexpr size_t WS_CF = WS_LOGF + (size_t)NTOK * 16 * 4;
constexpr size_t WS_ROPE = WS_CF + (size_t)64 * 2048 * 4;
constexpr size_t WS_KR = WS_ROPE + (size_t)NTOK * 64 * 4;
constexpr size_t WS_SCR = WS_KR + (size_t)NTOK * 64 * 4;
constexpr size_t SC_Q = 0, SC_K = (size_t)NTOK * DM * 2, SC_V = 2 * (size_t)NTOK * DM * 2;
constexpr size_t SC_DOWN = 0;
constexpr size_t SC_CQ = SC_DOWN + (size_t)NTOK * MLA_DOWN_PAD * 2;
constexpr size_t SC_CKV = SC_CQ + (size_t)NTOK * MLA_QR * 2;
constexpr size_t SC_QUP = SC_CKV + (size_t)NTOK * MLA_KVR * 2;
constexpr size_t SC_KV = SC_QUP + (size_t)NTOK * 3072 * 2;
constexpr size_t SC_QN = SC_KV + (size_t)NTOK * 4096 * 2;
constexpr size_t SC_KN = SC_QN + (size_t)NTOK * 3072 * 2;
constexpr size_t SC_END = SC_KN + (size_t)NTOK * 3072 * 2;
constexpr size_t WS_BAR = WS_SCR + SC_END;
constexpr size_t WS_END = WS_BAR + 16384;

constexpr int LDS_BYTES = 131072 + 16;

struct Params {
    const float* x; const int* pos; const float* mix_norm; const float* mlp_norm;
    const float* sb_w_in; const float* sb_w_out; const float* fox_w_in; const float* fox_b_f; const float* fox_q_gain; const float* fox_k_gain; const float* fox_w_out;
    const float* mla_w_in; const float* mla_q_norm; const float* mla_kv_norm; const float* mla_w_uq; const float* mla_w_ukv; const float* mla_q_gain; const float* mla_k_gain; const float* mla_w_out;
    const float* mlp_w1; const float* mlp_w2;
    float* out; unsigned char* ws;
    long long ph_lo, ph_hi, alt;
};

__device__ __forceinline__ unsigned cvtpk(float lo, float hi) { unsigned r; asm volatile("v_cvt_pk_bf16_f32 %0, %1, %2" : "=v"(r) : "v"(lo), "v"(hi)); return r; }
__device__ __forceinline__ float bflo(unsigned w) { return __uint_as_float(w << 16); }
__device__ __forceinline__ float bfhi(unsigned w) { return __uint_as_float(w & 0xffff0000u); }
__device__ __forceinline__ int opq(int x) { asm volatile("" : "+v"(x)); return x; }
__device__ __forceinline__ float wave_sum(float v) {
#pragma unroll
    for (int o = 32; o > 0; o >>= 1) v += __shfl_xor(v, o);
    return v;
}
__device__ __forceinline__ float sum16(float v) {
#pragma unroll
    for (int o = 8; o > 0; o >>= 1) v += __shfl_xor(v, o);
    return v;
}

namespace pg8 {
constexpr int BM = 256, BK = 64, HALF = 128, HTB = HALF * BK * 2, STAGE_BYTES = 8 * HTB, NXCD = 8, WGM = 8;
__host__ __device__ __forceinline__ int lds_byte(int r, int c) { const int st = (r >> 4) * 2 + (c >> 5), rr = r & 15, cc = c & 31, ob = rr * 64 + cc * 2; return st * 1024 + (ob ^ (((ob >> 9) & 1) << 5)); }
__host__ __device__ __forceinline__ void stage_rc(int b, int& R, int& C) { const int st = b / 1024, sb = b % 1024, swz = sb ^ (((sb >> 9) & 1) << 5); R = (st >> 1) * 16 + swz / 64; C = (st & 1) * 32 + (swz % 64) / 2; }
__host__ __device__ __forceinline__ int perm32(int rho) { const int n = rho >> 4, i = rho & 15; return 8 * (i >> 2) + 4 * n + (i & 3); }
struct Unit { int pm, pn; };
struct Gemm { const bf16_t* A; const bf16_t* Bt; int M, N, K; };
struct StaticOrder {
    int nM, nN, nwg, G, c;
    __device__ void init(int M, int N, int G_, int c_) { nM = M / BM; nN = N / BM; nwg = nM * nN; G = G_; c = c_; }
    __device__ bool next(int i, Unit& u) const {
        const long L = (long)i * G + c; if (L >= nwg) return false;
        int wgid = (int)L; { const int q = nwg / NXCD, r = nwg % NXCD, xcd = wgid % NXCD, off = wgid / NXCD; wgid = (xcd < r ? xcd * (q + 1) : r * (q + 1) + (xcd - r) * q) + off; }
        const int nig = WGM * nN, gid = wgid / nig, fm = gid * WGM, gsz = (nM - fm) < WGM ? (nM - fm) : WGM;
        u.pm = fm + ((wgid % nig) % gsz); u.pn = (wgid % nig) / gsz; return true;
    }
};
struct EpiGen {
    int mode; bf16_t* O; int ldc; int split_cols; size_t split_stride; const float* R; float* C;
    __device__ __forceinline__ void operator()(const f32x4 (&acc)[2][2][4][2], const Unit& u, int wr, int wc, int fr, int fq) const {
        const int row0 = u.pm * BM + wr * 64 + fr;
        if (mode == 2) {
            const int col0 = u.pn * BM + wc * 32 + 4 * fq;
#pragma unroll
            for (int ai = 0; ai < 2; ++ai) {
                f32x4 rv[4][2][2];
#pragma unroll
                for (int m = 0; m < 4; ++m) { const size_t ro = (size_t)(row0 + ai * HALF + m * 16) * ldc + col0;
#pragma unroll
                    for (int bj = 0; bj < 2; ++bj)
#pragma unroll
                        for (int n = 0; n < 2; ++n) rv[m][bj][n] = *(const f32x4*)(R + ro + bj * HALF + n * 16); }
#pragma unroll
                for (int m = 0; m < 4; ++m) { const size_t ro = (size_t)(row0 + ai * HALF + m * 16) * ldc + col0;
#pragma unroll
                    for (int bj = 0; bj < 2; ++bj)
#pragma unroll
                        for (int n = 0; n < 2; ++n) *(f32x4*)(C + ro + bj * HALF + n * 16) = acc[ai][bj][m][n] + rv[m][bj][n]; }
            }
        } else {
            int colt = u.pn * BM; bf16_t* base = O;
            if (split_cols) { const int t = colt / split_cols; base += (size_t)t * split_stride; colt -= t * split_cols; }
            const int col0 = colt + wc * 32 + 8 * fq; const bool act = mode == 1;
#pragma unroll
            for (int ai = 0; ai < 2; ++ai)
#pragma unroll
                for (int m = 0; m < 4; ++m) { bf16_t* rowp = base + (size_t)(row0 + ai * HALF + m * 16) * ldc + col0;
#pragma unroll
                    for (int bj = 0; bj < 2; ++bj) { f32x4 v0 = acc[ai][bj][m][0], v1 = acc[ai][bj][m][1];
                        if (act) {
#pragma unroll
                            for (int j = 0; j < 4; ++j) { float x = fmaxf(v0[j], 0.f), y = fmaxf(v1[j], 0.f); v0[j] = x * x; v1[j] = y * y; } }
                        u32x4 w; w.x = cvtpk(v0[0], v0[1]); w.y = cvtpk(v0[2], v0[3]); w.z = cvtpk(v1[0], v1[1]); w.w = cvtpk(v1[2], v1[3]);
                        *(u32x4*)(rowp + bj * HALF) = w; } }
        }
    }
};

template <class Epi, class Sched>
__device__ __forceinline__ void gemm_phase(LAS unsigned char* lds, const Gemm g, const Sched& S, const Epi& E) {
    const int tid = opq(threadIdx.x), wid = __builtin_amdgcn_readfirstlane(tid >> 6), lane = tid & 63, wr = wid >> 2, wc = wid & 3, fr = lane & 15, fq = lane >> 4;
    const int K = g.K, nt = K / BK;
    unsigned voffA[2], voffB[2];
#pragma unroll
    for (int i = 0; i < 2; ++i) { int R, C; stage_rc(tid * 16 + i * 8192, R, C); const int Rb = (E.mode != 2) ? ((R & ~31) + perm32(R & 31)) : R;
        voffA[i] = (unsigned)(R * K + C) * 2u; voffB[i] = (unsigned)(Rb * K + C) * 2u; }
    const size_t kstep = (size_t)(BK * 2);
    const size_t hstep = (size_t)HALF * K * 2;
    const size_t tstep = 2 * hstep;
    const unsigned ldsw = (unsigned)wid * 1024u;
    const int aoff = lds_byte(wr * 64 + fr, fq * 8), boff = lds_byte(wc * 32 + fr, fq * 8);
#define PG8_SA(b, h) (((b) * 2 + (h)) * HTB)
#define PG8_SB(b, h) ((4 + (b) * 2 + (h)) * HTB)
#define PG8_STAGE(bufoff, gbase, voff) do { _Pragma("unroll") for (int _i = 0; _i < 2; ++_i) \
        __builtin_amdgcn_global_load_lds((const unsigned*)((const char*)(gbase) + (voff)[_i]), (LAS unsigned*)(lds + (bufoff) + ldsw + _i * 8192), 16, 0, 0); } while (0)
#define PG8_LDA(dst, b, h) do { _Pragma("unroll") for (int m = 0; m < 4; ++m) _Pragma("unroll") for (int k = 0; k < 2; ++k) dst[m][k] = *(const LAS bf16x8*)(lds + PG8_SA(b, h) + aoff + m * 2048 + k * 1024); } while (0)
#define PG8_LDB(dst, b, h) do { _Pragma("unroll") for (int n = 0; n < 2; ++n) _Pragma("unroll") for (int k = 0; k < 2; ++k) dst[n][k] = *(const LAS bf16x8*)(lds + PG8_SB(b, h) + boff + n * 2048 + k * 1024); } while (0)
#define PG8_MMA(ai, bj, At, Bt) do { __builtin_amdgcn_s_setprio(1); _Pragma("unroll") for (int m = 0; m < 4; ++m) _Pragma("unroll") for (int n = 0; n < 2; ++n) _Pragma("unroll") for (int k = 0; k < 2; ++k) \
        acc[ai][bj][m][n] = __builtin_amdgcn_mfma_f32_16x16x32_bf16(Bt[n][k], At[m][k], acc[ai][bj][m][n], 0, 0, 0); __builtin_amdgcn_s_setprio(0); } while (0)
#define PG8_WAIT_V(n) asm volatile("s_waitcnt vmcnt(" #n ")" ::: "memory")
#define PG8_WAIT_L(n) asm volatile("s_waitcnt lgkmcnt(" #n ")" ::: "memory")
#define PG8_BAR __builtin_amdgcn_s_barrier()
#define PG8_SCHED __builtin_amdgcn_sched_barrier(0)
    Unit cur, nxt; int ui = 0;
    if (!S.next(0, cur)) return;
    f32x4 acc[2][2][4][2];
#pragma unroll
    for (int a = 0; a < 2; ++a)
#pragma unroll
        for (int b = 0; b < 2; ++b)
#pragma unroll
            for (int m = 0; m < 4; ++m)
#pragma unroll
                for (int n = 0; n < 2; ++n) acc[a][b][m][n] = (f32x4){0.f, 0.f, 0.f, 0.f};
    bf16x8 At[4][2], B0[2][2], B1[2][2];
    const char* cA = (const char*)g.A + (size_t)cur.pm * tstep; const char* cB = (const char*)g.Bt + (size_t)cur.pn * tstep;
    PG8_STAGE(PG8_SB(0, 0), cB, voffB); PG8_STAGE(PG8_SA(0, 0), cA, voffA); PG8_STAGE(PG8_SB(0, 1), cB + hstep, voffB); PG8_STAGE(PG8_SA(0, 1), cA + hstep, voffA);
    if (wr == 1) PG8_BAR;
    PG8_WAIT_V(4); PG8_BAR;
    PG8_STAGE(PG8_SB(1, 0), cB + kstep, voffB); PG8_STAGE(PG8_SA(1, 0), cA + kstep, voffA); PG8_STAGE(PG8_SB(1, 1), cB + hstep + kstep, voffB);
    PG8_WAIT_V(6); PG8_BAR;
    for (;;) {
        const bool has_next = S.next(ui + 1, nxt);
        const char* nA = has_next ? (const char*)g.A + (size_t)nxt.pm * tstep : cA; const char* nB = has_next ? (const char*)g.Bt + (size_t)nxt.pn * tstep : cB;
        for (int t = 0; t < nt; t += 2) {
            const bool last = (t == nt - 2);
            const char* a1 = cA + (size_t)(t + 1) * kstep;
            const char* a2 = last ? nA : cA + (size_t)(t + 2) * kstep; const char* b2 = last ? nB : cB + (size_t)(t + 2) * kstep;
            const char* a3 = a2 + kstep; const char* b3 = b2 + kstep;
            PG8_LDB(B0, 0, 0); PG8_SCHED; PG8_LDA(At, 0, 0); PG8_STAGE(PG8_SA(1, 1), a1 + hstep, voffA);
            PG8_WAIT_L(8); PG8_BAR; PG8_WAIT_L(0); PG8_MMA(0, 0, At, B0); PG8_BAR; PG8_SCHED;
            PG8_LDB(B1, 0, 1); PG8_STAGE(PG8_SB(0, 0), b2, voffB);
            PG8_BAR; PG8_WAIT_L(0); PG8_MMA(0, 1, At, B1); PG8_BAR;
            PG8_LDA(At, 0, 1); PG8_STAGE(PG8_SA(0, 0), a2, voffA);
            PG8_BAR; PG8_WAIT_L(0); PG8_MMA(1, 0, At, B0); PG8_BAR; PG8_SCHED;
            PG8_STAGE(PG8_SB(0, 1), b2 + hstep, voffB);
            PG8_WAIT_V(6); PG8_BAR; PG8_MMA(1, 1, At, B1); PG8_BAR;
            PG8_LDB(B0, 1, 0); PG8_SCHED; PG8_LDA(At, 1, 0); PG8_STAGE(PG8_SA(0, 1), a2 + hstep, voffA);
            PG8_WAIT_L(8); PG8_BAR; PG8_WAIT_L(0); PG8_MMA(0, 0, At, B0); PG8_BAR; PG8_SCHED;
            PG8_LDB(B1, 1, 1); PG8_STAGE(PG8_SB(1, 0), b3, voffB);
            PG8_BAR; PG8_WAIT_L(0); PG8_MMA(0, 1, At, B1); PG8_BAR;
            PG8_LDA(At, 1, 1); PG8_STAGE(PG8_SA(1, 0), a3, voffA);
            PG8_BAR; PG8_WAIT_L(0); PG8_MMA(1, 0, At, B0); PG8_BAR; PG8_SCHED;
            PG8_STAGE(PG8_SB(1, 1), b3 + hstep, voffB);
            PG8_WAIT_V(6); PG8_BAR; PG8_MMA(1, 1, At, B1); PG8_BAR;
        }
        E(acc, cur, wr, wc, fr, fq);
        if (!has_next) break;
#pragma unroll
        for (int a = 0; a < 2; ++a)
#pragma unroll
            for (int b = 0; b < 2; ++b)
#pragma unroll
                for (int m = 0; m < 4; ++m)
#pragma unroll
                    for (int n = 0; n < 2; ++n) acc[a][b][m][n] = (f32x4){0.f, 0.f, 0.f, 0.f};
        cur = nxt; cA = nA; cB = nB; ++ui;
    }
    PG8_WAIT_V(0);
    if (wr == 0) PG8_BAR;
    PG8_BAR;
#undef PG8_SA
#undef PG8_SB
#undef PG8_STAGE
#undef PG8_LDA
#undef PG8_LDB
#undef PG8_MMA
#undef PG8_WAIT_V
#undef PG8_WAIT_L
#undef PG8_BAR
#undef PG8_SCHED
}
}

struct GemmJob { const bf16_t* A; const bf16_t* Bt; int M, N, K; pg8::EpiGen E; };
__device__ __forceinline__ void run_gemm(LAS unsigned char* lds, const GemmJob& j) {
    pg8::Gemm g{j.A, j.Bt, j.M, j.N, j.K};
    pg8::StaticOrder S; S.init(j.M, j.N, (int)gridDim.x, (int)blockIdx.x);
    pg8::gemm_phase<pg8::EpiGen, pg8::StaticOrder>(lds, g, S, j.E);
    __syncthreads();
}

__device__ __forceinline__ void conv_job(LAS unsigned char* lds, const float* __restrict__ src, int ldn, int col0, int ncols, int npad, int K, bf16_t* __restrict__ dst) {
    constexpr int LR = 132;
    LAS float* T = (LAS float*)lds;
    const int tid = opq(threadIdx.x), n4 = tid & 31, kr = tid >> 5;
    const int rn = tid & 127, rk = tid >> 7;
    const int ntn = npad / 128, ntk = K / 128, ntiles = ntn * ntk;
    f32x4 r[8];
    int t = blockIdx.x;
#define CONV_LOAD(tt_) do { const int tn_ = (tt_) % ntn, tk_ = (tt_) / ntn; const int n_ = tn_ * 128 + n4 * 4; const bool ok_ = n_ < ncols; \
        const float* p_ = src + (size_t)(tk_ * 128 + kr) * ldn + col0 + (ok_ ? n_ : 0); \
        _Pragma("unroll") for (int j_ = 0; j_ < 8; ++j_) { r[j_] = *(const f32x4*)(p_ + (size_t)(16 * j_) * ldn); if (!ok_) r[j_] = (f32x4){0.f, 0.f, 0.f, 0.f}; } } while (0)
    if (t < ntiles) CONV_LOAD(t);
    for (; t < ntiles; t += gridDim.x) {
        const int tn = t % ntn, tk = t / ntn;
#pragma unroll
        for (int j = 0; j < 8; ++j) *(LAS f32x4*)(T + (kr + 16 * j) * LR + n4 * 4) = r[j];
        if (t + (int)gridDim.x < ntiles) CONV_LOAD(t + (int)gridDim.x);
        __syncthreads();
#pragma unroll
        for (int j = 0; j < 4; ++j) { const int kc = rk + 4 * j; float v[8];
#pragma unroll
            for (int i = 0; i < 8; ++i) v[i] = T[(kc * 8 + i) * LR + rn];
            u32x4 w; w.x = cvtpk(v[0], v[1]); w.y = cvtpk(v[2], v[3]); w.z = cvtpk(v[4], v[5]); w.w = cvtpk(v[6], v[7]);
            *(u32x4*)(dst + (size_t)(tn * 128 + rn) * K + tk * 128 + kc * 8) = w; }
        __syncthreads();
    }
}

__device__ __forceinline__ void rmsnorm_phase(const float* __restrict__ x, const float* __restrict__ g, bf16_t* __restrict__ h) {
    const int tid = opq(threadIdx.x), lane = tid & 63, gw = blockIdx.x * 8 + (tid >> 6), nw = gridDim.x * 8;
    for (int row = gw; row < NTOK; row += nw) {
        const float* xr = x + (size_t)row * DM; f32x4 v[8]; float ss = 0.f;
#pragma unroll
        for (int j = 0; j < 8; ++j) { v[j] = *(const f32x4*)(xr + j * 256 + lane * 4); ss += v[j][0] * v[j][0] + v[j][1] * v[j][1] + v[j][2] * v[j][2] + v[j][3] * v[j][3]; }
        ss = wave_sum(ss); const float rs = rsqrtf(ss * (1.f / DM) + EPS);
#pragma unroll
        for (int j = 0; j < 8; ++j) { const f32x4 gv = *(const f32x4*)(g + j * 256 + lane * 4);
            u32x2 w; w.x = cvtpk(v[j][0] * rs * gv[0], v[j][1] * rs * gv[1]); w.y = cvtpk(v[j][2] * rs * gv[2], v[j][3] * rs * gv[3]);
            *(u32x2*)(h + (size_t)row * DM + j * 256 + lane * 4) = w; }
    }
}

__device__ __forceinline__ void fgate_phase(const bf16_t* __restrict__ h, const bf16_t* __restrict__ wft, const float* __restrict__ bfv, float* __restrict__ logf) {
    const int tid = opq(threadIdx.x), lane = tid & 63, gw = blockIdx.x * 8 + (tid >> 6), nw = gridDim.x * 8;
    const int fr = lane & 15, fq = lane >> 4;
    if ((gw & 3) != 0) return;
    for (int job = gw >> 2; job < NTOK / 16; job += (nw >> 2)) {
        const bf16_t* ap = h + (size_t)(job * 16 + fr) * DM + fq * 8; const bf16_t* bp = wft + (size_t)fr * DM + fq * 8;
        f32x4 acc = {0.f, 0.f, 0.f, 0.f};
#pragma unroll 8
        for (int k = 0; k < DM; k += 32) { const bf16x8 a = *(const bf16x8*)(ap + k), b = *(const bf16x8*)(bp + k); acc = __builtin_amdgcn_mfma_f32_16x16x32_bf16(a, b, acc, 0, 0, 0); }
        const float bb = bfv[fr];
#pragma unroll
        for (int j = 0; j < 4; ++j) { const float u = acc[j] + bb; logf[(size_t)(job * 16 + fq * 4 + j) * 16 + fr] = -(fmaxf(-u, 0.f) + log1pf(__expf(-fabsf(u)))); }
    }
}

__device__ __forceinline__ void fox_prep_phase(bf16_t* __restrict__ qk  , const float* __restrict__ qg, const float* __restrict__ kg, const float* __restrict__ logf, float* __restrict__ cf) {
    const int tid = opq(threadIdx.x), lane = tid & 63, gw = blockIdx.x * 8 + (tid >> 6), nw = gridDim.x * 8;
    const int sub = lane >> 4, l16 = lane & 15;
    const int nrows = 2 * NTOK * NH;
    for (int r0 = gw * 4; r0 < nrows; r0 += nw * 16) {
        u32x4 w[4];
#pragma unroll
        for (int q = 0; q < 4; ++q) { const int row = r0 + q * nw * 4 + sub; if (row < nrows) w[q] = *(const u32x4*)(qk + (size_t)row * HD + l16 * 8); }
#pragma unroll
        for (int q = 0; q < 4; ++q) { const int row = r0 + q * nw * 4 + sub; if (row < nrows) {
            const bool isk = row >= NTOK * NH; bf16_t* p = qk + (size_t)row * HD + l16 * 8;
            float v[8] = {bflo(w[q].x), bfhi(w[q].x), bflo(w[q].y), bfhi(w[q].y), bflo(w[q].z), bfhi(w[q].z), bflo(w[q].w), bfhi(w[q].w)};
            float ss = 0.f;
#pragma unroll
            for (int i = 0; i < 8; ++i) ss += v[i] * v[i];
            ss = sum16(ss); const float rs = rsqrtf(ss * (1.f / HD) + EPS);
            const float* gp = (isk ? kg : qg) + l16 * 8; const f32x4 g0 = *(const f32x4*)gp, g1 = *(const f32x4*)(gp + 4);
            u32x4 o; o.x = cvtpk(v[0] * rs * g0[0], v[1] * rs * g0[1]); o.y = cvtpk(v[2] * rs * g0[2], v[3] * rs * g0[3]);
            o.z = cvtpk(v[4] * rs * g1[0], v[5] * rs * g1[1]); o.w = cvtpk(v[6] * rs * g1[2], v[7] * rs * g1[3]);
            *(u32x4*)p = o; } }
    }
    for (int bh = blockIdx.x; bh < 64; bh += gridDim.x) {
        if ((threadIdx.x >> 6) != 0) continue;
        const int b = bh >> 4, hd = bh & 15; const float* lp = logf + (size_t)(b * SEQ + lane * 32) * 16 + hd;
        float v[32]; float tot = 0.f;
#pragma unroll
        for (int i = 0; i < 32; ++i) { tot += lp[(size_t)i * 16]; v[i] = tot; }
        float inc = tot;
#pragma unroll
        for (int o = 1; o < 64; o <<= 1) { const float up = __shfl_up(inc, o); if (lane >= o) inc += up; }
        const float base = inc - tot;
        float* cp = cf + (size_t)bh * SEQ + lane * 32;
#pragma unroll
        for (int i = 0; i < 32; ++i) cp[i] = base + v[i];
    }
}

__device__ __forceinline__ void mla_prep1_phase(const bf16_t* __restrict__ down, const int* __restrict__ pos, const float* __restrict__ qn, const float* __restrict__ kvn,
                                                bf16_t* __restrict__ cq, bf16_t* __restrict__ ckv, float* __restrict__ ropet, float* __restrict__ kr) {
    const int tid = opq(threadIdx.x), lane = tid & 63, gw = blockIdx.x * 8 + (tid >> 6), nw = gridDim.x * 8;
    for (int row = gw; row < NTOK; row += nw) {
        const bf16_t* dr = down + (size_t)row * MLA_DOWN_PAD;
        {   float v[12]; float ss = 0.f;
#pragma unroll
            for (int j = 0; j < 3; ++j) { const u32x2 w = *(const u32x2*)(dr + j * 256 + lane * 4); v[4 * j] = bflo(w.x); v[4 * j + 1] = bfhi(w.x); v[4 * j + 2] = bflo(w.y); v[4 * j + 3] = bfhi(w.y); }
#pragma unroll
            for (int i = 0; i < 12; ++i) ss += v[i] * v[i];
            ss = wave_sum(ss); const float rs = rsqrtf(ss * (1.f / MLA_QR) + EPS);
#pragma unroll
            for (int j = 0; j < 3; ++j) { const f32x4 g = *(const f32x4*)(qn + j * 256 + lane * 4);
                u32x2 w; w.x = cvtpk(v[4 * j] * rs * g[0], v[4 * j + 1] * rs * g[1]); w.y = cvtpk(v[4 * j + 2] * rs * g[2], v[4 * j + 3] * rs * g[3]);
                *(u32x2*)(cq + (size_t)row * MLA_QR + j * 256 + lane * 4) = w; } }
        {   float v[8]; float ss = 0.f;
#pragma unroll
            for (int j = 0; j < 2; ++j) { const u32x2 w = *(const u32x2*)(dr + MLA_QR + j * 256 + lane * 4); v[4 * j] = bflo(w.x); v[4 * j + 1] = bfhi(w.x); v[4 * j + 2] = bflo(w.y); v[4 * j + 3] = bfhi(w.y); }
#pragma unroll
            for (int i = 0; i < 8; ++i) ss += v[i] * v[i];
            ss = wave_sum(ss); const float rs = rsqrtf(ss * (1.f / MLA_KVR) + EPS);
#pragma unroll
            for (int j = 0; j < 2; ++j) { const f32x4 g = *(const f32x4*)(kvn + j * 256 + lane * 4);
                u32x2 w; w.x = cvtpk(v[4 * j] * rs * g[0], v[4 * j + 1] * rs * g[1]); w.y = cvtpk(v[4 * j + 2] * rs * g[2], v[4 * j + 3] * rs * g[3]);
                *(u32x2*)(ckv + (size_t)row * MLA_KVR + j * 256 + lane * 4) = w; } }
        if (lane < 32) {
            const float invf = powf(10000.0f, -(float)(2 * lane) / 64.0f);
            const float ang = (float)pos[row] * invf; const float cs = cosf(ang), sn = sinf(ang);
            ropet[(size_t)row * 64 + lane] = cs; ropet[(size_t)row * 64 + 32 + lane] = sn;
            const float x1 = __uint_as_float((unsigned)dr[MLA_QR + MLA_KVR + lane] << 16), x2 = __uint_as_float((unsigned)dr[MLA_QR + MLA_KVR + 32 + lane] << 16);
            kr[(size_t)row * 64 + lane] = x1 * cs - x2 * sn; kr[(size_t)row * 64 + 32 + lane] = x1 * sn + x2 * cs;
        }
    }
}

__device__ __forceinline__ void mla_prep2_phase(const bf16_t* __restrict__ qup, const bf16_t* __restrict__ kv, const float* __restrict__ ropet, const float* __restrict__ kr,
                                                const float* __restrict__ qg, const float* __restrict__ kg, bf16_t* __restrict__ Qn, bf16_t* __restrict__ Kn) {
    const int tid = opq(threadIdx.x), lane = tid & 63, gw = blockIdx.x * 8 + (tid >> 6), nw = gridDim.x * 8;
    const int sub = lane >> 4, j = lane & 15;
    const int nrows = 2 * NTOK * NH;
#pragma unroll 4
    for (int r0 = gw * 4; r0 < nrows; r0 += nw * 4) {
        int row = r0 + sub; const bool isk = row >= NTOK * NH; if (isk) row -= NTOK * NH;
        const int tok = row >> 4, hd = row & 15;
        float v[8], ra[2], rb[2];
        if (!isk) {
            const bf16_t* p = qup + (size_t)tok * 3072 + hd * 192;
            const u32x4 w = *(const u32x4*)(p + j * 8);
            v[0] = bflo(w.x); v[1] = bfhi(w.x); v[2] = bflo(w.y); v[3] = bfhi(w.y); v[4] = bflo(w.z); v[5] = bfhi(w.z); v[6] = bflo(w.w); v[7] = bfhi(w.w);
            const unsigned w1 = *(const unsigned*)(p + 128 + 2 * j), w2 = *(const unsigned*)(p + 160 + 2 * j);
            const float x1a = bflo(w1), x1b = bfhi(w1), x2a = bflo(w2), x2b = bfhi(w2);
            const float* rt = ropet + (size_t)tok * 64; const float c0 = rt[2 * j], c1 = rt[2 * j + 1], s0 = rt[32 + 2 * j], s1 = rt[32 + 2 * j + 1];
            ra[0] = x1a * c0 - x2a * s0; ra[1] = x1b * c1 - x2b * s1; rb[0] = x1a * s0 + x2a * c0; rb[1] = x1b * s1 + x2b * c1;
        } else {
            const bf16_t* p = kv + (size_t)tok * 4096 + hd * 256;
            const u32x4 w = *(const u32x4*)(p + j * 8);
            v[0] = bflo(w.x); v[1] = bfhi(w.x); v[2] = bflo(w.y); v[3] = bfhi(w.y); v[4] = bflo(w.z); v[5] = bfhi(w.z); v[6] = bflo(w.w); v[7] = bfhi(w.w);
            const float* kp = kr + (size_t)tok * 64; ra[0] = kp[2 * j]; ra[1] = kp[2 * j + 1]; rb[0] = kp[32 + 2 * j]; rb[1] = kp[32 + 2 * j + 1];
        }
        float ss = ra[0] * ra[0] + ra[1] * ra[1] + rb[0] * rb[0] + rb[1] * rb[1];
#pragma unroll
        for (int i = 0; i < 8; ++i) ss += v[i] * v[i];
        ss = sum16(ss); const float rs = rsqrtf(ss * (1.f / MLA_QK) + EPS);
        const float* g = isk ? kg : qg; const f32x4 g0 = *(const f32x4*)(g + j * 8), g1 = *(const f32x4*)(g + j * 8 + 4);
        bf16_t* o = (isk ? Kn : Qn) + (size_t)tok * 3072 + hd * 192;
        u32x4 ow; ow.x = cvtpk(v[0] * rs * g0[0], v[1] * rs * g0[1]); ow.y = cvtpk(v[2] * rs * g0[2], v[3] * rs * g0[3]);
        ow.z = cvtpk(v[4] * rs * g1[0], v[5] * rs * g1[1]); ow.w = cvtpk(v[6] * rs * g1[2], v[7] * rs * g1[3]);
        *(u32x4*)(o + j * 8) = ow;
        *(unsigned*)(o + 128 + 2 * j) = cvtpk(ra[0] * rs * g[128 + 2 * j], ra[1] * rs * g[128 + 2 * j + 1]);
        *(unsigned*)(o + 160 + 2 * j) = cvtpk(rb[0] * rs * g[160 + 2 * j], rb[1] * rs * g[160 + 2 * j + 1]);
    }
}

__device__ __forceinline__ int v_st(int k, int c) { const int kk = (k & ~0xC) | ((k & 4) << 1) | ((k & 8) >> 1); return ((kk >> 3) * 4 + (c >> 5)) * 512 + ((kk & 7) * 32 + (c & 31)) * 2; }
__device__ __forceinline__ int v_rd_base(int lane) { return ((lane & 3) << 3) | (((lane >> 2) & 3) << 6) | (((lane >> 4) & 1) << 5) | (((lane >> 5) & 1) << 8); }
constexpr int v_rd_off(int d0, int ks, int half) { return d0 * 512 + ks * 4096 + half * 2048; }
__device__ __forceinline__ int crow(int r, int hi) { return (r & 3) + 8 * (r >> 2) + 4 * hi; }

constexpr int AT_SHM_V = 16384, AT_KBUF = 24576;
constexpr int AT_OFF_K = 3 * AT_SHM_V, AT_OFF_WS = AT_OFF_K + 3 * AT_KBUF, AT_OFF_CF = AT_OFF_K + 3 * 16384;

#ifdef TESTB
#define SB_LG(y) fmaxf(1.f - 0.5f * fabsf(y), 0.f)
#else
#define SB_LG(y) __builtin_amdgcn_logf(1.f + __builtin_amdgcn_exp2f(-fabsf(y)))
#endif
#ifndef SB_BLOCK_EXIT
#define SB_BLOCK_EXIT 0
#endif
template <int DQK, int MODE>
__device__ __forceinline__ void attn_block(const bf16_t* __restrict__ Qg, int ldq, const bf16_t* __restrict__ Kg, int ldk, const bf16_t* __restrict__ Vg, int ldv,
                                           bf16_t* __restrict__ Og, int ldo, int q0, float C2, LAS unsigned char* lds) {
    constexpr int NQ = DQK / 16, ROWB = DQK * 2, SHM_K = 64 * ROWB, NCH = DQK / 8, KCH = NCH / 8;
#define KSW(row) (DQK == 128 ? (((row) & 15) << 4) : ((((row) >> 1) & 7) << 4))
    const int tid = opq(threadIdx.x), wid = __builtin_amdgcn_readfirstlane(tid >> 6), lane = tid & 63, r32 = lane & 31, hi = lane >> 5;
    LAS unsigned char* V_lds = lds; LAS unsigned char* K_lds = lds + AT_OFF_K;
    LAS float* li_l = (LAS float*)(lds + AT_OFF_WS) + wid * 64; LAS float* al_l = li_l + 32;
    const LAS float* cfl = (const LAS float*)(lds + AT_OFF_CF);
    const int qlo = q0 + wid * 32, trow = qlo + r32;
    bf16x8 qr[NQ];
#pragma unroll
    for (int d0 = 0; d0 < NQ; ++d0) qr[d0] = *(const bf16x8*)(Qg + (size_t)trow * ldq + d0 * 16 + hi * 8);
    const int NT = q0 / 64 + 4;
    int kso[KCH], vso[2];
#pragma unroll
    for (int i = 0; i < KCH; ++i) { const int L = (i * 8 + wid) * 1024 + lane * 16, row = L / ROWB, wi = L % ROWB; kso[i] = row * ldk + ((wi ^ KSW(row)) >> 1); }
#pragma unroll
    for (int i = 0; i < 2; ++i) { const int L = (i * 8 + wid) * 1024 + lane * 16, sub = L >> 9, we = (L & 511) >> 1, kk = (sub >> 2) * 8 + (we >> 5), c = (sub & 3) * 32 + (we & 31);
        const int k = (kk & ~0xC) | ((kk & 4) << 1) | ((kk & 8) >> 1); vso[i] = k * ldv + c; }
#define AT_DMA(kb_, buf_) do { const bf16_t* kp_ = Kg + (size_t)(kb_) * ldk; const bf16_t* vp_ = Vg + (size_t)(kb_) * ldv; \
        _Pragma("unroll") for (int i_ = 0; i_ < KCH; ++i_) __builtin_amdgcn_global_load_lds((const unsigned*)(kp_ + kso[i_]), (LAS unsigned*)(K_lds + (buf_) * SHM_K + (i_ * 8 + wid) * 1024), 16, 0, 0); \
        _Pragma("unroll") for (int i_ = 0; i_ < 2; ++i_) __builtin_amdgcn_global_load_lds((const unsigned*)(vp_ + vso[i_]), (LAS unsigned*)(V_lds + (buf_) * AT_SHM_V + (i_ * 8 + wid) * 1024), 16, 0, 0); } while (0)
#if ATT_DMA
    constexpr int NDMA = KCH + 2;
    AT_DMA((NT - 1) * 64, 0);
    AT_DMA((NT - 2) * 64, 1);
    if (NDMA == 4) asm volatile("s_waitcnt vmcnt(4)\n\ts_waitcnt lgkmcnt(0)\n\ts_barrier" ::: "memory");
    else           asm volatile("s_waitcnt vmcnt(5)\n\ts_waitcnt lgkmcnt(0)\n\ts_barrier" ::: "memory");
#else
    bf16x8 stk[KCH], stv[2];
    const int vk = tid >> 4, vc = (tid & 15) * 8;
#define AT_LOAD(kb_) do { _Pragma("unroll") for (int i_ = 0; i_ < KCH; ++i_) { const int c_ = tid + 512 * i_, row_ = c_ / NCH, cc_ = c_ % NCH; stk[i_] = *(const bf16x8*)(Kg + (size_t)((kb_) + row_) * ldk + cc_ * 8); } \
        _Pragma("unroll") for (int i_ = 0; i_ < 2; ++i_) stv[i_] = *(const bf16x8*)(Vg + (size_t)((kb_) + vk + 32 * i_) * ldv + vc); } while (0)
#define AT_WRITE(buf_) do { _Pragma("unroll") for (int i_ = 0; i_ < KCH; ++i_) { const int c_ = tid + 512 * i_, row_ = c_ / NCH, cc_ = c_ % NCH; \
            *(LAS bf16x8*)(K_lds + (buf_) * SHM_K + row_ * ROWB + ((cc_ * 16) ^ KSW(row_))) = stk[i_]; } \
        _Pragma("unroll") for (int i_ = 0; i_ < 2; ++i_) *(LAS bf16x8*)(V_lds + (buf_) * AT_SHM_V + v_st(vk + 32 * i_, vc)) = stv[i_]; } while (0)
    AT_LOAD((NT - 1) * 64); AT_WRITE(0);
    if (NT > 1) AT_LOAD((NT - 2) * 64);
    __syncthreads();
#endif
    f32x16 o[4];
#pragma unroll
    for (int d = 0; d < 4; ++d)
#pragma unroll
        for (int r = 0; r < 16; ++r) o[d][r] = 0.f;
    float m_reg = -1e30f, l_reg = 0.f, carry = 0.f;
    float cft = 0.f; if (MODE == 1) cft = cfl[trow];
    int koff[4];
#pragma unroll
    for (int dd = 0; dd < 4; ++dd) koff[dd] = r32 * ROWB + ((dd * 32 + hi * 16) ^ (KSW(r32) & 0x70));
    const int kx7 = KSW(r32) & 0x80;
    const int vbase = (int)(uintptr_t)V_lds + v_rd_base(lane);
    bool wdone = false;
    LAS unsigned* dflag = (LAS unsigned*)(lds + AT_OFF_CF);
    for (int it = 0; it < NT; ++it) {
        const int kb = (NT - 1 - it) * 64;
#if ATT_DMA
        const int cur = it % 3;
#else
        const int cur = it & 1;
#endif
        bool alld = false;
        if (MODE == 0 && it > 0) {
            const LAS unsigned* fp = dflag + ((it - 1) & 1) * 8; const u32x4 f0 = *(const LAS u32x4*)fp, f1 = *(const LAS u32x4*)(fp + 4);
            alld = __builtin_amdgcn_readfirstlane(f0.x & f0.y & f0.z & f0.w & f1.x & f1.y & f1.z & f1.w) != 0u;
        }
        const bool act = (kb <= qlo + 31) && !wdone;
#if ATT_DMA
        const bool issued = (it + 2 < NT) && !alld;
        if (issued) AT_DMA(kb - 128, (it + 2) % 3);
#endif
        if (act) {
            f32x16 p0, p1;
#pragma unroll
            for (int r = 0; r < 16; ++r) { p0[r] = 0.f; p1[r] = 0.f; }
            const LAS unsigned char* kbase = K_lds + cur * SHM_K;
#pragma unroll
            for (int dg = 0; dg < NQ / 4; ++dg) {
                bf16x8 kf0[4], kf1[4];
#pragma unroll
                for (int dd = 0; dd < 4; ++dd) { const LAS unsigned char* a = kbase + koff[dd] + ((dg * 128) ^ kx7); kf0[dd] = *(const LAS bf16x8*)a; kf1[dd] = *(const LAS bf16x8*)(a + 32 * ROWB); }
#pragma unroll
                for (int dd = 0; dd < 4; ++dd) { p0 = __builtin_amdgcn_mfma_f32_32x32x16_bf16(kf0[dd], qr[dg * 4 + dd], p0, 0, 0, 0); p1 = __builtin_amdgcn_mfma_f32_32x32x16_bf16(kf1[dd], qr[dg * 4 + dd], p1, 0, 0, 0); }
                __builtin_amdgcn_sched_barrier(0);
            }
            const int dq = trow - kb - 4 * hi;
            if (MODE == 0) {
                const bool needm = kb + 63 >= qlo;
                f32x16 lkA, lkB;
#pragma unroll
                for (int r = 0; r < 16; ++r) { p0[r] *= C2; p1[r] *= C2; }
#pragma unroll
                for (int r = 0; r < 16; ++r) { lkA[r] = __builtin_amdgcn_exp2f(-fabsf(p0[r])); lkB[r] = __builtin_amdgcn_exp2f(-fabsf(p1[r])); }
                __builtin_amdgcn_sched_barrier(0);
#pragma unroll
                for (int r = 0; r < 16; ++r) { lkA[r] += 1.f; lkB[r] += 1.f; }
                __builtin_amdgcn_sched_barrier(0);
#pragma unroll
                for (int r = 0; r < 16; ++r) { lkA[r] = __builtin_amdgcn_logf(lkA[r]); lkB[r] = __builtin_amdgcn_logf(lkB[r]); }
                __builtin_amdgcn_sched_barrier(0);
#pragma unroll
                for (int r = 0; r < 16; ++r) { const int c = (r & 3) + 8 * (r >> 2);
                    { const float y = p0[r]; const float sp = fmaxf(y, 0.f) + lkA[r];
                      float lk = -sp, lb = y - sp; if (needm && !(c < dq)) { lk = 0.f; lb = -__builtin_inff(); } lkA[r] = lk; p0[r] = lb; }
                    { const float y = p1[r]; const float sp = fmaxf(y, 0.f) + lkB[r];
                      float lk = -sp, lb = y - sp; if (needm && !(c + 32 < dq)) { lk = 0.f; lb = -__builtin_inff(); } lkB[r] = lk; p1[r] = lb; } }
                __builtin_amdgcn_sched_barrier(0);
                float run = carry;
#pragma unroll
                for (int g = 7; g >= 0; --g) {
                    const float gs = (g < 4) ? (lkA[4 * g] + lkA[4 * g + 1]) + (lkA[4 * g + 2] + lkA[4 * g + 3]) : (lkB[4 * (g - 4)] + lkB[4 * (g - 4) + 1]) + (lkB[4 * (g - 4) + 2] + lkB[4 * (g - 4) + 3]);
                    auto rr = __builtin_amdgcn_permlane32_swap(__float_as_uint(gs), __float_as_uint(gs), false, false);
                    const float e = __uint_as_float(rr[0]), od = __uint_as_float(rr[1]);
                    const float base = run + (hi ? 0.f : od);
                    if (g < 4) { const int b = 4 * g; const float l3 = base, l2 = l3 + lkA[b + 3], l1 = l2 + lkA[b + 2], l0 = l1 + lkA[b + 1];
                        p0[b] = __builtin_amdgcn_exp2f(p0[b] + l0); p0[b + 1] = __builtin_amdgcn_exp2f(p0[b + 1] + l1); p0[b + 2] = __builtin_amdgcn_exp2f(p0[b + 2] + l2); p0[b + 3] = __builtin_amdgcn_exp2f(p0[b + 3] + l3); }
                    else { const int b = 4 * (g - 4); const float l3 = base, l2 = l3 + lkB[b + 3], l1 = l2 + lkB[b + 2], l0 = l1 + lkB[b + 1];
                        p1[b] = __builtin_amdgcn_exp2f(p1[b] + l0); p1[b + 1] = __builtin_amdgcn_exp2f(p1[b + 1] + l1); p1[b + 2] = __builtin_amdgcn_exp2f(p1[b + 2] + l2); p1[b + 3] = __builtin_amdgcn_exp2f(p1[b + 3] + l3); }
                    run += e + od;
                }
                carry = run;
                __builtin_amdgcn_sched_barrier(0);
            } else {
                if (MODE == 1) {
#pragma unroll
                    for (int g = 0; g < 4; ++g) { const f32x4 c0 = *(const LAS f32x4*)(cfl + kb + 8 * g + 4 * hi), c1 = *(const LAS f32x4*)(cfl + kb + 32 + 8 * g + 4 * hi);
#pragma unroll
                        for (int i = 0; i < 4; ++i) { p0[4 * g + i] = fmaf(p0[4 * g + i], C2, cft - c0[i]); p1[4 * g + i] = fmaf(p1[4 * g + i], C2, cft - c1[i]); } }
                } else {
#pragma unroll
                    for (int r = 0; r < 16; ++r) { p0[r] *= C2; p1[r] *= C2; }
                }
                if (kb + 63 > qlo) {
#pragma unroll
                    for (int r = 0; r < 16; ++r) { const int c = (r & 3) + 8 * (r >> 2); if (!(c <= dq)) p0[r] = -__builtin_inff(); if (!(c + 32 <= dq)) p1[r] = -__builtin_inff(); }
                }
                float pmax = p0[0];
#pragma unroll
                for (int r = 1; r < 16; ++r) pmax = fmaxf(pmax, p0[r]);
#pragma unroll
                for (int r = 0; r < 16; ++r) pmax = fmaxf(pmax, p1[r]);
                { auto rr = __builtin_amdgcn_permlane32_swap(__float_as_uint(pmax), __float_as_uint(pmax), false, false); pmax = fmaxf(__uint_as_float(rr[0]), __uint_as_float(rr[1])); }
                float mn, alpha;
                if (__all(pmax - m_reg <= 11.f)) { mn = m_reg; alpha = 1.f; }
                else { mn = fmaxf(m_reg, pmax); alpha = __builtin_amdgcn_exp2f(m_reg - mn); m_reg = mn; }
                float ps = 0.f;
#pragma unroll
                for (int r = 0; r < 16; ++r) { p0[r] = __builtin_amdgcn_exp2f(p0[r] - mn); p1[r] = __builtin_amdgcn_exp2f(p1[r] - mn); ps += p0[r] + p1[r]; }
                { auto rr = __builtin_amdgcn_permlane32_swap(__float_as_uint(ps), __float_as_uint(ps), false, false); ps = __uint_as_float(rr[0]) + __uint_as_float(rr[1]); }
                l_reg = l_reg * alpha + ps;
                if (__any(alpha < 1.f)) {
                    if (hi == 0) al_l[r32] = alpha;
                    asm volatile("s_waitcnt lgkmcnt(0)" ::: "memory");
#pragma unroll
                    for (int g = 0; g < 4; ++g) { const f32x4 av = *(const LAS f32x4*)(al_l + 8 * g + 4 * hi);
#pragma unroll
                        for (int d = 0; d < 4; ++d)
#pragma unroll
                            for (int i = 0; i < 4; ++i) o[d][4 * g + i] *= av[i]; }
                }
            }
            bf16x8 pa0, pa1, pa2, pa3;
#define PK4(P, B_, OUT) do { unsigned a0 = cvtpk(P[B_+0], P[B_+1]), a1 = cvtpk(P[B_+2], P[B_+3]); unsigned b0 = cvtpk(P[B_+4], P[B_+5]), b1 = cvtpk(P[B_+6], P[B_+7]); \
        auto r0 = __builtin_amdgcn_permlane32_swap(a0, b0, false, false); auto r1 = __builtin_amdgcn_permlane32_swap(a1, b1, false, false); \
        u32x4 w = {r0[0], r1[0], r0[1], r1[1]}; OUT = *reinterpret_cast<bf16x8*>(&w); } while (0)
            PK4(p0, 0, pa0); PK4(p0, 8, pa1); PK4(p1, 0, pa2); PK4(p1, 8, pa3);
#undef PK4
            const int vb0 = vbase + cur * AT_SHM_V;
#define TRRD(dst, off) asm volatile("ds_read_b64_tr_b16 %0, %1 offset:%2" : "=&v"(dst) : "v"(vb0), "i"(off) : "memory")
#define PV_D0(d0) do { s16x4 l0, l1, l2, l3, h0, h1, h2, h3; constexpr int b_ = v_rd_off(d0, 0, 0); \
        TRRD(l0, b_); TRRD(h0, b_ + 2048); TRRD(l1, b_ + 4096); TRRD(h1, b_ + 6144); TRRD(l2, b_ + 8192); TRRD(h2, b_ + 10240); TRRD(l3, b_ + 12288); TRRD(h3, b_ + 14336); \
        asm volatile("s_waitcnt lgkmcnt(0)" ::: "memory"); __builtin_amdgcn_sched_barrier(0); \
        o[d0] = __builtin_amdgcn_mfma_f32_32x32x16_bf16(pa0, (bf16x8){l0[0], l0[1], l0[2], l0[3], h0[0], h0[1], h0[2], h0[3]}, o[d0], 0, 0, 0); \
        o[d0] = __builtin_amdgcn_mfma_f32_32x32x16_bf16(pa1, (bf16x8){l1[0], l1[1], l1[2], l1[3], h1[0], h1[1], h1[2], h1[3]}, o[d0], 0, 0, 0); \
        o[d0] = __builtin_amdgcn_mfma_f32_32x32x16_bf16(pa2, (bf16x8){l2[0], l2[1], l2[2], l2[3], h2[0], h2[1], h2[2], h2[3]}, o[d0], 0, 0, 0); \
        o[d0] = __builtin_amdgcn_mfma_f32_32x32x16_bf16(pa3, (bf16x8){l3[0], l3[1], l3[2], l3[3], h3[0], h3[1], h3[2], h3[3]}, o[d0], 0, 0, 0); } while (0)
            PV_D0(0); PV_D0(1); PV_D0(2); PV_D0(3);
#undef PV_D0
#undef TRRD
        }
        if (MODE == 0) { if (kb <= qlo + 31) wdone = __all(carry < -152.f) != 0; if (lane == 0) dflag[(it & 1) * 8 + wid] = wdone ? 1u : 0u; }
#if ATT_DMA
        if (issued) { if (NDMA == 4) asm volatile("s_waitcnt vmcnt(4)\n\ts_waitcnt lgkmcnt(0)\n\ts_barrier" ::: "memory"); else asm volatile("s_waitcnt vmcnt(5)\n\ts_waitcnt lgkmcnt(0)\n\ts_barrier" ::: "memory"); }
        else asm volatile("s_waitcnt vmcnt(0)\n\ts_waitcnt lgkmcnt(0)\n\ts_barrier" ::: "memory");
#else
        if (it + 1 < NT) { AT_WRITE(cur ^ 1); if (it + 2 < NT) AT_LOAD((NT - 3 - it) * 64); }
        __syncthreads();
#endif
    }
#undef AT_DMA
#undef KSW
    float rli[16];
    if (MODE != 0) {
        if (hi == 0) li_l[r32] = l_reg;
        asm volatile("s_waitcnt lgkmcnt(0)" ::: "memory");
#pragma unroll
        for (int g = 0; g < 4; ++g) { const f32x4 lv = *(const LAS f32x4*)(li_l + 8 * g + 4 * hi);
#pragma unroll
            for (int i = 0; i < 4; ++i) rli[4 * g + i] = 1.0f / lv[i]; }
    } else {
#pragma unroll
        for (int r = 0; r < 16; ++r) rli[r] = 1.f;
    }
    bf16_t* Ow = Og + (size_t)qlo * ldo;
#pragma unroll
    for (int r = 0; r < 16; ++r) { const int orow = crow(r, hi);
#pragma unroll
        for (int d0 = 0; d0 < 4; ++d0) { const float v = o[d0][r] * rli[r]; const float vn = __shfl_xor(v, 1);
            if ((r32 & 1) == 0) *(unsigned*)(Ow + (size_t)orow * ldo + d0 * 32 + r32) = cvtpk(v, vn); } }
}

template <int DQK, int MODE>
__device__ __forceinline__ void attn_phase(const bf16_t* Qb, int ldq, int hq, const bf16_t* Kb, int ldk, int hk, const bf16_t* Vb, int ldv, int hv, bf16_t* Ob, const float* cf, float C2, LAS unsigned char* lds) {
#ifdef TESTCOPY
    if (MODE == 0) {
        for (size_t i = (size_t)blockIdx.x * 512 + threadIdx.x; i < (size_t)NTOK * DM; i += (size_t)gridDim.x * 512) {
            const float a = __uint_as_float((unsigned)Qb[i] << 16) + __uint_as_float((unsigned)Kb[i] << 16) + __uint_as_float((unsigned)Vb[i] << 16);
            Ob[i] = (bf16_t)(__float_as_uint(sinf(300.f * a)) >> 16); }
        return;
    }
#endif
#ifdef TESTNAN
    for (int i = threadIdx.x; i < LDS_BYTES / 4; i += 512) ((LAS unsigned*)lds)[i] = 0xFFFFFFFFu;
    __syncthreads();
#endif
    for (int w = blockIdx.x; w < 256; w += gridDim.x) {
        const int xcd = w & 7, slot = w >> 3, bh = xcd * 8 + (slot >> 2), y = slot & 3, b = bh >> 4, hd = bh & 15;
        if (MODE == 1) { LAS float* cfl = (LAS float*)(lds + AT_OFF_CF);
            for (int s = threadIdx.x; s < SEQ; s += 512) cfl[s] = cf[(size_t)bh * SEQ + s] * LOG2E;
            __syncthreads(); }
        const bf16_t* Q = Qb + (size_t)b * SEQ * ldq + hd * hq; const bf16_t* K = Kb + (size_t)b * SEQ * ldk + hd * hk; const bf16_t* V = Vb + (size_t)b * SEQ * ldv + hd * hv;
        bf16_t* O = Ob + (size_t)b * SEQ * DM + hd * HD;
        attn_block<DQK, MODE>(Q, ldq, K, ldk, V, ldv, O, DM, (7 - y) * 256, C2, lds);
        attn_block<DQK, MODE>(Q, ldq, K, ldk, V, ldv, O, DM, y * 256, C2, lds);
        __syncthreads();
    }
}

#define XB_TMO      128
#define XB_XCNT(j)  (256  + 64 * (j))
#define XB_XSUB(j)  (1280 + 64 * (j))
#define XB_XGEN(j)  (2304 + 64 * (j))
#define XB_TOP      3328
#define XB_TOPGEN   3392
#define XCD_BAR_WORDS 3456
#define XB_SPIN_CAP (1u << 18)
__device__ __forceinline__ unsigned xb_ld(unsigned* p)              { return __hip_atomic_load(p, __ATOMIC_RELAXED, __HIP_MEMORY_SCOPE_AGENT); }
__device__ __forceinline__ unsigned xb_add(unsigned* p, unsigned v) { return __hip_atomic_fetch_add(p, v, __ATOMIC_RELAXED, __HIP_MEMORY_SCOPE_AGENT); }
__device__ __forceinline__ unsigned xb_xcc_id() { return (unsigned)__builtin_amdgcn_s_getreg((3 << 11) | 20) & 0xFu; }
#define XB_SPIN(cond, bar) do { unsigned _sp = 0; while (cond) { __builtin_amdgcn_s_sleep(1); \
    if ((++_sp & 255u) == 0u) { if (xb_ld(&(bar)[XB_TMO])) break; if (_sp > XB_SPIN_CAP) { atomicAdd(&(bar)[XB_TMO], 1u); break; } } } } while (0)
struct XcdBarrier { unsigned* bar; unsigned x; volatile LAS unsigned* st; };
__device__ __forceinline__ XcdBarrier xcd_barrier_post(unsigned* bar, volatile LAS unsigned* st) {
    XcdBarrier b; b.bar = bar; b.x = xb_xcc_id(); b.st = st;
    if (threadIdx.x == 0) (void)xb_add(&bar[XB_XCNT(b.x)], 1u);
    return b;
}
__device__ __forceinline__ void xcd_barrier_complete(unsigned* bar, unsigned x, unsigned& nloc, unsigned& nx) {
    const unsigned G = gridDim.x * gridDim.y * gridDim.z;
    unsigned sum, cnt, mine, sp = 0u;
    for (;;) {
        sum = 0u; cnt = 0u; mine = 0u;
#pragma unroll
        for (unsigned j = 0; j < 16; ++j) { const unsigned c = xb_ld(&bar[XB_XCNT(j)]); sum += c; cnt += (c > 0u) ? 1u : 0u; mine = (j == x) ? c : mine; }
        if (sum == G) break;
        __builtin_amdgcn_s_sleep(1);
        if ((++sp & 255u) == 0u) { if (xb_ld(&bar[XB_TMO])) break; if (sp > XB_SPIN_CAP) { atomicAdd(&bar[XB_TMO], 1u); break; } }
    }
    nloc = mine > 0u ? mine : 1u; nx = cnt > 0u ? cnt : 1u;
}
__device__ __forceinline__ void xcd_barrier(const XcdBarrier& b) {
    asm volatile("s_waitcnt vmcnt(0)" ::: "memory");
    __syncthreads();
    if (threadIdx.x == 0) {
        unsigned* bar = b.bar;
        __builtin_amdgcn_s_waitcnt(0);
        unsigned nloc = b.st[0], nx = b.st[1];
        if (nloc == 0u) { xcd_barrier_complete(bar, b.x, nloc, nx); b.st[0] = nloc; b.st[1] = nx; }
        const unsigned old = xb_add(&bar[XB_XSUB(b.x)], 1u);
        const unsigned gen = old / nloc;
        if (old + 1u == (gen + 1u) * nloc) {
            __builtin_amdgcn_fence(__ATOMIC_RELEASE, "agent");
            asm volatile("s_waitcnt vmcnt(0)" ::: "memory");
            const unsigned og = xb_add(&bar[XB_TOP], 1u);
            const unsigned tg = og / nx;
            if (og + 1u == (tg + 1u) * nx) xb_add(&bar[XB_TOPGEN], 1u);
            else XB_SPIN(xb_ld(&bar[XB_TOPGEN]) == tg, bar);
            __builtin_amdgcn_fence(__ATOMIC_ACQUIRE, "agent");
            xb_add(&bar[XB_XGEN(b.x)], 1u);
            asm volatile("s_waitcnt vmcnt(0)" ::: "memory");
        } else {
            XB_SPIN(xb_ld(&bar[XB_XGEN(b.x)]) == gen, bar);
            __builtin_amdgcn_fence(__ATOMIC_ACQUIRE, "agent");
            asm volatile("s_waitcnt vmcnt(0)" ::: "memory");
        }
    }
    __syncthreads();
}

#ifndef NLAYERS
#define NLAYERS 4
#endif
constexpr int N_PHASES = 1 + 10 * NLAYERS;
__host__ __device__ inline bool phase_active(int ph) {
    if (ph == 0) return true;
    const int layer = (ph - 1) / 10, s = (ph - 1) % 10, kind = layer % 3;
    if (s == 2) return kind != 0;
    if (s == 3 || s == 4) return kind == 2;
    return true;
}

__global__ void __launch_bounds__(512, 2) fwd_megakernel(Params p) {
    extern __shared__ __attribute__((aligned(16))) unsigned char shm_raw[];
    LAS unsigned char* lds = (LAS unsigned char*)shm_raw;
    unsigned char* ws = p.ws;
    float* X = (float*)(ws + WS_X); bf16_t* H = (bf16_t*)(ws + WS_H); bf16_t* AO = (bf16_t*)(ws + WS_AO);
    float* LOGF = (float*)(ws + WS_LOGF); float* CF = (float*)(ws + WS_CF); float* ROPE = (float*)(ws + WS_ROPE); float* KR = (float*)(ws + WS_KR);
    unsigned char* scr = ws + WS_SCR;
    bool first = true;
#if COOP
    volatile LAS unsigned* st = (volatile LAS unsigned*)(lds + 131072);
    if (threadIdx.x == 0) { st[0] = 0u; st[1] = 0u; }
    __syncthreads();
    const XcdBarrier xb = xcd_barrier_post((unsigned*)(ws + WS_BAR), st);
    int nsync = 0;
#endif
    for (int ph = (int)p.ph_lo; ph < (int)p.ph_hi; ++ph) {
        if (!phase_active(ph)) continue;
#if COOP
        if (!first) { if (nsync == 0) cg::this_grid().sync(); else xcd_barrier(xb); ++nsync; }
#endif
        first = false;
        if (ph == 0) { if (EN(100)) {
            for (int j = 0; j < 2; ++j) {
                conv_job(lds, p.sb_w_in + (size_t)j * 2048 * 6144, 6144, 0, 6144, 6144, 2048, (bf16_t*)(ws + W_SB_IN + j * SZ_QKVW));
                conv_job(lds, p.sb_w_out + (size_t)j * 2048 * 2048, 2048, 0, 2048, 2048, 2048, (bf16_t*)(ws + W_SB_OUT + j * SZ_SQW));
            }
            conv_job(lds, p.fox_w_in, 6160, 0, 6144, 6144, 2048, (bf16_t*)(ws + W_FOX_IN));
            conv_job(lds, p.fox_w_in, 6160, 6144, 16, 128, 2048, (bf16_t*)(ws + W_FOX_F));
            conv_job(lds, p.fox_w_out, 2048, 0, 2048, 2048, 2048, (bf16_t*)(ws + W_FOX_OUT));
            conv_job(lds, p.mla_w_in, MLA_DOWN, 0, MLA_DOWN, MLA_DOWN_PAD, 2048, (bf16_t*)(ws + W_MLA_IN));
            conv_job(lds, p.mla_w_uq, 3072, 0, 3072, 3072, 768, (bf16_t*)(ws + W_MLA_UQ));
            conv_job(lds, p.mla_w_ukv, 4096, 0, 4096, 4096, 512, (bf16_t*)(ws + W_MLA_UKV));
            conv_job(lds, p.mla_w_out, 2048, 0, 2048, 2048, 2048, (bf16_t*)(ws + W_MLA_OUT));
            for (int j = 0; j < 4; ++j) {
                conv_job(lds, p.mlp_w1 + (size_t)j * 2048 * 8192, 8192, 0, 8192, 8192, 2048, (bf16_t*)(ws + W_W1 + j * SZ_FFW));
                conv_job(lds, p.mlp_w2 + (size_t)j * 8192 * 2048, 2048, 0, 2048, 2048, 8192, (bf16_t*)(ws + W_W2 + j * SZ_FFW));
            } }
            continue;
        }
        const int layer = (ph - 1) / 10, s = (ph - 1) % 10, kind = layer % 3, j = layer / 3;
        const float* xin = (layer == 0) ? p.x : X;
        int ng = 0; GemmJob g0{}, g1{}; bool do_fgate = false;
        g0.M = NTOK; g1.M = NTOK;
        if (s == 0 || s == 7) { if (EN(0)) rmsnorm_phase(s == 0 ? xin : X, (s == 0 ? p.mix_norm : p.mlp_norm) + layer * DM, H); }
        else if (s == 1) {
            ng = 1; g0.A = H; g0.K = DM;
            if (kind == 2) { g0.Bt = (const bf16_t*)(ws + W_MLA_IN); g0.N = MLA_DOWN_PAD; g0.E = pg8::EpiGen{0, (bf16_t*)(scr + SC_DOWN), MLA_DOWN_PAD, 0, 0, nullptr, nullptr}; }
            else { g0.Bt = (const bf16_t*)(ws + (kind == 0 ? W_SB_IN + j * SZ_QKVW : W_FOX_IN)); g0.N = 3 * DM; g0.E = pg8::EpiGen{0, (bf16_t*)(scr + SC_Q), DM, DM, (size_t)NTOK * DM, nullptr, nullptr}; do_fgate = kind == 1; }
        } else if (s == 2) {
            if (kind == 1) { if (EN(2)) fox_prep_phase((bf16_t*)(scr + SC_Q), p.fox_q_gain, p.fox_k_gain, LOGF, CF); }
            else { if (EN(2)) mla_prep1_phase((const bf16_t*)(scr + SC_DOWN), p.pos, p.mla_q_norm, p.mla_kv_norm, (bf16_t*)(scr + SC_CQ), (bf16_t*)(scr + SC_CKV), ROPE, KR); }
        } else if (s == 3) {
            ng = 2;
            g0.A = (const bf16_t*)(scr + SC_CQ); g0.Bt = (const bf16_t*)(ws + W_MLA_UQ); g0.N = 3072; g0.K = MLA_QR; g0.E = pg8::EpiGen{0, (bf16_t*)(scr + SC_QUP), 3072, 0, 0, nullptr, nullptr};
            g1.A = (const bf16_t*)(scr + SC_CKV); g1.Bt = (const bf16_t*)(ws + W_MLA_UKV); g1.N = 4096; g1.K = MLA_KVR; g1.E = pg8::EpiGen{0, (bf16_t*)(scr + SC_KV), 4096, 0, 0, nullptr, nullptr};
        } else if (s == 4) { if (EN(4)) mla_prep2_phase((const bf16_t*)(scr + SC_QUP), (const bf16_t*)(scr + SC_KV), ROPE, KR, p.mla_q_gain, p.mla_k_gain, (bf16_t*)(scr + SC_QN), (bf16_t*)(scr + SC_KN)); }
        else if (s == 5) {
#ifdef PROBE_ATT2
          for (int rep = 0; rep < 2; ++rep) {
#endif
            if (kind == 0) { if (EN(50)) attn_phase<128, TESTMODE2 ? 2 : 0>((const bf16_t*)(scr + SC_Q), DM, HD, (const bf16_t*)(scr + SC_K), DM, HD, (const bf16_t*)(scr + SC_V), DM, HD, AO, nullptr, 0.08838834764831845f * LOG2E, lds); }
            else if (kind == 1) { if (EN(51)) attn_phase<128, 1>((const bf16_t*)(scr + SC_Q), DM, HD, (const bf16_t*)(scr + SC_K), DM, HD, (const bf16_t*)(scr + SC_V), DM, HD, AO, CF, 0.08838834764831845f * LOG2E, lds); }
            else { if (EN(52)) attn_phase<192, 2>((const bf16_t*)(scr + SC_QN), 3072, 192, (const bf16_t*)(scr + SC_KN), 3072, 192, (const bf16_t*)(scr + SC_KV) + 128, 4096, 256, AO, nullptr, 0.07216878364870323f * LOG2E, lds); }
#ifdef PROBE_ATT2
          }
#endif
        } else if (s == 6) {
            ng = 1; g0.A = AO; g0.K = DM; g0.N = DM; g0.Bt = (const bf16_t*)(ws + (kind == 0 ? W_SB_OUT + j * SZ_SQW : (kind == 1 ? W_FOX_OUT : W_MLA_OUT)));
            g0.E = pg8::EpiGen{2, nullptr, DM, 0, 0, xin, X};
        } else if (s == 8) {
            ng = 1; g0.A = H; g0.K = DM; g0.N = DFF; g0.Bt = (const bf16_t*)(ws + W_W1 + layer * SZ_FFW); g0.E = pg8::EpiGen{1, (bf16_t*)scr, DFF, 0, 0, nullptr, nullptr};
        } else {
            ng = 1; g0.A = (const bf16_t*)scr; g0.K = DFF; g0.N = DM; g0.Bt = (const bf16_t*)(ws + W_W2 + layer * SZ_FFW); g0.E = pg8::EpiGen{2, nullptr, DM, 0, 0, X, (layer == NLAYERS - 1) ? p.out : X};
        }
        if (EN(1)) {
#pragma nounroll
            for (int gi = 0; gi < ng; ++gi) run_gemm(lds, gi ? g1 : g0);
        }
        if (do_fgate && EN(2)) fgate_phase(H, (const bf16_t*)(ws + W_FOX_F), p.fox_b_f, LOGF);
    }
}

extern "C" void kernel_launch(void* const* d_in, const int* in_sizes, int n_in, void* d_out, int out_size, void* d_ws, size_t ws_size, hipStream_t stream) {
    static int grid = 0;
    if (grid == 0) {
        if (n_in != 21 || out_size != NTOK * DM || ws_size < WS_END) { fprintf(stderr, "kernel_launch: unexpected shapes (n_in %d out %d ws %zu need %zu)\n", n_in, out_size, ws_size, (size_t)WS_END); grid = -1; return; }
        int dev = 0, cus = 0, per_cu = 0;
        hipGetDevice(&dev); hipDeviceGetAttribute(&cus, hipDeviceAttributeMultiprocessorCount, dev);
        if (hipFuncSetAttribute((const void*)fwd_megakernel, hipFuncAttributeMaxDynamicSharedMemorySize, LDS_BYTES) != hipSuccess) { fprintf(stderr, "kernel_launch: hipFuncSetAttribute failed\n"); grid = -1; return; }
        if (hipOccupancyMaxActiveBlocksPerMultiprocessor(&per_cu, (const void*)fwd_megakernel, 512, LDS_BYTES) != hipSuccess || per_cu < 1) { fprintf(stderr, "kernel_launch: occupancy query says %d\n", per_cu); per_cu = 1; }
        (void)hipGetLastError();
        grid = cus * 1;
        if (grid > 256) grid = 256;
    }
    if (grid < 0) return;
    Params p{};
    p.x = (const float*)d_in[0]; p.pos = (const int*)d_in[1]; p.mix_norm = (const float*)d_in[2]; p.mlp_norm = (const float*)d_in[3];
    p.sb_w_in = (const float*)d_in[4]; p.sb_w_out = (const float*)d_in[5]; p.fox_w_in = (const float*)d_in[6]; p.fox_b_f = (const float*)d_in[7];
    p.fox_q_gain = (const float*)d_in[8]; p.fox_k_gain = (const float*)d_in[9]; p.fox_w_out = (const float*)d_in[10];
    p.mla_w_in = (const float*)d_in[11]; p.mla_q_norm = (const float*)d_in[12]; p.mla_kv_norm = (const float*)d_in[13]; p.mla_w_uq = (const float*)d_in[14]; p.mla_w_ukv = (const float*)d_in[15];
    p.mla_q_gain = (const float*)d_in[16]; p.mla_k_gain = (const float*)d_in[17]; p.mla_w_out = (const float*)d_in[18]; p.mlp_w1 = (const float*)d_in[19]; p.mlp_w2 = (const float*)d_in[20];
    p.out = (float*)d_out; p.ws = (unsigned char*)d_ws;
#if COOP
    hipMemsetAsync((char*)d_ws + WS_BAR, 0, 16384, stream);
    p.ph_lo = 0; p.ph_hi = N_PHASES;
    void* args[] = {&p};
    hipError_t e = hipLaunchCooperativeKernel((const void*)fwd_megakernel, dim3(grid), dim3(512), args, LDS_BYTES, stream);
    if (e != hipSuccess) fprintf(stderr, "cooperative launch failed: %s (grid %d)\n", hipGetErrorString(e), grid);
#else
    for (int ph = 0; ph < N_PHASES; ++ph) {
        if (!phase_active(ph)) continue;
        p.ph_lo = ph; p.ph_hi = ph + 1;
        hipLaunchKernelGGL(fwd_megakernel, dim3(grid), dim3(512), LDS_BYTES, stream, p);
    }
#endif
}
```

```cpp
#include <hip/hip_runtime.h>
#include <hip/hip_cooperative_groups.h>
#include <cstdio>
#include <cstdint>
namespace cg = cooperative_groups;

#ifndef COOP
#define COOP 1
#endif
#ifndef ONLY
#define ONLY -1
#endif
#ifndef ATT_DMA
#define ATT_DMA 1
#endif
#define TESTMODE2 0

#ifndef SKIP
#define SKIP -5
#endif
#define EN(x) ((ONLY < 0 || ONLY == (x)) && (x) != SKIP)

#define LAS __attribute__((address_space(3)))
typedef unsigned short bf16_t;
typedef short bf16x8 __attribute__((ext_vector_type(8)));
typedef short s16x4 __attribute__((ext_vector_type(4)));
typedef float f32x4 __attribute__((ext_vector_type(4)));
typedef float f32x16 __attribute__((ext_vector_type(16)));
typedef unsigned u32x4 __attribute__((ext_vector_type(4)));
typedef unsigned u32x2 __attribute__((ext_vector_type(2)));

constexpr int DM = 2048, NTOK = 8192, SEQ = 2048, NH = 16, HD = 128, DFF = 8192, DEPTH = 4;
constexpr int MLA_QR = 768, MLA_KVR = 512, MLA_ROPE = 64, MLA_QK = 192, MLA_DOWN = 1344, MLA_DOWN_PAD = 1536;
constexpr float EPS = 1e-6f;
constexpr float LOG2E = 1.4426950408889634f;

constexpr size_t SZ_QKVW = (size_t)6144 * 2048 * 2, SZ_SQW = (size_t)2048 * 2048 * 2, SZ_FFW = (size_t)8192 * 2048 * 2;
constexpr size_t W_SB_IN = 0;
constexpr size_t W_SB_OUT = W_SB_IN + 2 * SZ_QKVW;
constexpr size_t W_FOX_IN = W_SB_OUT + 2 * SZ_SQW;
constexpr size_t W_FOX_F = W_FOX_IN + SZ_QKVW;
constexpr size_t W_FOX_OUT = W_FOX_F + (size_t)128 * 2048 * 2;
constexpr size_t W_MLA_IN = W_FOX_OUT + SZ_SQW;
constexpr size_t W_MLA_UQ = W_MLA_IN + (size_t)1536 * 2048 * 2;
constexpr size_t W_MLA_UKV = W_MLA_UQ + (size_t)3072 * 768 * 2;
constexpr size_t W_MLA_OUT = W_MLA_UKV + (size_t)4096 * 512 * 2;
constexpr size_t W_W1 = W_MLA_OUT + SZ_SQW;
constexpr size_t W_W2 = W_W1 + 4 * SZ_FFW;
constexpr size_t WS_X = W_W2 + 4 * SZ_FFW;
constexpr size_t WS_H = WS_X + (size_t)NTOK * DM * 4;
constexpr size_t WS_AO = WS_H + (size_t)NTOK * DM * 2;
constexpr size_t WS_LOGF = WS_AO + (size_t)NTOK * DM * 2;
constexpr size_t WS_CF = WS_LOGF + (size_t)NTOK * 16 * 4;
constexpr size_t WS_ROPE = WS_CF + (size_t)64 * 2048 * 4;
constexpr size_t WS_KR = WS_ROPE + (size_t)NTOK * 64 * 4;
constexpr size_t WS_SCR = WS_KR + (size_t)NTOK * 64 * 4;
constexpr size_t SC_Q = 0, SC_K = (size_t)NTOK * DM * 2, SC_V = 2 * (size_t)NTOK * DM * 2;
constexpr size_t SC_DOWN = 0;
constexpr size_t SC_CQ = SC_DOWN + (size_t)NTOK * MLA_DOWN_PAD * 2;
constexpr size_t SC_CKV = SC_CQ + (size_t)NTOK * MLA_QR * 2;
constexpr size_t SC_QUP = SC_CKV + (size_t)NTOK * MLA_KVR * 2;
constexpr size_t SC_KV = SC_QUP + (size_t)NTOK * 3072 * 2;
constexpr size_t SC_QN = SC_KV + (size_t)NTOK * 4096 * 2;
constexpr size_t SC_KN = SC_QN + (size_t)NTOK * 3072 * 2;
constexpr size_t SC_END = SC_KN + (size_t)NTOK * 3072 * 2;
constexpr size_t WS_BAR = WS_SCR + SC_END;
constexpr size_t WS_SS = WS_BAR + 16384;
constexpr size_t WS_END = WS_SS + (size_t)8 * NTOK * 8 * 4;

constexpr int LDS_BYTES = 131072 + 16 + 2048;

struct Params {
    const float* x; const int* pos; const float* mix_norm; const float* mlp_norm;
    const float* sb_w_in; const float* sb_w_out; const float* fox_w_in; const float* fox_b_f; const float* fox_q_gain; const float* fox_k_gain; const float* fox_w_out;
    const float* mla_w_in; const float* mla_q_norm; const float* mla_kv_norm; const float* mla_w_uq; const float* mla_w_ukv; const float* mla_q_gain; const float* mla_k_gain; const float* mla_w_out;
    const float* mlp_w1; const float* mlp_w2;
    float* out; unsigned char* ws;
    long long ph_lo, ph_hi, alt;
};

__device__ __forceinline__ unsigned cvtpk(float lo, float hi) { unsigned r; asm volatile("v_cvt_pk_bf16_f32 %0, %1, %2" : "=v"(r) : "v"(lo), "v"(hi)); return r; }
__device__ __forceinline__ float bflo(unsigned w) { return __uint_as_float(w << 16); }
__device__ __forceinline__ float bfhi(unsigned w) { return __uint_as_float(w & 0xffff0000u); }
__device__ __forceinline__ int opq(int x) { asm volatile("" : "+v"(x)); return x; }
__device__ __forceinline__ float wave_sum(float v) {
#pragma unroll
    for (int o = 32; o > 0; o >>= 1) v += __shfl_xor(v, o);
    return v;
}
__device__ __forceinline__ float sum16(float v) {
#pragma unroll
    for (int o = 8; o > 0; o >>= 1) v += __shfl_xor(v, o);
    return v;
}

namespace pg8 {
constexpr int BM = 256, BK = 64, HALF = 128, HTB = HALF * BK * 2, STAGE_BYTES = 8 * HTB, NXCD = 8, WGM = 8;
__host__ __device__ __forceinline__ int lds_byte(int r, int c) { const int st = (r >> 4) * 2 + (c >> 5), rr = r & 15, cc = c & 31, ob = rr * 64 + cc * 2; return st * 1024 + (ob ^ (((ob >> 9) & 1) << 5)); }
__host__ __device__ __forceinline__ void stage_rc(int b, int& R, int& C) { const int st = b / 1024, sb = b % 1024, swz = sb ^ (((sb >> 9) & 1) << 5); R = (st >> 1) * 16 + swz / 64; C = (st & 1) * 32 + (swz % 64) / 2; }
__host__ __device__ __forceinline__ int perm32(int rho) { const int n = rho >> 4, i = rho & 15; return 8 * (i >> 2) + 4 * n + (i & 3); }
struct Unit { int pm, pn; };
struct Gemm { const bf16_t* A; const bf16_t* Bt; int M, N, K; };
struct StaticOrder {
    int nM, nN, nwg, G, c;
    __device__ void init(int M, int N, int G_, int c_) { nM = M / BM; nN = N / BM; nwg = nM * nN; G = G_; c = c_; }
    __device__ bool next(int i, Unit& u) const {
        const long L = (long)i * G + c; if (L >= nwg) return false;
        int wgid = (int)L; { const int q = nwg / NXCD, r = nwg % NXCD, xcd = wgid % NXCD, off = wgid / NXCD; wgid = (xcd < r ? xcd * (q + 1) : r * (q + 1) + (xcd - r) * q) + off; }
        const int nig = WGM * nN, gid = wgid / nig, fm = gid * WGM, gsz = (nM - fm) < WGM ? (nM - fm) : WGM;
        u.pm = fm + ((wgid % nig) % gsz); u.pn = (wgid % nig) / gsz; return true;
    }
};
__device__ __forceinline__ float rstd_of(const float* ss, int row) {
    const f32x4 a = *(const f32x4*)(ss + (size_t)row * 8), b = *(const f32x4*)(ss + (size_t)row * 8 + 4);
    return rsqrtf((((a[0] + a[1]) + (a[2] + a[3])) + ((b[0] + b[1]) + (b[2] + b[3]))) * (1.f / DM) + EPS);
}
struct EpiGen {
    int mode; bf16_t* O; int ldc; int split_cols; size_t split_stride; const float* R; float* C;
    const float* SSc;
    bf16_t* Hn; const float* gn; float* SSn;
    __device__ __forceinline__ void operator()(const f32x4 (&acc)[2][2][4][2], const Unit& u, int wr, int wc, int fr, int fq, LAS unsigned char* lds) const {
        const int row0 = u.pm * BM + wr * 64 + fr;
        if (mode == 2) {
            const int col0 = u.pn * BM + wc * 32 + 8 * fq;
            LAS float* ex = (LAS float*)(lds + 131072 + 16) + wr * 256;
            f32x4 gv[2][2];
            if (Hn) {
#pragma unroll
                for (int bj = 0; bj < 2; ++bj) { gv[bj][0] = *(const f32x4*)(gn + col0 + bj * HALF); gv[bj][1] = *(const f32x4*)(gn + col0 + bj * HALF + 4); } }
#pragma unroll
            for (int ai = 0; ai < 2; ++ai) {
                float ssq[4];
#pragma unroll
                for (int mp = 0; mp < 2; ++mp) {
                    f32x4 rv[2][2][2];
#pragma unroll
                    for (int mm = 0; mm < 2; ++mm) { const size_t ro = (size_t)(row0 + ai * HALF + (2 * mp + mm) * 16) * ldc + col0;
#pragma unroll
                        for (int bj = 0; bj < 2; ++bj) { rv[mm][bj][0] = *(const f32x4*)(R + ro + bj * HALF); rv[mm][bj][1] = *(const f32x4*)(R + ro + bj * HALF + 4); } }
#pragma unroll
                    for (int mm = 0; mm < 2; ++mm) { const int m = 2 * mp + mm; const size_t ro = (size_t)(row0 + ai * HALF + m * 16) * ldc + col0; ssq[m] = 0.f;
#pragma unroll
                        for (int bj = 0; bj < 2; ++bj) { const f32x4 x0 = acc[ai][bj][m][0] + rv[mm][bj][0], x1 = acc[ai][bj][m][1] + rv[mm][bj][1];
                            *(f32x4*)(C + ro + bj * HALF) = x0; *(f32x4*)(C + ro + bj * HALF + 4) = x1;
                            if (Hn) { ssq[m] += (x0[0] * x0[0] + x0[1] * x0[1]) + (x0[2] * x0[2] + x0[3] * x0[3]) + (x1[0] * x1[0] + x1[1] * x1[1]) + (x1[2] * x1[2] + x1[3] * x1[3]);
                                u32x4 hw; hw.x = cvtpk(x0[0] * gv[bj][0][0], x0[1] * gv[bj][0][1]); hw.y = cvtpk(x0[2] * gv[bj][0][2], x0[3] * gv[bj][0][3]);
                                hw.z = cvtpk(x1[0] * gv[bj][1][0], x1[1] * gv[bj][1][1]); hw.w = cvtpk(x1[2] * gv[bj][1][2], x1[3] * gv[bj][1][3]);
                                *(u32x4*)(Hn + ro + bj * HALF) = hw; } } }
                }
                if (Hn) {
#pragma unroll
                    for (int m = 0; m < 4; ++m) { float t = ssq[m]; t += __shfl_xor(t, 16); t += __shfl_xor(t, 32); if (fq == 0) ex[(ai * 0 + m * 16 + fr) * 4 + wc] = t; }
                    asm volatile("s_waitcnt lgkmcnt(0)\n\ts_barrier" ::: "memory");
                    if (wc == 0 && fq == 0) {
#pragma unroll
                        for (int m = 0; m < 4; ++m) { const f32x4 q = *(const LAS f32x4*)(ex + (m * 16 + fr) * 4); SSn[(size_t)(row0 + ai * HALF + m * 16) * 8 + u.pn] = (q[0] + q[1]) + (q[2] + q[3]); } }
                    asm volatile("s_waitcnt lgkmcnt(0)\n\ts_barrier" ::: "memory");
                }
            }
        } else {
            int colt = u.pn * BM; bf16_t* base = O;
            if (split_cols) { const int t = colt / split_cols; base += (size_t)t * split_stride; colt -= t * split_cols; }
            const int col0 = colt + wc * 32 + 8 * fq; const bool act = mode == 1;
#pragma unroll
            for (int ai = 0; ai < 2; ++ai)
#pragma unroll
                for (int m = 0; m < 4; ++m) { bf16_t* rowp = base + (size_t)(row0 + ai * HALF + m * 16) * ldc + col0;
                    const float rs = SSc ? rstd_of(SSc, row0 + ai * HALF + m * 16) : 1.f;
#pragma unroll
                    for (int bj = 0; bj < 2; ++bj) { f32x4 v0 = acc[ai][bj][m][0] * rs, v1 = acc[ai][bj][m][1] * rs;
                        if (act) {
#pragma unroll
                            for (int j = 0; j < 4; ++j) { float x = fmaxf(v0[j], 0.f), y = fmaxf(v1[j], 0.f); v0[j] = x * x; v1[j] = y * y; } }
                        u32x4 w; w.x = cvtpk(v0[0], v0[1]); w.y = cvtpk(v0[2], v0[3]); w.z = cvtpk(v1[0], v1[1]); w.w = cvtpk(v1[2], v1[3]);
                        *(u32x4*)(rowp + bj * HALF) = w; } }
        }
    }
};

template <class Epi, class Sched>
__device__ __forceinline__ void gemm_phase(LAS unsigned char* lds, const Gemm g, const Sched& S, const Epi& E) {
    const int tid = opq(threadIdx.x), wid = __builtin_amdgcn_readfirstlane(tid >> 6), lane = tid & 63, wr = wid >> 2, wc = wid & 3, fr = lane & 15, fq = lane >> 4;
    const int K = g.K, nt = K / BK;
    unsigned voffA[2], voffB[2];
#pragma unroll
    for (int i = 0; i < 2; ++i) { int R, C; stage_rc(tid * 16 + i * 8192, R, C); const int Rb = (R & ~31) + perm32(R & 31);
        voffA[i] = (unsigned)(R * K + C) * 2u; voffB[i] = (unsigned)(Rb * K + C) * 2u; }
    const size_t kstep = (size_t)(BK * 2);
    const size_t hstep = (size_t)HALF * K * 2;
    const size_t tstep = 2 * hstep;
    const unsigned ldsw = (unsigned)wid * 1024u;
    const int aoff = lds_byte(wr * 64 + fr, fq * 8), boff = lds_byte(wc * 32 + fr, fq * 8);
#define PG8_SA(b, h) (((b) * 2 + (h)) * HTB)
#define PG8_SB(b, h) ((4 + (b) * 2 + (h)) * HTB)
#define PG8_STAGE(bufoff, gbase, voff) do { _Pragma("unroll") for (int _i = 0; _i < 2; ++_i) \
        __builtin_amdgcn_global_load_lds((const unsigned*)((const char*)(gbase) + (voff)[_i]), (LAS unsigned*)(lds + (bufoff) + ldsw + _i * 8192), 16, 0, 0); } while (0)
#define PG8_LDA(dst, b, h) do { _Pragma("unroll") for (int m = 0; m < 4; ++m) _Pragma("unroll") for (int k = 0; k < 2; ++k) dst[m][k] = *(const LAS bf16x8*)(lds + PG8_SA(b, h) + aoff + m * 2048 + k * 1024); } while (0)
#define PG8_LDB(dst, b, h) do { _Pragma("unroll") for (int n = 0; n < 2; ++n) _Pragma("unroll") for (int k = 0; k < 2; ++k) dst[n][k] = *(const LAS bf16x8*)(lds + PG8_SB(b, h) + boff + n * 2048 + k * 1024); } while (0)
#define PG8_MMA(ai, bj, At, Bt) do { __builtin_amdgcn_s_setprio(1); _Pragma("unroll") for (int m = 0; m < 4; ++m) _Pragma("unroll") for (int n = 0; n < 2; ++n) _Pragma("unroll") for (int k = 0; k < 2; ++k) \
        acc[ai][bj][m][n] = __builtin_amdgcn_mfma_f32_16x16x32_bf16(Bt[n][k], At[m][k], acc[ai][bj][m][n], 0, 0, 0); __builtin_amdgcn_s_setprio(0); } while (0)
#define PG8_WAIT_V(n) asm volatile("s_waitcnt vmcnt(" #n ")" ::: "memory")
#define PG8_WAIT_L(n) asm volatile("s_waitcnt lgkmcnt(" #n ")" ::: "memory")
#define PG8_BAR __builtin_amdgcn_s_barrier()
#define PG8_SCHED __builtin_amdgcn_sched_barrier(0)
    Unit cur, nxt; int ui = 0;
    if (!S.next(0, cur)) return;
    f32x4 acc[2][2][4][2];
#pragma unroll
    for (int a = 0; a < 2; ++a)
#pragma unroll
        for (int b = 0; b < 2; ++b)
#pragma unroll
            for (int m = 0; m < 4; ++m)
#pragma unroll
                for (int n = 0; n < 2; ++n) acc[a][b][m][n] = (f32x4){0.f, 0.f, 0.f, 0.f};
    bf16x8 At[4][2], B0[2][2], B1[2][2];
    const char* cA = (const char*)g.A + (size_t)cur.pm * tstep; const char* cB = (const char*)g.Bt + (size_t)cur.pn * tstep;
    PG8_STAGE(PG8_SB(0, 0), cB, voffB); PG8_STAGE(PG8_SA(0, 0), cA, voffA); PG8_STAGE(PG8_SB(0, 1), cB + hstep, voffB); PG8_STAGE(PG8_SA(0, 1), cA + hstep, voffA);
    if (wr == 1) PG8_BAR;
    PG8_WAIT_V(4); PG8_BAR;
    PG8_STAGE(PG8_SB(1, 0), cB + kstep, voffB); PG8_STAGE(PG8_SA(1, 0), cA + kstep, voffA); PG8_STAGE(PG8_SB(1, 1), cB + hstep + kstep, voffB);
    PG8_WAIT_V(6); PG8_BAR;
    for (;;) {
        const bool has_next = S.next(ui + 1, nxt);
        const char* nA = has_next ? (const char*)g.A + (size_t)nxt.pm * tstep : cA; const char* nB = has_next ? (const char*)g.Bt + (size_t)nxt.pn * tstep : cB;
        for (int t = 0; t < nt; t += 2) {
            const bool last = (t == nt - 2);
            const char* a1 = cA + (size_t)(t + 1) * kstep;
            const char* a2 = last ? nA : cA + (size_t)(t + 2) * kstep; const char* b2 = last ? nB : cB + (size_t)(t + 2) * kstep;
            const char* a3 = a2 + kstep; const char* b3 = b2 + kstep;
            PG8_LDB(B0, 0, 0); PG8_SCHED; PG8_LDA(At, 0, 0); PG8_STAGE(PG8_SA(1, 1), a1 + hstep, voffA);
            PG8_WAIT_L(8); PG8_BAR; PG8_WAIT_L(0); PG8_MMA(0, 0, At, B0); PG8_BAR; PG8_SCHED;
            PG8_LDB(B1, 0, 1); PG8_STAGE(PG8_SB(0, 0), b2, voffB);
            PG8_BAR; PG8_WAIT_L(0); PG8_MMA(0, 1, At, B1); PG8_BAR;
            PG8_LDA(At, 0, 1); PG8_STAGE(PG8_SA(0, 0), a2, voffA);
            PG8_BAR; PG8_WAIT_L(0); PG8_MMA(1, 0, At, B0); PG8_BAR; PG8_SCHED;
            PG8_STAGE(PG8_SB(0, 1), b2 + hstep, voffB);
            PG8_WAIT_V(6); PG8_BAR; PG8_MMA(1, 1, At, B1); PG8_BAR;
            PG8_LDB(B0, 1, 0); PG8_SCHED; PG8_LDA(At, 1, 0); PG8_STAGE(PG8_SA(0, 1), a2 + hstep, voffA);
            PG8_WAIT_L(8); PG8_BAR; PG8_WAIT_L(0); PG8_MMA(0, 0, At, B0); PG8_BAR; PG8_SCHED;
            PG8_LDB(B1, 1, 1); PG8_STAGE(PG8_SB(1, 0), b3, voffB);
            PG8_BAR; PG8_WAIT_L(0); PG8_MMA(0, 1, At, B1); PG8_BAR;
            PG8_LDA(At, 1, 1); PG8_STAGE(PG8_SA(1, 0), a3, voffA);
            PG8_BAR; PG8_WAIT_L(0); PG8_MMA(1, 0, At, B0); PG8_BAR; PG8_SCHED;
            PG8_STAGE(PG8_SB(1, 1), b3 + hstep, voffB);
            PG8_WAIT_V(6); PG8_BAR; PG8_MMA(1, 1, At, B1); PG8_BAR;
        }
        E(acc, cur, wr, wc, fr, fq, lds);
        if (!has_next) break;
#pragma unroll
        for (int a = 0; a < 2; ++a)
#pragma unroll
            for (int b = 0; b < 2; ++b)
#pragma unroll
                for (int m = 0; m < 4; ++m)
#pragma unroll
                    for (int n = 0; n < 2; ++n) acc[a][b][m][n] = (f32x4){0.f, 0.f, 0.f, 0.f};
        cur = nxt; cA = nA; cB = nB; ++ui;
    }
    PG8_WAIT_V(0);
    if (wr == 0) PG8_BAR;
    PG8_BAR;
#undef PG8_SA
#undef PG8_SB
#undef PG8_STAGE
#undef PG8_LDA
#undef PG8_LDB
#undef PG8_MMA
#undef PG8_WAIT_V
#undef PG8_WAIT_L
#undef PG8_BAR
#undef PG8_SCHED
}
}

struct GemmJob { const bf16_t* A; const bf16_t* Bt; int M, N, K; pg8::EpiGen E; };
__device__ __forceinline__ void run_gemm(LAS unsigned char* lds, const GemmJob& j) {
    pg8::Gemm g{j.A, j.Bt, j.M, j.N, j.K};
    pg8::StaticOrder S; S.init(j.M, j.N, (int)gridDim.x, (int)blockIdx.x);
    pg8::gemm_phase<pg8::EpiGen, pg8::StaticOrder>(lds, g, S, j.E);
    __syncthreads();
}

__device__ __forceinline__ void conv_job(LAS unsigned char* lds, const float* __restrict__ src, int ldn, int col0, int ncols, int npad, int K, bf16_t* __restrict__ dst) {
    constexpr int LR = 132;
    LAS float* T = (LAS float*)lds;
    const int tid = opq(threadIdx.x), n4 = tid & 31, kr = tid >> 5;
    const int rn = tid & 127, rk = tid >> 7;
    const int ntn = npad / 128, ntk = K / 128, ntiles = ntn * ntk;
    f32x4 r[8];
    int t = blockIdx.x;
#define CONV_LOAD(tt_) do { const int tn_ = (tt_) % ntn, tk_ = (tt_) / ntn; const int n_ = tn_ * 128 + n4 * 4; const bool ok_ = n_ < ncols; \
        const float* p_ = src + (size_t)(tk_ * 128 + kr) * ldn + col0 + (ok_ ? n_ : 0); \
        _Pragma("unroll") for (int j_ = 0; j_ < 8; ++j_) { r[j_] = *(const f32x4*)(p_ + (size_t)(16 * j_) * ldn); if (!ok_) r[j_] = (f32x4){0.f, 0.f, 0.f, 0.f}; } } while (0)
    if (t < ntiles) CONV_LOAD(t);
    for (; t < ntiles; t += gridDim.x) {
        const int tn = t % ntn, tk = t / ntn;
#pragma unroll
        for (int j = 0; j < 8; ++j) *(LAS f32x4*)(T + (kr + 16 * j) * LR + n4 * 4) = r[j];
        if (t + (int)gridDim.x < ntiles) CONV_LOAD(t + (int)gridDim.x);
        __syncthreads();
#pragma unroll
        for (int j = 0; j < 4; ++j) { const int kc = rk + 4 * j; float v[8];
#pragma unroll
            for (int i = 0; i < 8; ++i) v[i] = T[(kc * 8 + i) * LR + rn];
            u32x4 w; w.x = cvtpk(v[0], v[1]); w.y = cvtpk(v[2], v[3]); w.z = cvtpk(v[4], v[5]); w.w = cvtpk(v[6], v[7]);
            *(u32x4*)(dst + (size_t)(tn * 128 + rn) * K + tk * 128 + kc * 8) = w; }
        __syncthreads();
    }
}

__device__ __forceinline__ void xprep_phase(const float* __restrict__ x, const float* __restrict__ g, bf16_t* __restrict__ h, float* __restrict__ ss0) {
    const int tid = opq(threadIdx.x), lane = tid & 63, gw = blockIdx.x * 8 + (tid >> 6), nw = gridDim.x * 8;
    for (int row = gw; row < NTOK; row += nw) {
        const float* xr = x + (size_t)row * DM; f32x4 v[8]; float ss = 0.f;
#pragma unroll
        for (int j = 0; j < 8; ++j) { v[j] = *(const f32x4*)(xr + j * 256 + lane * 4); ss += v[j][0] * v[j][0] + v[j][1] * v[j][1] + v[j][2] * v[j][2] + v[j][3] * v[j][3]; }
        ss = wave_sum(ss); if (lane < 8) ss0[(size_t)row * 8 + lane] = lane == 0 ? ss : 0.f;
#pragma unroll
        for (int j = 0; j < 8; ++j) { const f32x4 gv = *(const f32x4*)(g + j * 256 + lane * 4);
            u32x2 w; w.x = cvtpk(v[j][0] * gv[0], v[j][1] * gv[1]); w.y = cvtpk(v[j][2] * gv[2], v[j][3] * gv[3]);
            *(u32x2*)(h + (size_t)row * DM + j * 256 + lane * 4) = w; }
    }
}

__device__ __forceinline__ void fgate_phase(const bf16_t* __restrict__ h, const bf16_t* __restrict__ wft, const float* __restrict__ bfv, const float* __restrict__ ssc, float* __restrict__ logf) {
    const int tid = opq(threadIdx.x), lane = tid & 63, gw = blockIdx.x * 8 + (tid >> 6), nw = gridDim.x * 8;
    const int fr = lane & 15, fq = lane >> 4;
    if ((gw & 3) != 0) return;
    for (int job = gw >> 2; job < NTOK / 16; job += (nw >> 2)) {
        const bf16_t* ap = h + (size_t)(job * 16 + fr) * DM + fq * 8; const bf16_t* bp = wft + (size_t)fr * DM + fq * 8;
        f32x4 acc = {0.f, 0.f, 0.f, 0.f};
#pragma unroll 8
        for (int k = 0; k < DM; k += 32) { const bf16x8 a = *(const bf16x8*)(ap + k), b = *(const bf16x8*)(bp + k); acc = __builtin_amdgcn_mfma_f32_16x16x32_bf16(a, b, acc, 0, 0, 0); }
        const float bb = bfv[fr];
#pragma unroll
        for (int j = 0; j < 4; ++j) { const float u = acc[j] * pg8::rstd_of(ssc, job * 16 + fq * 4 + j) + bb; logf[(size_t)(job * 16 + fq * 4 + j) * 16 + fr] = -(fmaxf(-u, 0.f) + log1pf(__expf(-fabsf(u)))); }
    }
}

__device__ __forceinline__ void fox_prep_phase(bf16_t* __restrict__ qk  , const float* __restrict__ qg, const float* __restrict__ kg, const float* __restrict__ logf, float* __restrict__ cf) {
    const int tid = opq(threadIdx.x), lane = tid & 63, gw = blockIdx.x * 8 + (tid >> 6), nw = gridDim.x * 8;
    const int sub = lane >> 4, l16 = lane & 15;
    const int nrows = 2 * NTOK * NH;
    for (int r0 = gw * 4; r0 < nrows; r0 += nw * 16) {
        u32x4 w[4];
#pragma unroll
        for (int q = 0; q < 4; ++q) { const int row = r0 + q * nw * 4 + sub; if (row < nrows) w[q] = *(const u32x4*)(qk + (size_t)row * HD + l16 * 8); }
#pragma unroll
        for (int q = 0; q < 4; ++q) { const int row = r0 + q * nw * 4 + sub; if (row < nrows) {
            const bool isk = row >= NTOK * NH; bf16_t* p = qk + (size_t)row * HD + l16 * 8;
            float v[8] = {bflo(w[q].x), bfhi(w[q].x), bflo(w[q].y), bfhi(w[q].y), bflo(w[q].z), bfhi(w[q].z), bflo(w[q].w), bfhi(w[q].w)};
            float ss = 0.f;
#pragma unroll
            for (int i = 0; i < 8; ++i) ss += v[i] * v[i];
            ss = sum16(ss); const float rs = rsqrtf(ss * (1.f / HD) + EPS);
            const float* gp = (isk ? kg : qg) + l16 * 8; const f32x4 g0 = *(const f32x4*)gp, g1 = *(const f32x4*)(gp + 4);
            u32x4 o; o.x = cvtpk(v[0] * rs * g0[0], v[1] * rs * g0[1]); o.y = cvtpk(v[2] * rs * g0[2], v[3] * rs * g0[3]);
            o.z = cvtpk(v[4] * rs * g1[0], v[5] * rs * g1[1]); o.w = cvtpk(v[6] * rs * g1[2], v[7] * rs * g1[3]);
            *(u32x4*)p = o; } }
    }
    for (int bh = blockIdx.x; bh < 64; bh += gridDim.x) {
        if ((threadIdx.x >> 6) != 0) continue;
        const int b = bh >> 4, hd = bh & 15; const float* lp = logf + (size_t)(b * SEQ + lane * 32) * 16 + hd;
        float v[32]; float tot = 0.f;
#pragma unroll
        for (int i = 0; i < 32; ++i) { tot += lp[(size_t)i * 16]; v[i] = tot; }
        float inc = tot;
#pragma unroll
        for (int o = 1; o < 64; o <<= 1) { const float up = __shfl_up(inc, o); if (lane >= o) inc += up; }
        const float base = inc - tot;
        float* cp = cf + (size_t)bh * SEQ + lane * 32;
#pragma unroll
        for (int i = 0; i < 32; ++i) cp[i] = base + v[i];
    }
}

__device__ __forceinline__ void mla_prep1_phase(const bf16_t* __restrict__ down, const int* __restrict__ pos, const float* __restrict__ qn, const float* __restrict__ kvn,
                                                bf16_t* __restrict__ cq, bf16_t* __restrict__ ckv, float* __restrict__ ropet, float* __restrict__ kr) {
    const int tid = opq(threadIdx.x), lane = tid & 63, gw = blockIdx.x * 8 + (tid >> 6), nw = gridDim.x * 8;
    for (int row = gw; row < NTOK; row += nw) {
        const bf16_t* dr = down + (size_t)row * MLA_DOWN_PAD;
        {   float v[12]; float ss = 0.f;
#pragma unroll
            for (int j = 0; j < 3; ++j) { const u32x2 w = *(const u32x2*)(dr + j * 256 + lane * 4); v[4 * j] = bflo(w.x); v[4 * j + 1] = bfhi(w.x); v[4 * j + 2] = bflo(w.y); v[4 * j + 3] = bfhi(w.y); }
#pragma unroll
            for (int i = 0; i < 12; ++i) ss += v[i] * v[i];
            ss = wave_sum(ss); const float rs = rsqrtf(ss * (1.f / MLA_QR) + EPS);
#pragma unroll
            for (int j = 0; j < 3; ++j) { const f32x4 g = *(const f32x4*)(qn + j * 256 + lane * 4);
                u32x2 w; w.x = cvtpk(v[4 * j] * rs * g[0], v[4 * j + 1] * rs * g[1]); w.y = cvtpk(v[4 * j + 2] * rs * g[2], v[4 * j + 3] * rs * g[3]);
                *(u32x2*)(cq + (size_t)row * MLA_QR + j * 256 + lane * 4) = w; } }
        {   float v[8]; float ss = 0.f;
#pragma unroll
            for (int j = 0; j < 2; ++j) { const u32x2 w = *(const u32x2*)(dr + MLA_QR + j * 256 + lane * 4); v[4 * j] = bflo(w.x); v[4 * j + 1] = bfhi(w.x); v[4 * j + 2] = bflo(w.y); v[4 * j + 3] = bfhi(w.y); }
#pragma unroll
            for (int i = 0; i < 8; ++i) ss += v[i] * v[i];
            ss = wave_sum(ss); const float rs = rsqrtf(ss * (1.f / MLA_KVR) + EPS);
#pragma unroll
            for (int j = 0; j < 2; ++j) { const f32x4 g = *(const f32x4*)(kvn + j * 256 + lane * 4);
                u32x2 w; w.x = cvtpk(v[4 * j] * rs * g[0], v[4 * j + 1] * rs * g[1]); w.y = cvtpk(v[4 * j + 2] * rs * g[2], v[4 * j + 3] * rs * g[3]);
                *(u32x2*)(ckv + (size_t)row * MLA_KVR + j * 256 + lane * 4) = w; } }
        if (lane < 32) {
            const float invf = powf(10000.0f, -(float)(2 * lane) / 64.0f);
            const float ang = (float)pos[row] * invf; const float cs = cosf(ang), sn = sinf(ang);
            ropet[(size_t)row * 64 + lane] = cs; ropet[(size_t)row * 64 + 32 + lane] = sn;
            const float x1 = __uint_as_float((unsigned)dr[MLA_QR + MLA_KVR + lane] << 16), x2 = __uint_as_float((unsigned)dr[MLA_QR + MLA_KVR + 32 + lane] << 16);
            kr[(size_t)row * 64 + lane] = x1 * cs - x2 * sn; kr[(size_t)row * 64 + 32 + lane] = x1 * sn + x2 * cs;
        }
    }
}

__device__ __forceinline__ void mla_prep2_phase(const bf16_t* __restrict__ qup, const bf16_t* __restrict__ kv, const float* __restrict__ ropet, const float* __restrict__ kr,
                                                const float* __restrict__ qg, const float* __restrict__ kg, bf16_t* __restrict__ Qn, bf16_t* __restrict__ Kn) {
    const int tid = opq(threadIdx.x), lane = tid & 63, gw = blockIdx.x * 8 + (tid >> 6), nw = gridDim.x * 8;
    const int sub = lane >> 4, j = lane & 15;
    const int nrows = 2 * NTOK * NH;
#pragma unroll 4
    for (int r0 = gw * 4; r0 < nrows; r0 += nw * 4) {
        int row = r0 + sub; const bool isk = row >= NTOK * NH; if (isk) row -= NTOK * NH;
        const int tok = row >> 4, hd = row & 15;
        float v[8], ra[2], rb[2];
        if (!isk) {
            const bf16_t* p = qup + (size_t)tok * 3072 + hd * 192;
            const u32x4 w = *(const u32x4*)(p + j * 8);
            v[0] = bflo(w.x); v[1] = bfhi(w.x); v[2] = bflo(w.y); v[3] = bfhi(w.y); v[4] = bflo(w.z); v[5] = bfhi(w.z); v[6] = bflo(w.w); v[7] = bfhi(w.w);
            const unsigned w1 = *(const unsigned*)(p + 128 + 2 * j), w2 = *(const unsigned*)(p + 160 + 2 * j);
            const float x1a = bflo(w1), x1b = bfhi(w1), x2a = bflo(w2), x2b = bfhi(w2);
            const float* rt = ropet + (size_t)tok * 64; const float c0 = rt[2 * j], c1 = rt[2 * j + 1], s0 = rt[32 + 2 * j], s1 = rt[32 + 2 * j + 1];
            ra[0] = x1a * c0 - x2a * s0; ra[1] = x1b * c1 - x2b * s1; rb[0] = x1a * s0 + x2a * c0; rb[1] = x1b * s1 + x2b * c1;
        } else {
            const bf16_t* p = kv + (size_t)tok * 4096 + hd * 256;
            const u32x4 w = *(const u32x4*)(p + j * 8);
            v[0] = bflo(w.x); v[1] = bfhi(w.x); v[2] = bflo(w.y); v[3] = bfhi(w.y); v[4] = bflo(w.z); v[5] = bfhi(w.z); v[6] = bflo(w.w); v[7] = bfhi(w.w);
            const float* kp = kr + (size_t)tok * 64; ra[0] = kp[2 * j]; ra[1] = kp[2 * j + 1]; rb[0] = kp[32 + 2 * j]; rb[1] = kp[32 + 2 * j + 1];
        }
        float ss = ra[0] * ra[0] + ra[1] * ra[1] + rb[0] * rb[0] + rb[1] * rb[1];
#pragma unroll
        for (int i = 0; i < 8; ++i) ss += v[i] * v[i];
        ss = sum16(ss); const float rs = rsqrtf(ss * (1.f / MLA_QK) + EPS);
        const float* g = isk ? kg : qg; const f32x4 g0 = *(const f32x4*)(g + j * 8), g1 = *(const f32x4*)(g + j * 8 + 4);
        bf16_t* o = (isk ? Kn : Qn) + (size_t)tok * 3072 + hd * 192;
        u32x4 ow; ow.x = cvtpk(v[0] * rs * g0[0], v[1] * rs * g0[1]); ow.y = cvtpk(v[2] * rs * g0[2], v[3] * rs * g0[3]);
        ow.z = cvtpk(v[4] * rs * g1[0], v[5] * rs * g1[1]); ow.w = cvtpk(v[6] * rs * g1[2], v[7] * rs * g1[3]);
        *(u32x4*)(o + j * 8) = ow;
        *(unsigned*)(o + 128 + 2 * j) = cvtpk(ra[0] * rs * g[128 + 2 * j], ra[1] * rs * g[128 + 2 * j + 1]);
        *(unsigned*)(o + 160 + 2 * j) = cvtpk(rb[0] * rs * g[160 + 2 * j], rb[1] * rs * g[160 + 2 * j + 1]);
    }
}

__device__ __forceinline__ int v_st(int k, int c) { const int kk = (k & ~0xC) | ((k & 4) << 1) | ((k & 8) >> 1); return ((kk >> 3) * 4 + (c >> 5)) * 512 + ((kk & 7) * 32 + (c & 31)) * 2; }
__device__ __forceinline__ int v_rd_base(int lane) { return ((lane & 3) << 3) | (((lane >> 2) & 3) << 6) | (((lane >> 4) & 1) << 5) | (((lane >> 5) & 1) << 8); }
constexpr int v_rd_off(int d0, int ks, int half) { return d0 * 512 + ks * 4096 + half * 2048; }
__device__ __forceinline__ int crow(int r, int hi) { return (r & 3) + 8 * (r >> 2) + 4 * hi; }

constexpr int AT_SHM_V = 16384, AT_KBUF = 24576;
constexpr int AT_OFF_K = 3 * AT_SHM_V, AT_OFF_WS = AT_OFF_K + 3 * AT_KBUF, AT_OFF_CF = AT_OFF_K + 3 * 16384;

#ifdef TESTB
#define SB_LG(y) fmaxf(1.f - 0.5f * fabsf(y), 0.f)
#else
#define SB_LG(y) __builtin_amdgcn_logf(1.f + __builtin_amdgcn_exp2f(-fabsf(y)))
#endif
#ifndef SB_BLOCK_EXIT
#define SB_BLOCK_EXIT 0
#endif
template <int DQK, int MODE>
__device__ __forceinline__ void attn_block(const bf16_t* __restrict__ Qg, int ldq, const bf16_t* __restrict__ Kg, int ldk, const bf16_t* __restrict__ Vg, int ldv,
                                           bf16_t* __restrict__ Og, int ldo, int q0, float C2, LAS unsigned char* lds) {
    constexpr int NQ = DQK / 16, ROWB = DQK * 2, SHM_K = 64 * ROWB, NCH = DQK / 8, KCH = NCH / 8;
#define KSW(row) (DQK == 128 ? (((row) & 15) << 4) : ((((row) >> 1) & 7) << 4))
    const int tid = opq(threadIdx.x), wid = __builtin_amdgcn_readfirstlane(tid >> 6), lane = tid & 63, r32 = lane & 31, hi = lane >> 5;
    LAS unsigned char* V_lds = lds; LAS unsigned char* K_lds = lds + AT_OFF_K;
    LAS float* li_l = (LAS float*)(lds + AT_OFF_WS) + wid * 64; LAS float* al_l = li_l + 32;
    const LAS float* cfl = (const LAS float*)(lds + AT_OFF_CF);
    const int qlo = q0 + wid * 32, trow = qlo + r32;
    bf16x8 qr[NQ];
#pragma unroll
    for (int d0 = 0; d0 < NQ; ++d0) qr[d0] = *(const bf16x8*)(Qg + (size_t)trow * ldq + d0 * 16 + hi * 8);
    const int NT = q0 / 64 + 4;
    int kso[KCH], vso[2];
#pragma unroll
    for (int i = 0; i < KCH; ++i) { const int L = (i * 8 + wid) * 1024 + lane * 16, row = L / ROWB, wi = L % ROWB; kso[i] = row * ldk + ((wi ^ KSW(row)) >> 1); }
#pragma unroll
    for (int i = 0; i < 2; ++i) { const int L = (i * 8 + wid) * 1024 + lane * 16, sub = L >> 9, we = (L & 511) >> 1, kk = (sub >> 2) * 8 + (we >> 5), c = (sub & 3) * 32 + (we & 31);
        const int k = (kk & ~0xC) | ((kk & 4) << 1) | ((kk & 8) >> 1); vso[i] = k * ldv + c; }
#define AT_DMA(kb_, buf_) do { const bf16_t* kp_ = Kg + (size_t)(kb_) * ldk; const bf16_t* vp_ = Vg + (size_t)(kb_) * ldv; \
        _Pragma("unroll") for (int i_ = 0; i_ < KCH; ++i_) __builtin_amdgcn_global_load_lds((const unsigned*)(kp_ + kso[i_]), (LAS unsigned*)(K_lds + (buf_) * SHM_K + (i_ * 8 + wid) * 1024), 16, 0, 0); \
        _Pragma("unroll") for (int i_ = 0; i_ < 2; ++i_) __builtin_amdgcn_global_load_lds((const unsigned*)(vp_ + vso[i_]), (LAS unsigned*)(V_lds + (buf_) * AT_SHM_V + (i_ * 8 + wid) * 1024), 16, 0, 0); } while (0)
#if ATT_DMA
    constexpr int NDMA = KCH + 2;
    AT_DMA((NT - 1) * 64, 0);
    AT_DMA((NT - 2) * 64, 1);
    if (NDMA == 4) asm volatile("s_waitcnt vmcnt(4)\n\ts_waitcnt lgkmcnt(0)\n\ts_barrier" ::: "memory");
    else           asm volatile("s_waitcnt vmcnt(5)\n\ts_waitcnt lgkmcnt(0)\n\ts_barrier" ::: "memory");
#else
    bf16x8 stk[KCH], stv[2];
    const int vk = tid >> 4, vc = (tid & 15) * 8;
#define AT_LOAD(kb_) do { _Pragma("unroll") for (int i_ = 0; i_ < KCH; ++i_) { const int c_ = tid + 512 * i_, row_ = c_ / NCH, cc_ = c_ % NCH; stk[i_] = *(const bf16x8*)(Kg + (size_t)((kb_) + row_) * ldk + cc_ * 8); } \
        _Pragma("unroll") for (int i_ = 0; i_ < 2; ++i_) stv[i_] = *(const bf16x8*)(Vg + (size_t)((kb_) + vk + 32 * i_) * ldv + vc); } while (0)
#define AT_WRITE(buf_) do { _Pragma("unroll") for (int i_ = 0; i_ < KCH; ++i_) { const int c_ = tid + 512 * i_, row_ = c_ / NCH, cc_ = c_ % NCH; \
            *(LAS bf16x8*)(K_lds + (buf_) * SHM_K + row_ * ROWB + ((cc_ * 16) ^ KSW(row_))) = stk[i_]; } \
        _Pragma("unroll") for (int i_ = 0; i_ < 2; ++i_) *(LAS bf16x8*)(V_lds + (buf_) * AT_SHM_V + v_st(vk + 32 * i_, vc)) = stv[i_]; } while (0)
    AT_LOAD((NT - 1) * 64); AT_WRITE(0);
    if (NT > 1) AT_LOAD((NT - 2) * 64);
    __syncthreads();
#endif
    f32x16 o[4];
#pragma unroll
    for (int d = 0; d < 4; ++d)
#pragma unroll
        for (int r = 0; r < 16; ++r) o[d][r] = 0.f;
    float m_reg = -1e30f, l_reg = 0.f, carry = 0.f;
    float cft = 0.f; if (MODE == 1) cft = cfl[trow];
    int koff[4];
#pragma unroll
    for (int dd = 0; dd < 4; ++dd) koff[dd] = r32 * ROWB + ((dd * 32 + hi * 16) ^ (KSW(r32) & 0x70));
    const int kx7 = KSW(r32) & 0x80;
    const int vbase = (int)(uintptr_t)V_lds + v_rd_base(lane);
    bool wdone = false;
    LAS unsigned* dflag = (LAS unsigned*)(lds + AT_OFF_CF);
    for (int it = 0; it < NT; ++it) {
        const int kb = (NT - 1 - it) * 64;
#if ATT_DMA
        const int cur = it % 3;
#else
        const int cur = it & 1;
#endif
        bool alld = false;
        if (MODE == 0 && it > 0) {
            const LAS unsigned* fp = dflag + ((it - 1) & 1) * 8; const u32x4 f0 = *(const LAS u32x4*)fp, f1 = *(const LAS u32x4*)(fp + 4);
            alld = __builtin_amdgcn_readfirstlane(f0.x & f0.y & f0.z & f0.w & f1.x & f1.y & f1.z & f1.w) != 0u;
        }
        const bool act = (kb <= qlo + 31) && !wdone;
#if ATT_DMA
        const bool issued = (it + 2 < NT) && !alld;
        if (issued) AT_DMA(kb - 128, (it + 2) % 3);
#endif
        if (act) {
            f32x16 p0, p1;
#pragma unroll
            for (int r = 0; r < 16; ++r) { p0[r] = 0.f; p1[r] = 0.f; }
            const LAS unsigned char* kbase = K_lds + cur * SHM_K;
#pragma unroll
            for (int dg = 0; dg < NQ / 4; ++dg) {
                bf16x8 kf0[4], kf1[4];
#pragma unroll
                for (int dd = 0; dd < 4; ++dd) { const LAS unsigned char* a = kbase + koff[dd] + ((dg * 128) ^ kx7); kf0[dd] = *(const LAS bf16x8*)a; kf1[dd] = *(const LAS bf16x8*)(a + 32 * ROWB); }
#pragma unroll
                for (int dd = 0; dd < 4; ++dd) { p0 = __builtin_amdgcn_mfma_f32_32x32x16_bf16(kf0[dd], qr[dg * 4 + dd], p0, 0, 0, 0); p1 = __builtin_amdgcn_mfma_f32_32x32x16_bf16(kf1[dd], qr[dg * 4 + dd], p1, 0, 0, 0); }
                __builtin_amdgcn_sched_barrier(0);
            }
            const int dq = trow - kb - 4 * hi;
            if (MODE == 0) {
                const bool needm = kb + 63 >= qlo;
                f32x16 lkA, lkB;
#pragma unroll
                for (int r = 0; r < 16; ++r) { p0[r] *= C2; p1[r] *= C2; }
#pragma unroll
                for (int r = 0; r < 16; ++r) { lkA[r] = __builtin_amdgcn_exp2f(-fabsf(p0[r])); lkB[r] = __builtin_amdgcn_exp2f(-fabsf(p1[r])); }
                __builtin_amdgcn_sched_barrier(0);
#pragma unroll
                for (int r = 0; r < 16; ++r) { lkA[r] += 1.f; lkB[r] += 1.f; }
                __builtin_amdgcn_sched_barrier(0);
#pragma unroll
                for (int r = 0; r < 16; ++r) { lkA[r] = __builtin_amdgcn_logf(lkA[r]); lkB[r] = __builtin_amdgcn_logf(lkB[r]); }
                __builtin_amdgcn_sched_barrier(0);
#pragma unroll
                for (int r = 0; r < 16; ++r) { const int c = (r & 3) + 8 * (r >> 2);
                    { const float y = p0[r]; const float sp = fmaxf(y, 0.f) + lkA[r];
                      float lk = -sp, lb = y - sp; if (needm && !(c < dq)) { lk = 0.f; lb = -__builtin_inff(); } lkA[r] = lk; p0[r] = lb; }
                    { const float y = p1[r]; const float sp = fmaxf(y, 0.f) + lkB[r];
                      float lk = -sp, lb = y - sp; if (needm && !(c + 32 < dq)) { lk = 0.f; lb = -__builtin_inff(); } lkB[r] = lk; p1[r] = lb; } }
                __builtin_amdgcn_sched_barrier(0);
                float run = carry;
#pragma unroll
                for (int g = 7; g >= 0; --g) {
                    const float gs = (g < 4) ? (lkA[4 * g] + lkA[4 * g + 1]) + (lkA[4 * g + 2] + lkA[4 * g + 3]) : (lkB[4 * (g - 4)] + lkB[4 * (g - 4) + 1]) + (lkB[4 * (g - 4) + 2] + lkB[4 * (g - 4) + 3]);
                    auto rr = __builtin_amdgcn_permlane32_swap(__float_as_uint(gs), __float_as_uint(gs), false, false);
                    const float e = __uint_as_float(rr[0]), od = __uint_as_float(rr[1]);
                    const float base = run + (hi ? 0.f : od);
                    if (g < 4) { const int b = 4 * g; const float l3 = base, l2 = l3 + lkA[b + 3], l1 = l2 + lkA[b + 2], l0 = l1 + lkA[b + 1];
                        p0[b] = __builtin_amdgcn_exp2f(p0[b] + l0); p0[b + 1] = __builtin_amdgcn_exp2f(p0[b + 1] + l1); p0[b + 2] = __builtin_amdgcn_exp2f(p0[b + 2] + l2); p0[b + 3] = __builtin_amdgcn_exp2f(p0[b + 3] + l3); }
                    else { const int b = 4 * (g - 4); const float l3 = base, l2 = l3 + lkB[b + 3], l1 = l2 + lkB[b + 2], l0 = l1 + lkB[b + 1];
                        p1[b] = __builtin_amdgcn_exp2f(p1[b] + l0); p1[b + 1] = __builtin_amdgcn_exp2f(p1[b + 1] + l1); p1[b + 2] = __builtin_amdgcn_exp2f(p1[b + 2] + l2); p1[b + 3] = __builtin_amdgcn_exp2f(p1[b + 3] + l3); }
                    run += e + od;
                }
                carry = run;
                __builtin_amdgcn_sched_barrier(0);
            } else {
                if (MODE == 1) {
#pragma unroll
                    for (int g = 0; g < 4; ++g) { const f32x4 c0 = *(const LAS f32x4*)(cfl + kb + 8 * g + 4 * hi), c1 = *(const LAS f32x4*)(cfl + kb + 32 + 8 * g + 4 * hi);
#pragma unroll
                        for (int i = 0; i < 4; ++i) { p0[4 * g + i] = fmaf(p0[4 * g + i], C2, cft - c0[i]); p1[4 * g + i] = fmaf(p1[4 * g + i], C2, cft - c1[i]); } }
                } else {
#pragma unroll
                    for (int r = 0; r < 16; ++r) { p0[r] *= C2; p1[r] *= C2; }
                }
                if (kb + 63 > qlo) {
#pragma unroll
                    for (int r = 0; r < 16; ++r) { const int c = (r & 3) + 8 * (r >> 2); if (!(c <= dq)) p0[r] = -__builtin_inff(); if (!(c + 32 <= dq)) p1[r] = -__builtin_inff(); }
                }
                float pmax = p0[0];
#pragma unroll
                for (int r = 1; r < 16; ++r) pmax = fmaxf(pmax, p0[r]);
#pragma unroll
                for (int r = 0; r < 16; ++r) pmax = fmaxf(pmax, p1[r]);
                { auto rr = __builtin_amdgcn_permlane32_swap(__float_as_uint(pmax), __float_as_uint(pmax), false, false); pmax = fmaxf(__uint_as_float(rr[0]), __uint_as_float(rr[1])); }
                float mn, alpha;
                if (__all(pmax - m_reg <= 11.f)) { mn = m_reg; alpha = 1.f; }
                else { mn = fmaxf(m_reg, pmax); alpha = __builtin_amdgcn_exp2f(m_reg - mn); m_reg = mn; }
                float ps = 0.f;
#pragma unroll
                for (int r = 0; r < 16; ++r) { p0[r] = __builtin_amdgcn_exp2f(p0[r] - mn); p1[r] = __builtin_amdgcn_exp2f(p1[r] - mn); ps += p0[r] + p1[r]; }
                { auto rr = __builtin_amdgcn_permlane32_swap(__float_as_uint(ps), __float_as_uint(ps), false, false); ps = __uint_as_float(rr[0]) + __uint_as_float(rr[1]); }
                l_reg = l_reg * alpha + ps;
                if (__any(alpha < 1.f)) {
                    if (hi == 0) al_l[r32] = alpha;
                    asm volatile("s_waitcnt lgkmcnt(0)" ::: "memory");
#pragma unroll
                    for (int g = 0; g < 4; ++g) { const f32x4 av = *(const LAS f32x4*)(al_l + 8 * g + 4 * hi);
#pragma unroll
                        for (int d = 0; d < 4; ++d)
#pragma unroll
                            for (int i = 0; i < 4; ++i) o[d][4 * g + i] *= av[i]; }
                }
            }
            bf16x8 pa0, pa1, pa2, pa3;
#define PK4(P, B_, OUT) do { unsigned a0 = cvtpk(P[B_+0], P[B_+1]), a1 = cvtpk(P[B_+2], P[B_+3]); unsigned b0 = cvtpk(P[B_+4], P[B_+5]), b1 = cvtpk(P[B_+6], P[B_+7]); \
        auto r0 = __builtin_amdgcn_permlane32_swap(a0, b0, false, false); auto r1 = __builtin_amdgcn_permlane32_swap(a1, b1, false, false); \
        u32x4 w = {r0[0], r1[0], r0[1], r1[1]}; OUT = *reinterpret_cast<bf16x8*>(&w); } while (0)
            PK4(p0, 0, pa0); PK4(p0, 8, pa1); PK4(p1, 0, pa2); PK4(p1, 8, pa3);
#undef PK4
            const int vb0 = vbase + cur * AT_SHM_V;
#define TRRD(dst, off) asm volatile("ds_read_b64_tr_b16 %0, %1 offset:%2" : "=&v"(dst) : "v"(vb0), "i"(off) : "memory")
#define PV_D0(d0) do { s16x4 l0, l1, l2, l3, h0, h1, h2, h3; constexpr int b_ = v_rd_off(d0, 0, 0); \
        TRRD(l0, b_); TRRD(h0, b_ + 2048); TRRD(l1, b_ + 4096); TRRD(h1, b_ + 6144); TRRD(l2, b_ + 8192); TRRD(h2, b_ + 10240); TRRD(l3, b_ + 12288); TRRD(h3, b_ + 14336); \
        asm volatile("s_waitcnt lgkmcnt(0)" ::: "memory"); __builtin_amdgcn_sched_barrier(0); \
        o[d0] = __builtin_amdgcn_mfma_f32_32x32x16_bf16(pa0, (bf16x8){l0[0], l0[1], l0[2], l0[3], h0[0], h0[1], h0[2], h0[3]}, o[d0], 0, 0, 0); \
        o[d0] = __builtin_amdgcn_mfma_f32_32x32x16_bf16(pa1, (bf16x8){l1[0], l1[1], l1[2], l1[3], h1[0], h1[1], h1[2], h1[3]}, o[d0], 0, 0, 0); \
        o[d0] = __builtin_amdgcn_mfma_f32_32x32x16_bf16(pa2, (bf16x8){l2[0], l2[1], l2[2], l2[3], h2[0], h2[1], h2[2], h2[3]}, o[d0], 0, 0, 0); \
        o[d0] = __builtin_amdgcn_mfma_f32_32x32x16_bf16(pa3, (bf16x8){l3[0], l3[1], l3[2], l3[3], h3[0], h3[1], h3[2], h3[3]}, o[d0], 0, 0, 0); } while (0)
            PV_D0(0); PV_D0(1); PV_D0(2); PV_D0(3);
#undef PV_D0
#undef TRRD
        }
        if (MODE == 0) { if (kb <= qlo + 31) wdone = __all(carry < -152.f) != 0; if (lane == 0) dflag[(it & 1) * 8 + wid] = wdone ? 1u : 0u; }
#if ATT_DMA
        if (issued) { if (NDMA == 4) asm volatile("s_waitcnt vmcnt(4)\n\ts_waitcnt lgkmcnt(0)\n\ts_barrier" ::: "memory"); else asm volatile("s_waitcnt vmcnt(5)\n\ts_waitcnt lgkmcnt(0)\n\ts_barrier" ::: "memory"); }
        else asm volatile("s_waitcnt vmcnt(0)\n\ts_waitcnt lgkmcnt(0)\n\ts_barrier" ::: "memory");
#else
        if (it + 1 < NT) { AT_WRITE(cur ^ 1); if (it + 2 < NT) AT_LOAD((NT - 3 - it) * 64); }
        __syncthreads();
#endif
    }
#undef AT_DMA
#undef KSW
    float rli[16];
    if (MODE != 0) {
        if (hi == 0) li_l[r32] = l_reg;
        asm volatile("s_waitcnt lgkmcnt(0)" ::: "memory");
#pragma unroll
        for (int g = 0; g < 4; ++g) { const f32x4 lv = *(const LAS f32x4*)(li_l + 8 * g + 4 * hi);
#pragma unroll
            for (int i = 0; i < 4; ++i) rli[4 * g + i] = 1.0f / lv[i]; }
    } else {
#pragma unroll
        for (int r = 0; r < 16; ++r) rli[r] = 1.f;
    }
    bf16_t* Ow = Og + (size_t)qlo * ldo;
#pragma unroll
    for (int r = 0; r < 16; ++r) { const int orow = crow(r, hi);
#pragma unroll
        for (int d0 = 0; d0 < 4; ++d0) { const float v = o[d0][r] * rli[r]; const float vn = __shfl_xor(v, 1);
            if ((r32 & 1) == 0) *(unsigned*)(Ow + (size_t)orow * ldo + d0 * 32 + r32) = cvtpk(v, vn); } }
}

template <int DQK, int MODE>
__device__ __forceinline__ void attn_phase(const bf16_t* Qb, int ldq, int hq, const bf16_t* Kb, int ldk, int hk, const bf16_t* Vb, int ldv, int hv, bf16_t* Ob, const float* cf, float C2, LAS unsigned char* lds) {
#ifdef TESTCOPY
    if (MODE == 0) {
        for (size_t i = (size_t)blockIdx.x * 512 + threadIdx.x; i < (size_t)NTOK * DM; i += (size_t)gridDim.x * 512) {
            const float a = __uint_as_float((unsigned)Qb[i] << 16) + __uint_as_float((unsigned)Kb[i] << 16) + __uint_as_float((unsigned)Vb[i] << 16);
            Ob[i] = (bf16_t)(__float_as_uint(sinf(300.f * a)) >> 16); }
        return;
    }
#endif
#ifdef TESTNAN
    for (int i = threadIdx.x; i < LDS_BYTES / 4; i += 512) ((LAS unsigned*)lds)[i] = 0xFFFFFFFFu;
    __syncthreads();
#endif
    for (int w = blockIdx.x; w < 256; w += gridDim.x) {
        const int xcd = w & 7, slot = w >> 3, bh = xcd * 8 + (slot >> 2), y = slot & 3, b = bh >> 4, hd = bh & 15;
        if (MODE == 1) { LAS float* cfl = (LAS float*)(lds + AT_OFF_CF);
            for (int s = threadIdx.x; s < SEQ; s += 512) cfl[s] = cf[(size_t)bh * SEQ + s] * LOG2E;
            __syncthreads(); }
        const bf16_t* Q = Qb + (size_t)b * SEQ * ldq + hd * hq; const bf16_t* K = Kb + (size_t)b * SEQ * ldk + hd * hk; const bf16_t* V = Vb + (size_t)b * SEQ * ldv + hd * hv;
        bf16_t* O = Ob + (size_t)b * SEQ * DM + hd * HD;
        attn_block<DQK, MODE>(Q, ldq, K, ldk, V, ldv, O, DM, (7 - y) * 256, C2, lds);
        attn_block<DQK, MODE>(Q, ldq, K, ldk, V, ldv, O, DM, y * 256, C2, lds);
        __syncthreads();
    }
}

#define XB_TMO      128
#define XB_XCNT(j)  (256  + 64 * (j))
#define XB_XSUB(j)  (1280 + 64 * (j))
#define XB_XGEN(j)  (2304 + 64 * (j))
#define XB_TOP      3328
#define XB_TOPGEN   3392
#define XCD_BAR_WORDS 3456
#define XB_SPIN_CAP (1u << 18)
__device__ __forceinline__ unsigned xb_ld(unsigned* p)              { return __hip_atomic_load(p, __ATOMIC_RELAXED, __HIP_MEMORY_SCOPE_AGENT); }
__device__ __forceinline__ unsigned xb_add(unsigned* p, unsigned v) { return __hip_atomic_fetch_add(p, v, __ATOMIC_RELAXED, __HIP_MEMORY_SCOPE_AGENT); }
__device__ __forceinline__ unsigned xb_xcc_id() { return (unsigned)__builtin_amdgcn_s_getreg((3 << 11) | 20) & 0xFu; }
#define XB_SPIN(cond, bar) do { unsigned _sp = 0; while (cond) { __builtin_amdgcn_s_sleep(1); \
    if ((++_sp & 255u) == 0u) { if (xb_ld(&(bar)[XB_TMO])) break; if (_sp > XB_SPIN_CAP) { atomicAdd(&(bar)[XB_TMO], 1u); break; } } } } while (0)
struct XcdBarrier { unsigned* bar; unsigned x; volatile LAS unsigned* st; };
__device__ __forceinline__ XcdBarrier xcd_barrier_post(unsigned* bar, volatile LAS unsigned* st) {
    XcdBarrier b; b.bar = bar; b.x = xb_xcc_id(); b.st = st;
    if (threadIdx.x == 0) (void)xb_add(&bar[XB_XCNT(b.x)], 1u);
    return b;
}
__device__ __forceinline__ void xcd_barrier_complete(unsigned* bar, unsigned x, unsigned& nloc, unsigned& nx) {
    const unsigned G = gridDim.x * gridDim.y * gridDim.z;
    unsigned sum, cnt, mine, sp = 0u;
    for (;;) {
        sum = 0u; cnt = 0u; mine = 0u;
#pragma unroll
        for (unsigned j = 0; j < 16; ++j) { const unsigned c = xb_ld(&bar[XB_XCNT(j)]); sum += c; cnt += (c > 0u) ? 1u : 0u; mine = (j == x) ? c : mine; }
        if (sum == G) break;
        __builtin_amdgcn_s_sleep(1);
        if ((++sp & 255u) == 0u) { if (xb_ld(&bar[XB_TMO])) break; if (sp > XB_SPIN_CAP) { atomicAdd(&bar[XB_TMO], 1u); break; } }
    }
    nloc = mine > 0u ? mine : 1u; nx = cnt > 0u ? cnt : 1u;
}
__device__ __forceinline__ void xcd_barrier(const XcdBarrier& b) {
    asm volatile("s_waitcnt vmcnt(0)" ::: "memory");
    __syncthreads();
    if (threadIdx.x == 0) {
        unsigned* bar = b.bar;
        __builtin_amdgcn_s_waitcnt(0);
        unsigned nloc = b.st[0], nx = b.st[1];
        if (nloc == 0u) { xcd_barrier_complete(bar, b.x, nloc, nx); b.st[0] = nloc; b.st[1] = nx; }
        const unsigned old = xb_add(&bar[XB_XSUB(b.x)], 1u);
        const unsigned gen = old / nloc;
        if (old + 1u == (gen + 1u) * nloc) {
            __builtin_amdgcn_fence(__ATOMIC_RELEASE, "agent");
            asm volatile("s_waitcnt vmcnt(0)" ::: "memory");
            const unsigned og = xb_add(&bar[XB_TOP], 1u);
            const unsigned tg = og / nx;
            if (og + 1u == (tg + 1u) * nx) xb_add(&bar[XB_TOPGEN], 1u);
            else XB_SPIN(xb_ld(&bar[XB_TOPGEN]) == tg, bar);
            __builtin_amdgcn_fence(__ATOMIC_ACQUIRE, "agent");
            xb_add(&bar[XB_XGEN(b.x)], 1u);
            asm volatile("s_waitcnt vmcnt(0)" ::: "memory");
        } else {
            XB_SPIN(xb_ld(&bar[XB_XGEN(b.x)]) == gen, bar);
            __builtin_amdgcn_fence(__ATOMIC_ACQUIRE, "agent");
            asm volatile("s_waitcnt vmcnt(0)" ::: "memory");
        }
    }
    __syncthreads();
}

#ifndef NLAYERS
#define NLAYERS 4
#endif
constexpr int N_PHASES = 1 + 10 * NLAYERS;
__host__ __device__ inline bool phase_active(int ph) {
    if (ph == 0) return true;
    const int layer = (ph - 1) / 10, s = (ph - 1) % 10, kind = layer % 3;
    if (s == 0 || s == 7) return false;
    if (s == 2) return kind != 0;
    if (s == 3 || s == 4) return kind == 2;
    return true;
}

__global__ void __launch_bounds__(512, 2) fwd_megakernel(Params p) {
    extern __shared__ __attribute__((aligned(16))) unsigned char shm_raw[];
    LAS unsigned char* lds = (LAS unsigned char*)shm_raw;
    unsigned char* ws = p.ws;
    float* X = (float*)(ws + WS_X); bf16_t* H = (bf16_t*)(ws + WS_H); bf16_t* AO = (bf16_t*)(ws + WS_AO);
    float* SS = (float*)(ws + WS_SS); float* LOGF = (float*)(ws + WS_LOGF); float* CF = (float*)(ws + WS_CF); float* ROPE = (float*)(ws + WS_ROPE); float* KR = (float*)(ws + WS_KR);
    unsigned char* scr = ws + WS_SCR;
    bool first = true;
#if COOP
    volatile LAS unsigned* st = (volatile LAS unsigned*)(lds + 131072);
    if (threadIdx.x == 0) { st[0] = 0u; st[1] = 0u; }
    __syncthreads();
    const XcdBarrier xb = xcd_barrier_post((unsigned*)(ws + WS_BAR), st);
    int nsync = 0;
#endif
    for (int ph = (int)p.ph_lo; ph < (int)p.ph_hi; ++ph) {
        if (!phase_active(ph)) continue;
#if COOP
        if (!first) { if (nsync == 0) cg::this_grid().sync(); else xcd_barrier(xb); ++nsync; }
#endif
        first = false;
        if (ph == 0) { if (EN(100)) {
            xprep_phase(p.x, p.mix_norm, H, SS);
            for (int j = 0; j < 2; ++j) {
                conv_job(lds, p.sb_w_in + (size_t)j * 2048 * 6144, 6144, 0, 6144, 6144, 2048, (bf16_t*)(ws + W_SB_IN + j * SZ_QKVW));
                conv_job(lds, p.sb_w_out + (size_t)j * 2048 * 2048, 2048, 0, 2048, 2048, 2048, (bf16_t*)(ws + W_SB_OUT + j * SZ_SQW));
            }
            conv_job(lds, p.fox_w_in, 6160, 0, 6144, 6144, 2048, (bf16_t*)(ws + W_FOX_IN));
            conv_job(lds, p.fox_w_in, 6160, 6144, 16, 128, 2048, (bf16_t*)(ws + W_FOX_F));
            conv_job(lds, p.fox_w_out, 2048, 0, 2048, 2048, 2048, (bf16_t*)(ws + W_FOX_OUT));
            conv_job(lds, p.mla_w_in, MLA_DOWN, 0, MLA_DOWN, MLA_DOWN_PAD, 2048, (bf16_t*)(ws + W_MLA_IN));
            conv_job(lds, p.mla_w_uq, 3072, 0, 3072, 3072, 768, (bf16_t*)(ws + W_MLA_UQ));
            conv_job(lds, p.mla_w_ukv, 4096, 0, 4096, 4096, 512, (bf16_t*)(ws + W_MLA_UKV));
            conv_job(lds, p.mla_w_out, 2048, 0, 2048, 2048, 2048, (bf16_t*)(ws + W_MLA_OUT));
            for (int j = 0; j < 4; ++j) {
                conv_job(lds, p.mlp_w1 + (size_t)j * 2048 * 8192, 8192, 0, 8192, 8192, 2048, (bf16_t*)(ws + W_W1 + j * SZ_FFW));
                conv_job(lds, p.mlp_w2 + (size_t)j * 8192 * 2048, 2048, 0, 2048, 2048, 8192, (bf16_t*)(ws + W_W2 + j * SZ_FFW));
            } }
            continue;
        }
        const int layer = (ph - 1) / 10, s = (ph - 1) % 10, kind = layer % 3, j = layer / 3;
        const float* xin = (layer == 0) ? p.x : X;
        int ng = 0; GemmJob g0{}, g1{}; bool do_fgate = false;
        g0.M = NTOK; g1.M = NTOK;
        const float* ss1 = SS + (size_t)(2 * layer) * NTOK * 8; const float* ss2 = SS + (size_t)(2 * layer + 1) * NTOK * 8;
        if (s == 1) {
            ng = 1; g0.A = H; g0.K = DM;
            if (kind == 2) { g0.Bt = (const bf16_t*)(ws + W_MLA_IN); g0.N = MLA_DOWN_PAD; g0.E = pg8::EpiGen{0, (bf16_t*)(scr + SC_DOWN), MLA_DOWN_PAD, 0, 0, nullptr, nullptr, ss1, nullptr, nullptr, nullptr}; }
            else { g0.Bt = (const bf16_t*)(ws + (kind == 0 ? W_SB_IN + j * SZ_QKVW : W_FOX_IN)); g0.N = 3 * DM; g0.E = pg8::EpiGen{0, (bf16_t*)(scr + SC_Q), DM, DM, (size_t)NTOK * DM, nullptr, nullptr, ss1, nullptr, nullptr, nullptr}; do_fgate = kind == 1; }
        } else if (s == 2) {
            if (kind == 1) { if (EN(2)) fox_prep_phase((bf16_t*)(scr + SC_Q), p.fox_q_gain, p.fox_k_gain, LOGF, CF); }
            else { if (EN(2)) mla_prep1_phase((const bf16_t*)(scr + SC_DOWN), p.pos, p.mla_q_norm, p.mla_kv_norm, (bf16_t*)(scr + SC_CQ), (bf16_t*)(scr + SC_CKV), ROPE, KR); }
        } else if (s == 3) {
            ng = 2;
            g0.A = (const bf16_t*)(scr + SC_CQ); g0.Bt = (const bf16_t*)(ws + W_MLA_UQ); g0.N = 3072; g0.K = MLA_QR; g0.E = pg8::EpiGen{0, (bf16_t*)(scr + SC_QUP), 3072, 0, 0, nullptr, nullptr, nullptr, nullptr, nullptr, nullptr};
            g1.A = (const bf16_t*)(scr + SC_CKV); g1.Bt = (const bf16_t*)(ws + W_MLA_UKV); g1.N = 4096; g1.K = MLA_KVR; g1.E = pg8::EpiGen{0, (bf16_t*)(scr + SC_KV), 4096, 0, 0, nullptr, nullptr, nullptr, nullptr, nullptr, nullptr};
        } else if (s == 4) { if (EN(4)) mla_prep2_phase((const bf16_t*)(scr + SC_QUP), (const bf16_t*)(scr + SC_KV), ROPE, KR, p.mla_q_gain, p.mla_k_gain, (bf16_t*)(scr + SC_QN), (bf16_t*)(scr + SC_KN)); }
        else if (s == 5) {
#ifdef PROBE_ATT2
          for (int rep = 0; rep < 2; ++rep) {
#endif
            if (kind == 0) { if (EN(50)) attn_phase<128, TESTMODE2 ? 2 : 0>((const bf16_t*)(scr + SC_Q), DM, HD, (const bf16_t*)(scr + SC_K), DM, HD, (const bf16_t*)(scr + SC_V), DM, HD, AO, nullptr, 0.08838834764831845f * LOG2E, lds); }
            else if (kind == 1) { if (EN(51)) attn_phase<128, 1>((const bf16_t*)(scr + SC_Q), DM, HD, (const bf16_t*)(scr + SC_K), DM, HD, (const bf16_t*)(scr + SC_V), DM, HD, AO, CF, 0.08838834764831845f * LOG2E, lds); }
            else { if (EN(52)) attn_phase<192, 2>((const bf16_t*)(scr + SC_QN), 3072, 192, (const bf16_t*)(scr + SC_KN), 3072, 192, (const bf16_t*)(scr + SC_KV) + 128, 4096, 256, AO, nullptr, 0.07216878364870323f * LOG2E, lds); }
#ifdef PROBE_ATT2
          }
#endif
        } else if (s == 6) {
            ng = 1; g0.A = AO; g0.K = DM; g0.N = DM; g0.Bt = (const bf16_t*)(ws + (kind == 0 ? W_SB_OUT + j * SZ_SQW : (kind == 1 ? W_FOX_OUT : W_MLA_OUT)));
            g0.E = pg8::EpiGen{2, nullptr, DM, 0, 0, xin, X, nullptr, H, p.mlp_norm + layer * DM, SS + (size_t)(2 * layer + 1) * NTOK * 8};
        } else if (s == 8) {
            ng = 1; g0.A = H; g0.K = DM; g0.N = DFF; g0.Bt = (const bf16_t*)(ws + W_W1 + layer * SZ_FFW); g0.E = pg8::EpiGen{1, (bf16_t*)scr, DFF, 0, 0, nullptr, nullptr, ss2, nullptr, nullptr, nullptr};
        } else {
            ng = 1; g0.A = (const bf16_t*)scr; g0.K = DFF; g0.N = DM; g0.Bt = (const bf16_t*)(ws + W_W2 + layer * SZ_FFW); const bool lastl = layer == NLAYERS - 1;
            g0.E = pg8::EpiGen{2, nullptr, DM, 0, 0, X, lastl ? p.out : X, nullptr, lastl ? nullptr : H, p.mix_norm + (lastl ? 0 : layer + 1) * DM, SS + (size_t)(lastl ? 0 : 2 * layer + 2) * NTOK * 8};
        }
        if (EN(1)) {
#pragma nounroll
            for (int gi = 0; gi < ng; ++gi) run_gemm(lds, gi ? g1 : g0);
        }
        if (do_fgate && EN(2)) fgate_phase(H, (const bf16_t*)(ws + W_FOX_F), p.fox_b_f, ss1, LOGF);
    }
}

extern "C" void kernel_launch(void* const* d_in, const int* in_sizes, int n_in, void* d_out, int out_size, void* d_ws, size_t ws_size, hipStream_t stream) {
    static int grid = 0;
    if (grid == 0) {
        if (n_in != 21 || out_size != NTOK * DM || ws_size < WS_END) { fprintf(stderr, "kernel_launch: unexpected shapes (n_in %d out %d ws %zu need %zu)\n", n_in, out_size, ws_size, (size_t)WS_END); grid = -1; return; }
        int dev = 0, cus = 0, per_cu = 0;
        hipGetDevice(&dev); hipDeviceGetAttribute(&cus, hipDeviceAttributeMultiprocessorCount, dev);
        if (hipFuncSetAttribute((const void*)fwd_megakernel, hipFuncAttributeMaxDynamicSharedMemorySize, LDS_BYTES) != hipSuccess) { fprintf(stderr, "kernel_launch: hipFuncSetAttribute failed\n"); grid = -1; return; }
        if (hipOccupancyMaxActiveBlocksPerMultiprocessor(&per_cu, (const void*)fwd_megakernel, 512, LDS_BYTES) != hipSuccess || per_cu < 1) { fprintf(stderr, "kernel_launch: occupancy query says %d\n", per_cu); per_cu = 1; }
        (void)hipGetLastError();
        grid = cus * 1;
        if (grid > 256) grid = 256;
    }
    if (grid < 0) return;
    Params p{};
    p.x = (const float*)d_in[0]; p.pos = (const int*)d_in[1]; p.mix_norm = (const float*)d_in[2]; p.mlp_norm = (const float*)d_in[3];
    p.sb_w_in = (const float*)d_in[4]; p.sb_w_out = (const float*)d_in[5]; p.fox_w_in = (const float*)d_in[6]; p.fox_b_f = (const float*)d_in[7];
    p.fox_q_gain = (const float*)d_in[8]; p.fox_k_gain = (const float*)d_in[9]; p.fox_w_out = (const float*)d_in[10];
    p.mla_w_in = (const float*)d_in[11]; p.mla_q_norm = (const float*)d_in[12]; p.mla_kv_norm = (const float*)d_in[13]; p.mla_w_uq = (const float*)d_in[14]; p.mla_w_ukv = (const float*)d_in[15];
    p.mla_q_gain = (const float*)d_in[16]; p.mla_k_gain = (const float*)d_in[17]; p.mla_w_out = (const float*)d_in[18]; p.mlp_w1 = (const float*)d_in[19]; p.mlp_w2 = (const float*)d_in[20];
    p.out = (float*)d_out; p.ws = (unsigned char*)d_ws;
#if COOP
    hipMemsetAsync((char*)d_ws + WS_BAR, 0, 16384, stream);
    p.ph_lo = 0; p.ph_hi = N_PHASES;
    void* args[] = {&p};
    hipError_t e = hipLaunchCooperativeKernel((const void*)fwd_megakernel, dim3(grid), dim3(512), args, LDS_BYTES, stream);
    if (e != hipSuccess) fprintf(stderr, "cooperative launch failed: %s (grid %d)\n", hipGetErrorString(e), grid);
#else
    for (int ph = 0; ph < N_PHASES; ++ph) {
        if (!phase_active(ph)) continue;
        p.ph_lo = ph; p.ph_hi = ph + 1;
        hipLaunchKernelGGL(fwd_megakernel, dim3(grid), dim3(512), LDS_BYTES, stream, p);
    }
#endif
}
```

```cpp
#include <hip/hip_runtime.h>
#include <hip/hip_cooperative_groups.h>
#include <cstdio>
#include <cstdint>
namespace cg = cooperative_groups;

#ifndef COOP
#define COOP 1
#endif
#ifndef ONLY
#define ONLY -1
#endif
#ifndef ATT_DMA
#define ATT_DMA 1
#endif
#define TESTMODE2 0

#ifndef SKIP
#define SKIP -5
#endif
#define EN(x) ((ONLY < 0 || ONLY == (x)) && (x) != SKIP)

#define LAS __attribute__((address_space(3)))
typedef unsigned short bf16_t;
typedef short bf16x8 __attribute__((ext_vector_type(8)));
typedef short s16x4 __attribute__((ext_vector_type(4)));
typedef float f32x4 __attribute__((ext_vector_type(4)));
typedef float f32x16 __attribute__((ext_vector_type(16)));
typedef unsigned u32x4 __attribute__((ext_vector_type(4)));
typedef unsigned u32x2 __attribute__((ext_vector_type(2)));

constexpr int DM = 2048, NTOK = 8192, SEQ = 2048, NH = 16, HD = 128, DFF = 8192, DEPTH = 4;
constexpr int MLA_QR = 768, MLA_KVR = 512, MLA_ROPE = 64, MLA_QK = 192, MLA_DOWN = 1344, MLA_DOWN_PAD = 1536;
constexpr float EPS = 1e-6f;
constexpr float LOG2E = 1.4426950408889634f;

constexpr size_t SZ_QKVW = (size_t)6144 * 2048 * 2, SZ_SQW = (size_t)2048 * 2048 * 2, SZ_FFW = (size_t)8192 * 2048 * 2;
constexpr size_t W_SB_IN = 0;
constexpr size_t W_SB_OUT = W_SB_IN + 2 * SZ_QKVW;
constexpr size_t W_FOX_IN = W_SB_OUT + 2 * SZ_SQW;
constexpr size_t W_FOX_F = W_FOX_IN + SZ_QKVW;
constexpr size_t W_FOX_OUT = W_FOX_F + (size_t)128 * 2048 * 2;
constexpr size_t W_MLA_IN = W_FOX_OUT + SZ_SQW;
constexpr size_t W_MLA_UQ = W_MLA_IN + (size_t)1536 * 2048 * 2;
constexpr size_t W_MLA_UKV = W_MLA_UQ + (size_t)3072 * 768 * 2;
constexpr size_t W_MLA_OUT = W_MLA_UKV + (size_t)4096 * 512 * 2;
constexpr size_t W_W1 = W_MLA_OUT + SZ_SQW;
constexpr size_t W_W2 = W_W1 + 4 * SZ_FFW;
constexpr size_t WS_X = W_W2 + 4 * SZ_FFW;
constexpr size_t WS_H = WS_X + (size_t)NTOK * DM * 4;
constexpr size_t WS_AO = WS_H + (size_t)NTOK * DM * 2;
constexpr size_t WS_LOGF = WS_AO + (size_t)NTOK * DM * 2;
constexpr size_t WS_CF = WS_LOGF + (size_t)NTOK * 16 * 4;
constexpr size_t WS_ROPE = WS_CF + (size_t)64 * 2048 * 4;
constexpr size_t WS_KR = WS_ROPE + (size_t)NTOK * 64 * 4;
constexpr size_t WS_SCR = WS_KR + (size_t)NTOK * 64 * 4;
constexpr size_t SC_Q = 0, SC_K = (size_t)NTOK * DM * 2, SC_V = 2 * (size_t)NTOK * DM * 2;
constexpr size_t SC_DOWN = 0;
constexpr size_t SC_CQ = SC_DOWN + (size_t)NTOK * MLA_DOWN_PAD * 2;
constexpr size_t SC_CKV = SC_CQ + (size_t)NTOK * MLA_QR * 2;
constexpr size_t SC_QUP = SC_CKV + (size_t)NTOK * MLA_KVR * 2;
constexpr size_t SC_KV = SC_QUP + (size_t)NTOK * 3072 * 2;
constexpr size_t SC_QN = SC_KV + (size_t)NTOK * 4096 * 2;
constexpr size_t SC_KN = SC_QN + (size_t)NTOK * 3072 * 2;
constexpr size_t SC_END = SC_KN + (size_t)NTOK * 3072 * 2;
constexpr size_t WS_BAR = WS_SCR + SC_END;
constexpr size_t WS_END = WS_BAR + 16384;

constexpr int LDS_BYTES = 131072 + 16;

struct Params {
    const float* x; const int* pos; const float* mix_norm; const float* mlp_norm;
    const float* sb_w_in; const float* sb_w_out; const float* fox_w_in; const float* fox_b_f; const float* fox_q_gain; const float* fox_k_gain; const float* fox_w_out;
    const float* mla_w_in; const float* mla_q_norm; const float* mla_kv_norm; const float* mla_w_uq; const float* mla_w_ukv; const float* mla_q_gain; const float* mla_k_gain; const float* mla_w_out;
    const float* mlp_w1; const float* mlp_w2;
    float* out; unsigned char* ws;
    long long ph_lo, ph_hi, alt;
};

__device__ __forceinline__ unsigned cvtpk(float lo, float hi) { unsigned r; asm volatile("v_cvt_pk_bf16_f32 %0, %1, %2" : "=v"(r) : "v"(lo), "v"(hi)); return r; }
__device__ __forceinline__ float bflo(unsigned w) { return __uint_as_float(w << 16); }
__device__ __forceinline__ float bfhi(unsigned w) { return __uint_as_float(w & 0xffff0000u); }
__device__ __forceinline__ int opq(int x) { asm volatile("" : "+v"(x)); return x; }
__device__ __forceinline__ float wave_sum(float v) {
#pragma unroll
    for (int o = 32; o > 0; o >>= 1) v += __shfl_xor(v, o);
    return v;
}
__device__ __forceinline__ float sum16(float v) {
#pragma unroll
    for (int o = 8; o > 0; o >>= 1) v += __shfl_xor(v, o);
    return v;
}

namespace pg8 {
constexpr int BM = 256, BK = 64, HALF = 128, HTB = HALF * BK * 2, STAGE_BYTES = 8 * HTB, NXCD = 8, WGM = 8;
__host__ __device__ __forceinline__ int lds_byte(int r, int c) { const int st = (r >> 4) * 2 + (c >> 5), rr = r & 15, cc = c & 31, ob = rr * 64 + cc * 2; return st * 1024 + (ob ^ (((ob >> 9) & 1) << 5)); }
__host__ __device__ __forceinline__ void stage_rc(int b, int& R, int& C) { const int st = b / 1024, sb = b % 1024, swz = sb ^ (((sb >> 9) & 1) << 5); R = (st >> 1) * 16 + swz / 64; C = (st & 1) * 32 + (swz % 64) / 2; }
__host__ __device__ __forceinline__ int perm32(int rho) { const int n = rho >> 4, i = rho & 15; return 8 * (i >> 2) + 4 * n + (i & 3); }
struct Unit { int pm, pn; };
struct Gemm { const bf16_t* A; const bf16_t* Bt; int M, N, K; };
struct StaticOrder {
    int nM, nN, nwg, G, c;
    __device__ void init(int M, int N, int G_, int c_) { nM = M / BM; nN = N / BM; nwg = nM * nN; G = G_; c = c_; }
    __device__ bool next(int i, Unit& u) const {
        const long L = (long)i * G + c; if (L >= nwg) return false;
        int wgid = (int)L; { const int q = nwg / NXCD, r = nwg % NXCD, xcd = wgid % NXCD, off = wgid / NXCD; wgid = (xcd < r ? xcd * (q + 1) : r * (q + 1) + (xcd - r) * q) + off; }
        const int nig = WGM * nN, gid = wgid / nig, fm = gid * WGM, gsz = (nM - fm) < WGM ? (nM - fm) : WGM;
        u.pm = fm + ((wgid % nig) % gsz); u.pn = (wgid % nig) / gsz; return true;
    }
};
struct EpiGen {
    int mode; bf16_t* O; int ldc; int split_cols; size_t split_stride; const float* R; float* C;
    __device__ __forceinline__ void operator()(const f32x4 (&acc)[2][2][4][2], const Unit& u, int wr, int wc, int fr, int fq) const {
        const int row0 = u.pm * BM + wr * 64 + fr;
        if (mode == 2) {
            const int col0 = u.pn * BM + wc * 32 + 4 * fq;
#pragma unroll
            for (int ai = 0; ai < 2; ++ai) {
                f32x4 rv[4][2][2];
#pragma unroll
                for (int m = 0; m < 4; ++m) { const size_t ro = (size_t)(row0 + ai * HALF + m * 16) * ldc + col0;
#pragma unroll
                    for (int bj = 0; bj < 2; ++bj)
#pragma unroll
                        for (int n = 0; n < 2; ++n) rv[m][bj][n] = *(const f32x4*)(R + ro + bj * HALF + n * 16); }
#pragma unroll
                for (int m = 0; m < 4; ++m) { const size_t ro = (size_t)(row0 + ai * HALF + m * 16) * ldc + col0;
#pragma unroll
                    for (int bj = 0; bj < 2; ++bj)
#pragma unroll
                        for (int n = 0; n < 2; ++n) *(f32x4*)(C + ro + bj * HALF + n * 16) = acc[ai][bj][m][n] + rv[m][bj][n]; }
            }
        } else {
            int colt = u.pn * BM; bf16_t* base = O;
            if (split_cols) { const int t = colt / split_cols; base += (size_t)t * split_stride; colt -= t * split_cols; }
            const int col0 = colt + wc * 32 + 8 * fq; const bool act = mode == 1;
#pragma unroll
            for (int ai = 0; ai < 2; ++ai)
#pragma unroll
                for (int m = 0; m < 4; ++m) { bf16_t* rowp = base + (size_t)(row0 + ai * HALF + m * 16) * ldc + col0;
#pragma unroll
                    for (int bj = 0; bj < 2; ++bj) { f32x4 v0 = acc[ai][bj][m][0], v1 = acc[ai][bj][m][1];
                        if (act) {
#pragma unroll
                            for (int j = 0; j < 4; ++j) { float x = fmaxf(v0[j], 0.f), y = fmaxf(v1[j], 0.f); v0[j] = x * x; v1[j] = y * y; } }
                        u32x4 w; w.x = cvtpk(v0[0], v0[1]); w.y = cvtpk(v0[2], v0[3]); w.z = cvtpk(v1[0], v1[1]); w.w = cvtpk(v1[2], v1[3]);
                        *(u32x4*)(rowp + bj * HALF) = w; } }
        }
    }
};

template <class Epi, class Sched>
__device__ __forceinline__ void gemm_phase(LAS unsigned char* lds, const Gemm g, const Sched& S, const Epi& E) {
    const int tid = opq(threadIdx.x), wid = __builtin_amdgcn_readfirstlane(tid >> 6), lane = tid & 63, wr = wid >> 2, wc = wid & 3, fr = lane & 15, fq = lane >> 4;
    const int K = g.K, nt = K / BK;
    unsigned voffA[2], voffB[2];
#pragma unroll
    for (int i = 0; i < 2; ++i) { int R, C; stage_rc(tid * 16 + i * 8192, R, C); const int Rb = (E.mode != 2) ? ((R & ~31) + perm32(R & 31)) : R;
        voffA[i] = (unsigned)(R * K + C) * 2u; voffB[i] = (unsigned)(Rb * K + C) * 2u; }
    const size_t kstep = (size_t)(BK * 2);
    const size_t hstep = (size_t)HALF * K * 2;
    const size_t tstep = 2 * hstep;
    const unsigned ldsw = (unsigned)wid * 1024u;
    const int aoff = lds_byte(wr * 64 + fr, fq * 8), boff = lds_byte(wc * 32 + fr, fq * 8);
#define PG8_SA(b, h) (((b) * 2 + (h)) * HTB)
#define PG8_SB(b, h) ((4 + (b) * 2 + (h)) * HTB)
#define PG8_STAGE(bufoff, gbase, voff) do { _Pragma("unroll") for (int _i = 0; _i < 2; ++_i) \
        __builtin_amdgcn_global_load_lds((const unsigned*)((const char*)(gbase) + (voff)[_i]), (LAS unsigned*)(lds + (bufoff) + ldsw + _i * 8192), 16, 0, 0); } while (0)
#define PG8_LDA(dst, b, h) do { _Pragma("unroll") for (int m = 0; m < 4; ++m) _Pragma("unroll") for (int k = 0; k < 2; ++k) dst[m][k] = *(const LAS bf16x8*)(lds + PG8_SA(b, h) + aoff + m * 2048 + k * 1024); } while (0)
#define PG8_LDB(dst, b, h) do { _Pragma("unroll") for (int n = 0; n < 2; ++n) _Pragma("unroll") for (int k = 0; k < 2; ++k) dst[n][k] = *(const LAS bf16x8*)(lds + PG8_SB(b, h) + boff + n * 2048 + k * 1024); } while (0)
#define PG8_MMA(ai, bj, At, Bt) do { __builtin_amdgcn_s_setprio(1); _Pragma("unroll") for (int m = 0; m < 4; ++m) _Pragma("unroll") for (int n = 0; n < 2; ++n) _Pragma("unroll") for (int k = 0; k < 2; ++k) \
        acc[ai][bj][m][n] = __builtin_amdgcn_mfma_f32_16x16x32_bf16(Bt[n][k], At[m][k], acc[ai][bj][m][n], 0, 0, 0); __builtin_amdgcn_s_setprio(0); } while (0)
#define PG8_WAIT_V(n) asm volatile("s_waitcnt vmcnt(" #n ")" ::: "memory")
#define PG8_WAIT_L(n) asm volatile("s_waitcnt lgkmcnt(" #n ")" ::: "memory")
#define PG8_BAR __builtin_amdgcn_s_barrier()
#define PG8_SCHED __builtin_amdgcn_sched_barrier(0)
    Unit cur, nxt; int ui = 0;
    if (!S.next(0, cur)) return;
    f32x4 acc[2][2][4][2];
#pragma unroll
    for (int a = 0; a < 2; ++a)
#pragma unroll
        for (int b = 0; b < 2; ++b)
#pragma unroll
            for (int m = 0; m < 4; ++m)
#pragma unroll
                for (int n = 0; n < 2; ++n) acc[a][b][m][n] = (f32x4){0.f, 0.f, 0.f, 0.f};
    bf16x8 At[4][2], B0[2][2], B1[2][2];
    const char* cA = (const char*)g.A + (size_t)cur.pm * tstep; const char* cB = (const char*)g.Bt + (size_t)cur.pn * tstep;
    PG8_STAGE(PG8_SB(0, 0), cB, voffB); PG8_STAGE(PG8_SA(0, 0), cA, voffA); PG8_STAGE(PG8_SB(0, 1), cB + hstep, voffB); PG8_STAGE(PG8_SA(0, 1), cA + hstep, voffA);
    if (wr == 1) PG8_BAR;
    PG8_WAIT_V(4); PG8_BAR;
    PG8_STAGE(PG8_SB(1, 0), cB + kstep, voffB); PG8_STAGE(PG8_SA(1, 0), cA + kstep, voffA); PG8_STAGE(PG8_SB(1, 1), cB + hstep + kstep, voffB);
    PG8_WAIT_V(6); PG8_BAR;
    for (;;) {
        const bool has_next = S.next(ui + 1, nxt);
        const char* nA = has_next ? (const char*)g.A + (size_t)nxt.pm * tstep : cA; const char* nB = has_next ? (const char*)g.Bt + (size_t)nxt.pn * tstep : cB;
        for (int t = 0; t < nt; t += 2) {
            const bool last = (t == nt - 2);
            const char* a1 = cA + (size_t)(t + 1) * kstep;
            const char* a2 = last ? nA : cA + (size_t)(t + 2) * kstep; const char* b2 = last ? nB : cB + (size_t)(t + 2) * kstep;
            const char* a3 = a2 + kstep; const char* b3 = b2 + kstep;
            PG8_LDB(B0, 0, 0); PG8_SCHED; PG8_LDA(At, 0, 0); PG8_STAGE(PG8_SA(1, 1), a1 + hstep, voffA);
            PG8_WAIT_L(8); PG8_BAR; PG8_WAIT_L(0); PG8_MMA(0, 0, At, B0); PG8_BAR; PG8_SCHED;
            PG8_LDB(B1, 0, 1); PG8_STAGE(PG8_SB(0, 0), b2, voffB);
            PG8_BAR; PG8_WAIT_L(0); PG8_MMA(0, 1, At, B1); PG8_BAR;
            PG8_LDA(At, 0, 1); PG8_STAGE(PG8_SA(0, 0), a2, voffA);
            PG8_BAR; PG8_WAIT_L(0); PG8_MMA(1, 0, At, B0); PG8_BAR; PG8_SCHED;
            PG8_STAGE(PG8_SB(0, 1), b2 + hstep, voffB);
            PG8_WAIT_V(6); PG8_BAR; PG8_MMA(1, 1, At, B1); PG8_BAR;
            PG8_LDB(B0, 1, 0); PG8_SCHED; PG8_LDA(At, 1, 0); PG8_STAGE(PG8_SA(0, 1), a2 + hstep, voffA);
            PG8_WAIT_L(8); PG8_BAR; PG8_WAIT_L(0); PG8_MMA(0, 0, At, B0); PG8_BAR; PG8_SCHED;
            PG8_LDB(B1, 1, 1); PG8_STAGE(PG8_SB(1, 0), b3, voffB);
            PG8_BAR; PG8_WAIT_L(0); PG8_MMA(0, 1, At, B1); PG8_BAR;
            PG8_LDA(At, 1, 1); PG8_STAGE(PG8_SA(1, 0), a3, voffA);
            PG8_BAR; PG8_WAIT_L(0); PG8_MMA(1, 0, At, B0); PG8_BAR; PG8_SCHED;
            PG8_STAGE(PG8_SB(1, 1), b3 + hstep, voffB);
            PG8_WAIT_V(6); PG8_BAR; PG8_MMA(1, 1, At, B1); PG8_BAR;
        }
        E(acc, cur, wr, wc, fr, fq);
        if (!has_next) break;
#pragma unroll
        for (int a = 0; a < 2; ++a)
#pragma unroll
            for (int b = 0; b < 2; ++b)
#pragma unroll
                for (int m = 0; m < 4; ++m)
#pragma unroll
                    for (int n = 0; n < 2; ++n) acc[a][b][m][n] = (f32x4){0.f, 0.f, 0.f, 0.f};
        cur = nxt; cA = nA; cB = nB; ++ui;
    }
    PG8_WAIT_V(0);
    if (wr == 0) PG8_BAR;
    PG8_BAR;
#undef PG8_SA
#undef PG8_SB
#undef PG8_STAGE
#undef PG8_LDA
#undef PG8_LDB
#undef PG8_MMA
#undef PG8_WAIT_V
#undef PG8_WAIT_L
#undef PG8_BAR
#undef PG8_SCHED
}
}

struct GemmJob { const bf16_t* A; const bf16_t* Bt; int M, N, K; pg8::EpiGen E; };
__device__ __forceinline__ void run_gemm(LAS unsigned char* lds, const GemmJob& j) {
    pg8::Gemm g{j.A, j.Bt, j.M, j.N, j.K};
    pg8::StaticOrder S; S.init(j.M, j.N, (int)gridDim.x, (int)blockIdx.x);
    pg8::gemm_phase<pg8::EpiGen, pg8::StaticOrder>(lds, g, S, j.E);
    __syncthreads();
}

__device__ __forceinline__ void conv_job(LAS unsigned char* lds, const float* __restrict__ src, int ldn, int col0, int ncols, int npad, int K, bf16_t* __restrict__ dst) {
    constexpr int LR = 132;
    LAS float* T = (LAS float*)lds;
    const int tid = opq(threadIdx.x), n4 = tid & 31, kr = tid >> 5;
    const int rn = tid & 127, rk = tid >> 7;
    const int ntn = npad / 128, ntk = K / 128, ntiles = ntn * ntk;
    f32x4 r[8];
    int t = blockIdx.x;
#define CONV_LOAD(tt_) do { const int tn_ = (tt_) % ntn, tk_ = (tt_) / ntn; const int n_ = tn_ * 128 + n4 * 4; const bool ok_ = n_ < ncols; \
        const float* p_ = src + (size_t)(tk_ * 128 + kr) * ldn + col0 + (ok_ ? n_ : 0); \
        _Pragma("unroll") for (int j_ = 0; j_ < 8; ++j_) { r[j_] = __builtin_nontemporal_load((const f32x4*)(p_ + (size_t)(16 * j_) * ldn)); if (!ok_) r[j_] = (f32x4){0.f, 0.f, 0.f, 0.f}; } } while (0)
    if (t < ntiles) CONV_LOAD(t);
    for (; t < ntiles; t += gridDim.x) {
        const int tn = t % ntn, tk = t / ntn;
#pragma unroll
        for (int j = 0; j < 8; ++j) *(LAS f32x4*)(T + (kr + 16 * j) * LR + n4 * 4) = r[j];
        if (t + (int)gridDim.x < ntiles) CONV_LOAD(t + (int)gridDim.x);
        __syncthreads();
#pragma unroll
        for (int j = 0; j < 4; ++j) { const int kc = rk + 4 * j; float v[8];
#pragma unroll
            for (int i = 0; i < 8; ++i) v[i] = T[(kc * 8 + i) * LR + rn];
            u32x4 w; w.x = cvtpk(v[0], v[1]); w.y = cvtpk(v[2], v[3]); w.z = cvtpk(v[4], v[5]); w.w = cvtpk(v[6], v[7]);
            *(u32x4*)(dst + (size_t)(tn * 128 + rn) * K + tk * 128 + kc * 8) = w; }
        __syncthreads();
    }
}

__device__ __forceinline__ void rmsnorm_phase(const float* __restrict__ x, const float* __restrict__ g, bf16_t* __restrict__ h) {
    const int tid = opq(threadIdx.x), lane = tid & 63, gw = blockIdx.x * 8 + (tid >> 6), nw = gridDim.x * 8;
    for (int row = gw; row < NTOK; row += nw) {
        const float* xr = x + (size_t)row * DM; f32x4 v[8]; float ss = 0.f;
#pragma unroll
        for (int j = 0; j < 8; ++j) { v[j] = *(const f32x4*)(xr + j * 256 + lane * 4); ss += v[j][0] * v[j][0] + v[j][1] * v[j][1] + v[j][2] * v[j][2] + v[j][3] * v[j][3]; }
        ss = wave_sum(ss); const float rs = rsqrtf(ss * (1.f / DM) + EPS);
#pragma unroll
        for (int j = 0; j < 8; ++j) { const f32x4 gv = *(const f32x4*)(g + j * 256 + lane * 4);
            u32x2 w; w.x = cvtpk(v[j][0] * rs * gv[0], v[j][1] * rs * gv[1]); w.y = cvtpk(v[j][2] * rs * gv[2], v[j][3] * rs * gv[3]);
            *(u32x2*)(h + (size_t)row * DM + j * 256 + lane * 4) = w; }
    }
}

__device__ __forceinline__ void fgate_phase(const bf16_t* __restrict__ h, const bf16_t* __restrict__ wft, const float* __restrict__ bfv, float* __restrict__ logf) {
    const int tid = opq(threadIdx.x), lane = tid & 63, gw = blockIdx.x * 8 + (tid >> 6), nw = gridDim.x * 8;
    const int fr = lane & 15, fq = lane >> 4;
    if ((gw & 3) != 0) return;
    for (int job = gw >> 2; job < NTOK / 16; job += (nw >> 2)) {
        const bf16_t* ap = h + (size_t)(job * 16 + fr) * DM + fq * 8; const bf16_t* bp = wft + (size_t)fr * DM + fq * 8;
        f32x4 acc = {0.f, 0.f, 0.f, 0.f};
#pragma unroll 8
        for (int k = 0; k < DM; k += 32) { const bf16x8 a = *(const bf16x8*)(ap + k), b = *(const bf16x8*)(bp + k); acc = __builtin_amdgcn_mfma_f32_16x16x32_bf16(a, b, acc, 0, 0, 0); }
        const float bb = bfv[fr];
#pragma unroll
        for (int j = 0; j < 4; ++j) { const float u = acc[j] + bb; logf[(size_t)(job * 16 + fq * 4 + j) * 16 + fr] = -(fmaxf(-u, 0.f) + log1pf(__expf(-fabsf(u)))); }
    }
}

__device__ __forceinline__ void fox_prep_phase(bf16_t* __restrict__ qk  , const float* __restrict__ qg, const float* __restrict__ kg, const float* __restrict__ logf, float* __restrict__ cf) {
    const int tid = opq(threadIdx.x), lane = tid & 63, gw = blockIdx.x * 8 + (tid >> 6), nw = gridDim.x * 8;
    const int sub = lane >> 4, l16 = lane & 15;
    const int nrows = 2 * NTOK * NH;
    for (int r0 = gw * 4; r0 < nrows; r0 += nw * 4) {
        const int row = r0 + sub; const bool isk = row >= NTOK * NH;
        bf16_t* p = qk + (size_t)row * HD + l16 * 8;
        const u32x4 w = *(const u32x4*)p; float v[8] = {bflo(w.x), bfhi(w.x), bflo(w.y), bfhi(w.y), bflo(w.z), bfhi(w.z), bflo(w.w), bfhi(w.w)};
        float ss = 0.f;
#pragma unroll
        for (int i = 0; i < 8; ++i) ss += v[i] * v[i];
        ss = sum16(ss); const float rs = rsqrtf(ss * (1.f / HD) + EPS);
        const float* gp = (isk ? kg : qg) + l16 * 8; const f32x4 g0 = *(const f32x4*)gp, g1 = *(const f32x4*)(gp + 4);
        u32x4 o; o.x = cvtpk(v[0] * rs * g0[0], v[1] * rs * g0[1]); o.y = cvtpk(v[2] * rs * g0[2], v[3] * rs * g0[3]);
        o.z = cvtpk(v[4] * rs * g1[0], v[5] * rs * g1[1]); o.w = cvtpk(v[6] * rs * g1[2], v[7] * rs * g1[3]);
        *(u32x4*)p = o;
    }
    for (int bh = blockIdx.x; bh < 64; bh += gridDim.x) {
        if ((threadIdx.x >> 6) != 0) continue;
        const int b = bh >> 4, hd = bh & 15; const float* lp = logf + (size_t)(b * SEQ + lane * 32) * 16 + hd;
        float v[32]; float tot = 0.f;
#pragma unroll
        for (int i = 0; i < 32; ++i) { tot += lp[(size_t)i * 16]; v[i] = tot; }
        float inc = tot;
#pragma unroll
        for (int o = 1; o < 64; o <<= 1) { const float up = __shfl_up(inc, o); if (lane >= o) inc += up; }
        const float base = inc - tot;
        float* cp = cf + (size_t)bh * SEQ + lane * 32;
#pragma unroll
        for (int i = 0; i < 32; ++i) cp[i] = base + v[i];
    }
}

__device__ __forceinline__ void mla_prep1_phase(const bf16_t* __restrict__ down, const int* __restrict__ pos, const float* __restrict__ qn, const float* __restrict__ kvn,
                                                bf16_t* __restrict__ cq, bf16_t* __restrict__ ckv, float* __restrict__ ropet, float* __restrict__ kr) {
    const int tid = opq(threadIdx.x), lane = tid & 63, gw = blockIdx.x * 8 + (tid >> 6), nw = gridDim.x * 8;
    for (int row = gw; row < NTOK; row += nw) {
        const bf16_t* dr = down + (size_t)row * MLA_DOWN_PAD;
        {   float v[12]; float ss = 0.f;
#pragma unroll
            for (int j = 0; j < 3; ++j) { const u32x2 w = *(const u32x2*)(dr + j * 256 + lane * 4); v[4 * j] = bflo(w.x); v[4 * j + 1] = bfhi(w.x); v[4 * j + 2] = bflo(w.y); v[4 * j + 3] = bfhi(w.y); }
#pragma unroll
            for (int i = 0; i < 12; ++i) ss += v[i] * v[i];
            ss = wave_sum(ss); const float rs = rsqrtf(ss * (1.f / MLA_QR) + EPS);
#pragma unroll
            for (int j = 0; j < 3; ++j) { const f32x4 g = *(const f32x4*)(qn + j * 256 + lane * 4);
                u32x2 w; w.x = cvtpk(v[4 * j] * rs * g[0], v[4 * j + 1] * rs * g[1]); w.y = cvtpk(v[4 * j + 2] * rs * g[2], v[4 * j + 3] * rs * g[3]);
                *(u32x2*)(cq + (size_t)row * MLA_QR + j * 256 + lane * 4) = w; } }
        {   float v[8]; float ss = 0.f;
#pragma unroll
            for (int j = 0; j < 2; ++j) { const u32x2 w = *(const u32x2*)(dr + MLA_QR + j * 256 + lane * 4); v[4 * j] = bflo(w.x); v[4 * j + 1] = bfhi(w.x); v[4 * j + 2] = bflo(w.y); v[4 * j + 3] = bfhi(w.y); }
#pragma unroll
            for (int i = 0; i < 8; ++i) ss += v[i] * v[i];
            ss = wave_sum(ss); const float rs = rsqrtf(ss * (1.f / MLA_KVR) + EPS);
#pragma unroll
            for (int j = 0; j < 2; ++j) { const f32x4 g = *(const f32x4*)(kvn + j * 256 + lane * 4);
                u32x2 w; w.x = cvtpk(v[4 * j] * rs * g[0], v[4 * j + 1] * rs * g[1]); w.y = cvtpk(v[4 * j + 2] * rs * g[2], v[4 * j + 3] * rs * g[3]);
                *(u32x2*)(ckv + (size_t)row * MLA_KVR + j * 256 + lane * 4) = w; } }
        if (lane < 32) {
            const float invf = powf(10000.0f, -(float)(2 * lane) / 64.0f);
            const float ang = (float)pos[row] * invf; const float cs = cosf(ang), sn = sinf(ang);
            ropet[(size_t)row * 64 + lane] = cs; ropet[(size_t)row * 64 + 32 + lane] = sn;
            const float x1 = __uint_as_float((unsigned)dr[MLA_QR + MLA_KVR + lane] << 16), x2 = __uint_as_float((unsigned)dr[MLA_QR + MLA_KVR + 32 + lane] << 16);
            kr[(size_t)row * 64 + lane] = x1 * cs - x2 * sn; kr[(size_t)row * 64 + 32 + lane] = x1 * sn + x2 * cs;
        }
    }
}

__device__ __forceinline__ void mla_prep2_phase(const bf16_t* __restrict__ qup, const bf16_t* __restrict__ kv, const float* __restrict__ ropet, const float* __restrict__ kr,
                                                const float* __restrict__ qg, const float* __restrict__ kg, bf16_t* __restrict__ Qn, bf16_t* __restrict__ Kn) {
    const int tid = opq(threadIdx.x), lane = tid & 63, gw = blockIdx.x * 8 + (tid >> 6), nw = gridDim.x * 8;
    const int sub = lane >> 4, j = lane & 15;
    const int nrows = 2 * NTOK * NH;
    for (int r0 = gw * 4; r0 < nrows; r0 += nw * 4) {
        int row = r0 + sub; const bool isk = row >= NTOK * NH; if (isk) row -= NTOK * NH;
        const int tok = row >> 4, hd = row & 15;
        float v[8], ra[2], rb[2];
        if (!isk) {
            const bf16_t* p = qup + (size_t)tok * 3072 + hd * 192;
            const u32x4 w = *(const u32x4*)(p + j * 8);
            v[0] = bflo(w.x); v[1] = bfhi(w.x); v[2] = bflo(w.y); v[3] = bfhi(w.y); v[4] = bflo(w.z); v[5] = bfhi(w.z); v[6] = bflo(w.w); v[7] = bfhi(w.w);
            const unsigned w1 = *(const unsigned*)(p + 128 + 2 * j), w2 = *(const unsigned*)(p + 160 + 2 * j);
            const float x1a = bflo(w1), x1b = bfhi(w1), x2a = bflo(w2), x2b = bfhi(w2);
            const float* rt = ropet + (size_t)tok * 64; const float c0 = rt[2 * j], c1 = rt[2 * j + 1], s0 = rt[32 + 2 * j], s1 = rt[32 + 2 * j + 1];
            ra[0] = x1a * c0 - x2a * s0; ra[1] = x1b * c1 - x2b * s1; rb[0] = x1a * s0 + x2a * c0; rb[1] = x1b * s1 + x2b * c1;
        } else {
            const bf16_t* p = kv + (size_t)tok * 4096 + hd * 256;
            const u32x4 w = *(const u32x4*)(p + j * 8);
            v[0] = bflo(w.x); v[1] = bfhi(w.x); v[2] = bflo(w.y); v[3] = bfhi(w.y); v[4] = bflo(w.z); v[5] = bfhi(w.z); v[6] = bflo(w.w); v[7] = bfhi(w.w);
            const float* kp = kr + (size_t)tok * 64; ra[0] = kp[2 * j]; ra[1] = kp[2 * j + 1]; rb[0] = kp[32 + 2 * j]; rb[1] = kp[32 + 2 * j + 1];
        }
        float ss = ra[0] * ra[0] + ra[1] * ra[1] + rb[0] * rb[0] + rb[1] * rb[1];
#pragma unroll
        for (int i = 0; i < 8; ++i) ss += v[i] * v[i];
        ss = sum16(ss); const float rs = rsqrtf(ss * (1.f / MLA_QK) + EPS);
        const float* g = isk ? kg : qg; const f32x4 g0 = *(const f32x4*)(g + j * 8), g1 = *(const f32x4*)(g + j * 8 + 4);
        bf16_t* o = (isk ? Kn : Qn) + (size_t)tok * 3072 + hd * 192;
        u32x4 ow; ow.x = cvtpk(v[0] * rs * g0[0], v[1] * rs * g0[1]); ow.y = cvtpk(v[2] * rs * g0[2], v[3] * rs * g0[3]);
        ow.z = cvtpk(v[4] * rs * g1[0], v[5] * rs * g1[1]); ow.w = cvtpk(v[6] * rs * g1[2], v[7] * rs * g1[3]);
        *(u32x4*)(o + j * 8) = ow;
        *(unsigned*)(o + 128 + 2 * j) = cvtpk(ra[0] * rs * g[128 + 2 * j], ra[1] * rs * g[128 + 2 * j + 1]);
        *(unsigned*)(o + 160 + 2 * j) = cvtpk(rb[0] * rs * g[160 + 2 * j], rb[1] * rs * g[160 + 2 * j + 1]);
    }
}

__device__ __forceinline__ int v_st(int k, int c) { const int kk = (k & ~0xC) | ((k & 4) << 1) | ((k & 8) >> 1); return ((kk >> 3) * 4 + (c >> 5)) * 512 + ((kk & 7) * 32 + (c & 31)) * 2; }
__device__ __forceinline__ int v_rd_base(int lane) { return ((lane & 3) << 3) | (((lane >> 2) & 3) << 6) | (((lane >> 4) & 1) << 5) | (((lane >> 5) & 1) << 8); }
constexpr int v_rd_off(int d0, int ks, int half) { return d0 * 512 + ks * 4096 + half * 2048; }
__device__ __forceinline__ int crow(int r, int hi) { return (r & 3) + 8 * (r >> 2) + 4 * hi; }

constexpr int AT_SHM_V = 16384, AT_KBUF = 24576;
constexpr int AT_OFF_K = 2 * AT_SHM_V, AT_OFF_WS = AT_OFF_K + 2 * AT_KBUF, AT_OFF_CF = AT_OFF_WS + 2048;

#ifdef TESTB
#define SB_LG(y) fmaxf(1.f - 0.5f * fabsf(y), 0.f)
#else
#define SB_LG(y) __builtin_amdgcn_logf(1.f + __builtin_amdgcn_exp2f(-fabsf(y)))
#endif
#ifndef SB_BLOCK_EXIT
#define SB_BLOCK_EXIT 0
#endif
template <int DQK, int MODE>
__device__ __forceinline__ void attn_block(const bf16_t* __restrict__ Qg, int ldq, const bf16_t* __restrict__ Kg, int ldk, const bf16_t* __restrict__ Vg, int ldv,
                                           bf16_t* __restrict__ Og, int ldo, int q0, float C2, LAS unsigned char* lds) {
    constexpr int NQ = DQK / 16, ROWB = DQK * 2, SHM_K = 64 * ROWB, NCH = DQK / 8, KCH = NCH / 8;
    const int tid = opq(threadIdx.x), wid = __builtin_amdgcn_readfirstlane(tid >> 6), lane = tid & 63, r32 = lane & 31, hi = lane >> 5;
    LAS unsigned char* V_lds = lds; LAS unsigned char* K_lds = lds + AT_OFF_K;
    LAS float* li_l = (LAS float*)(lds + AT_OFF_WS) + wid * 64; LAS float* al_l = li_l + 32;
    const LAS float* cfl = (const LAS float*)(lds + AT_OFF_CF);
    const int qlo = q0 + wid * 32, trow = qlo + r32;
    bf16x8 qr[NQ];
#pragma unroll
    for (int d0 = 0; d0 < NQ; ++d0) qr[d0] = *(const bf16x8*)(Qg + (size_t)trow * ldq + d0 * 16 + hi * 8);
    const int NT = q0 / 64 + 4;
    int kso[KCH], vso[2];
#pragma unroll
    for (int i = 0; i < KCH; ++i) { const int L = (i * 8 + wid) * 1024 + lane * 16, row = L / ROWB, wi = L % ROWB; kso[i] = row * ldk + ((wi ^ ((row & 7) << 4)) >> 1); }
#pragma unroll
    for (int i = 0; i < 2; ++i) { const int L = (i * 8 + wid) * 1024 + lane * 16, sub = L >> 9, we = (L & 511) >> 1, kk = (sub >> 2) * 8 + (we >> 5), c = (sub & 3) * 32 + (we & 31);
        const int k = (kk & ~0xC) | ((kk & 4) << 1) | ((kk & 8) >> 1); vso[i] = k * ldv + c; }
#define AT_DMA(kb_, buf_) do { const bf16_t* kp_ = Kg + (size_t)(kb_) * ldk; const bf16_t* vp_ = Vg + (size_t)(kb_) * ldv; \
        _Pragma("unroll") for (int i_ = 0; i_ < KCH; ++i_) __builtin_amdgcn_global_load_lds((const unsigned*)(kp_ + kso[i_]), (LAS unsigned*)(K_lds + (buf_) * SHM_K + (i_ * 8 + wid) * 1024), 16, 0, 0); \
        _Pragma("unroll") for (int i_ = 0; i_ < 2; ++i_) __builtin_amdgcn_global_load_lds((const unsigned*)(vp_ + vso[i_]), (LAS unsigned*)(V_lds + (buf_) * AT_SHM_V + (i_ * 8 + wid) * 1024), 16, 0, 0); } while (0)
#if ATT_DMA
    AT_DMA((NT - 1) * 64, 0);
    asm volatile("s_waitcnt vmcnt(0)" ::: "memory");
    __syncthreads();
#else
    bf16x8 stk[KCH], stv[2];
    const int vk = tid >> 4, vc = (tid & 15) * 8;
#define AT_LOAD(kb_) do { _Pragma("unroll") for (int i_ = 0; i_ < KCH; ++i_) { const int c_ = tid + 512 * i_, row_ = c_ / NCH, cc_ = c_ % NCH; stk[i_] = *(const bf16x8*)(Kg + (size_t)((kb_) + row_) * ldk + cc_ * 8); } \
        _Pragma("unroll") for (int i_ = 0; i_ < 2; ++i_) stv[i_] = *(const bf16x8*)(Vg + (size_t)((kb_) + vk + 32 * i_) * ldv + vc); } while (0)
#define AT_WRITE(buf_) do { _Pragma("unroll") for (int i_ = 0; i_ < KCH; ++i_) { const int c_ = tid + 512 * i_, row_ = c_ / NCH, cc_ = c_ % NCH; \
            *(LAS bf16x8*)(K_lds + (buf_) * SHM_K + row_ * ROWB + ((cc_ * 16) ^ ((row_ & 7) << 4))) = stk[i_]; } \
        _Pragma("unroll") for (int i_ = 0; i_ < 2; ++i_) *(LAS bf16x8*)(V_lds + (buf_) * AT_SHM_V + v_st(vk + 32 * i_, vc)) = stv[i_]; } while (0)
    AT_LOAD((NT - 1) * 64); AT_WRITE(0);
    if (NT > 1) AT_LOAD((NT - 2) * 64);
    __syncthreads();
#endif
    f32x16 o[4];
#pragma unroll
    for (int d = 0; d < 4; ++d)
#pragma unroll
        for (int r = 0; r < 16; ++r) o[d][r] = 0.f;
    float m_reg = -1e30f, l_reg = 0.f, carry = 0.f;
    float cft = 0.f; if (MODE == 1) cft = cfl[trow];
    int koff[4];
#pragma unroll
    for (int dd = 0; dd < 4; ++dd) koff[dd] = r32 * ROWB + ((dd * 32 + hi * 16) ^ ((r32 & 7) << 4));
    const int vbase = (int)(uintptr_t)V_lds + v_rd_base(lane);
    bool wdone = false;
    LAS unsigned* dflag = (LAS unsigned*)(lds + AT_OFF_CF);
    for (int it = 0; it < NT; ++it) {
        const int kb = (NT - 1 - it) * 64, cur = it & 1;
        bool alld = false;
        if (MODE == 0 && it > 0) {
            const LAS unsigned* fp = dflag + ((it - 1) & 1) * 8; const u32x4 f0 = *(const LAS u32x4*)fp, f1 = *(const LAS u32x4*)(fp + 4);
            alld = __builtin_amdgcn_readfirstlane(f0.x & f0.y & f0.z & f0.w & f1.x & f1.y & f1.z & f1.w) != 0u;
        }
        const bool act = (kb <= qlo + 31) && !wdone;
#if ATT_DMA
        if (it + 1 < NT && !alld) AT_DMA(kb - 64, cur ^ 1);
#endif
        if (act) {
            f32x16 p0, p1;
#pragma unroll
            for (int r = 0; r < 16; ++r) { p0[r] = 0.f; p1[r] = 0.f; }
            const LAS unsigned char* kbase = K_lds + cur * SHM_K;
#pragma unroll
            for (int dg = 0; dg < NQ / 4; ++dg) {
                bf16x8 kf0[4], kf1[4];
#pragma unroll
                for (int dd = 0; dd < 4; ++dd) { const LAS unsigned char* a = kbase + koff[dd] + dg * 128; kf0[dd] = *(const LAS bf16x8*)a; kf1[dd] = *(const LAS bf16x8*)(a + 32 * ROWB); }
#pragma unroll
                for (int dd = 0; dd < 4; ++dd) { p0 = __builtin_amdgcn_mfma_f32_32x32x16_bf16(kf0[dd], qr[dg * 4 + dd], p0, 0, 0, 0); p1 = __builtin_amdgcn_mfma_f32_32x32x16_bf16(kf1[dd], qr[dg * 4 + dd], p1, 0, 0, 0); }
                __builtin_amdgcn_sched_barrier(0);
            }
            const int dq = trow - kb - 4 * hi;
            if (MODE == 0) {
                const bool needm = kb + 63 >= qlo;
                f32x16 lkA, lkB;
#pragma unroll
                for (int r = 0; r < 16; ++r) { p0[r] *= C2; p1[r] *= C2; }
#pragma unroll
                for (int r = 0; r < 16; ++r) { lkA[r] = __builtin_amdgcn_exp2f(-fabsf(p0[r])); lkB[r] = __builtin_amdgcn_exp2f(-fabsf(p1[r])); }
                __builtin_amdgcn_sched_barrier(0);
#pragma unroll
                for (int r = 0; r < 16; ++r) { lkA[r] += 1.f; lkB[r] += 1.f; }
                __builtin_amdgcn_sched_barrier(0);
#pragma unroll
                for (int r = 0; r < 16; ++r) { lkA[r] = __builtin_amdgcn_logf(lkA[r]); lkB[r] = __builtin_amdgcn_logf(lkB[r]); }
                __builtin_amdgcn_sched_barrier(0);
#pragma unroll
                for (int r = 0; r < 16; ++r) { const int c = (r & 3) + 8 * (r >> 2);
                    { const float y = p0[r]; const float sp = fmaxf(y, 0.f) + lkA[r];
                      float lk = -sp, lb = y - sp; if (needm && !(c < dq)) { lk = 0.f; lb = -__builtin_inff(); } lkA[r] = lk; p0[r] = lb; }
                    { const float y = p1[r]; const float sp = fmaxf(y, 0.f) + lkB[r];
                      float lk = -sp, lb = y - sp; if (needm && !(c + 32 < dq)) { lk = 0.f; lb = -__builtin_inff(); } lkB[r] = lk; p1[r] = lb; } }
                __builtin_amdgcn_sched_barrier(0);
                float pairs[8], oddv[8];
#pragma unroll
                for (int g = 0; g < 8; ++g) { const float gs = (g < 4) ? (lkA[4 * g] + lkA[4 * g + 1]) + (lkA[4 * g + 2] + lkA[4 * g + 3]) : (lkB[4 * (g - 4)] + lkB[4 * (g - 4) + 1]) + (lkB[4 * (g - 4) + 2] + lkB[4 * (g - 4) + 3]);
#ifdef TESTA
                    const float e = gs, od = gs * 0.5f;
#else
                    auto rr = __builtin_amdgcn_permlane32_swap(__float_as_uint(gs), __float_as_uint(gs), false, false);
                    const float e = __uint_as_float(rr[0]), od = __uint_as_float(rr[1]);
#endif
                    pairs[g] = e + od; oddv[g] = hi ? 0.f : od; }
                float run = carry;
#pragma unroll
                for (int g = 7; g >= 0; --g) {
                    const float base = run + oddv[g];
                    if (g < 4) { const int b = 4 * g; const float l3 = base, l2 = l3 + lkA[b + 3], l1 = l2 + lkA[b + 2], l0 = l1 + lkA[b + 1];
                        p0[b] = __builtin_amdgcn_exp2f(p0[b] + l0); p0[b + 1] = __builtin_amdgcn_exp2f(p0[b + 1] + l1); p0[b + 2] = __builtin_amdgcn_exp2f(p0[b + 2] + l2); p0[b + 3] = __builtin_amdgcn_exp2f(p0[b + 3] + l3); }
                    else { const int b = 4 * (g - 4); const float l3 = base, l2 = l3 + lkB[b + 3], l1 = l2 + lkB[b + 2], l0 = l1 + lkB[b + 1];
                        p1[b] = __builtin_amdgcn_exp2f(p1[b] + l0); p1[b + 1] = __builtin_amdgcn_exp2f(p1[b + 1] + l1); p1[b + 2] = __builtin_amdgcn_exp2f(p1[b + 2] + l2); p1[b + 3] = __builtin_amdgcn_exp2f(p1[b + 3] + l3); }
                    run += pairs[g];
                }
                carry = run;
                __builtin_amdgcn_sched_barrier(0);
            } else {
                if (MODE == 1) {
#pragma unroll
                    for (int g = 0; g < 4; ++g) { const f32x4 c0 = *(const LAS f32x4*)(cfl + kb + 8 * g + 4 * hi), c1 = *(const LAS f32x4*)(cfl + kb + 32 + 8 * g + 4 * hi);
#pragma unroll
                        for (int i = 0; i < 4; ++i) { p0[4 * g + i] = fmaf(p0[4 * g + i], C2, cft - c0[i]); p1[4 * g + i] = fmaf(p1[4 * g + i], C2, cft - c1[i]); } }
                } else {
#pragma unroll
                    for (int r = 0; r < 16; ++r) { p0[r] *= C2; p1[r] *= C2; }
                }
                if (kb + 63 > qlo) {
#pragma unroll
                    for (int r = 0; r < 16; ++r) { const int c = (r & 3) + 8 * (r >> 2); if (!(c <= dq)) p0[r] = -__builtin_inff(); if (!(c + 32 <= dq)) p1[r] = -__builtin_inff(); }
                }
                float pmax = p0[0];
#pragma unroll
                for (int r = 1; r < 16; ++r) pmax = fmaxf(pmax, p0[r]);
#pragma unroll
                for (int r = 0; r < 16; ++r) pmax = fmaxf(pmax, p1[r]);
                { auto rr = __builtin_amdgcn_permlane32_swap(__float_as_uint(pmax), __float_as_uint(pmax), false, false); pmax = fmaxf(__uint_as_float(rr[0]), __uint_as_float(rr[1])); }
                const float mn = fmaxf(m_reg, pmax); const float alpha = __builtin_amdgcn_exp2f(m_reg - mn); m_reg = mn;
                float ps = 0.f;
#pragma unroll
                for (int r = 0; r < 16; ++r) { p0[r] = __builtin_amdgcn_exp2f(p0[r] - mn); p1[r] = __builtin_amdgcn_exp2f(p1[r] - mn); ps += p0[r] + p1[r]; }
                { auto rr = __builtin_amdgcn_permlane32_swap(__float_as_uint(ps), __float_as_uint(ps), false, false); ps = __uint_as_float(rr[0]) + __uint_as_float(rr[1]); }
                l_reg = l_reg * alpha + ps;
                if (__any(alpha < 1.f)) {
                    if (hi == 0) al_l[r32] = alpha;
                    asm volatile("s_waitcnt lgkmcnt(0)" ::: "memory");
#pragma unroll
                    for (int g = 0; g < 4; ++g) { const f32x4 av = *(const LAS f32x4*)(al_l + 8 * g + 4 * hi);
#pragma unroll
                        for (int d = 0; d < 4; ++d)
#pragma unroll
                            for (int i = 0; i < 4; ++i) o[d][4 * g + i] *= av[i]; }
                }
            }
            bf16x8 pa0, pa1, pa2, pa3;
#define PK4(P, B_, OUT) do { unsigned a0 = cvtpk(P[B_+0], P[B_+1]), a1 = cvtpk(P[B_+2], P[B_+3]); unsigned b0 = cvtpk(P[B_+4], P[B_+5]), b1 = cvtpk(P[B_+6], P[B_+7]); \
        auto r0 = __builtin_amdgcn_permlane32_swap(a0, b0, false, false); auto r1 = __builtin_amdgcn_permlane32_swap(a1, b1, false, false); \
        u32x4 w = {r0[0], r1[0], r0[1], r1[1]}; OUT = *reinterpret_cast<bf16x8*>(&w); } while (0)
            PK4(p0, 0, pa0); PK4(p0, 8, pa1); PK4(p1, 0, pa2); PK4(p1, 8, pa3);
#undef PK4
            const int vb0 = vbase + cur * AT_SHM_V;
#define TRRD(dst, off) asm volatile("ds_read_b64_tr_b16 %0, %1 offset:%2" : "=&v"(dst) : "v"(vb0), "i"(off) : "memory")
#define PV_D0(d0) do { s16x4 l0, l1, l2, l3, h0, h1, h2, h3; constexpr int b_ = v_rd_off(d0, 0, 0); \
        TRRD(l0, b_); TRRD(h0, b_ + 2048); TRRD(l1, b_ + 4096); TRRD(h1, b_ + 6144); TRRD(l2, b_ + 8192); TRRD(h2, b_ + 10240); TRRD(l3, b_ + 12288); TRRD(h3, b_ + 14336); \
        asm volatile("s_waitcnt lgkmcnt(0)" ::: "memory"); __builtin_amdgcn_sched_barrier(0); \
        o[d0] = __builtin_amdgcn_mfma_f32_32x32x16_bf16(pa0, (bf16x8){l0[0], l0[1], l0[2], l0[3], h0[0], h0[1], h0[2], h0[3]}, o[d0], 0, 0, 0); \
        o[d0] = __builtin_amdgcn_mfma_f32_32x32x16_bf16(pa1, (bf16x8){l1[0], l1[1], l1[2], l1[3], h1[0], h1[1], h1[2], h1[3]}, o[d0], 0, 0, 0); \
        o[d0] = __builtin_amdgcn_mfma_f32_32x32x16_bf16(pa2, (bf16x8){l2[0], l2[1], l2[2], l2[3], h2[0], h2[1], h2[2], h2[3]}, o[d0], 0, 0, 0); \
        o[d0] = __builtin_amdgcn_mfma_f32_32x32x16_bf16(pa3, (bf16x8){l3[0], l3[1], l3[2], l3[3], h3[0], h3[1], h3[2], h3[3]}, o[d0], 0, 0, 0); } while (0)
            PV_D0(0); PV_D0(1); PV_D0(2); PV_D0(3);
#undef PV_D0
#undef TRRD
        }
        if (MODE == 0) { if (kb <= qlo + 31) wdone = __all(carry < -152.f) != 0; if (lane == 0) dflag[(it & 1) * 8 + wid] = wdone ? 1u : 0u; }
#if ATT_DMA
        asm volatile("s_waitcnt vmcnt(0)" ::: "memory");
#else
        if (it + 1 < NT) { AT_WRITE(cur ^ 1); if (it + 2 < NT) AT_LOAD((NT - 3 - it) * 64); }
#endif
        __syncthreads();
    }
#undef AT_DMA
    float rli[16];
    if (MODE != 0) {
        if (hi == 0) li_l[r32] = l_reg;
        asm volatile("s_waitcnt lgkmcnt(0)" ::: "memory");
#pragma unroll
        for (int g = 0; g < 4; ++g) { const f32x4 lv = *(const LAS f32x4*)(li_l + 8 * g + 4 * hi);
#pragma unroll
            for (int i = 0; i < 4; ++i) rli[4 * g + i] = 1.0f / lv[i]; }
    } else {
#pragma unroll
        for (int r = 0; r < 16; ++r) rli[r] = 1.f;
    }
    bf16_t* Ow = Og + (size_t)qlo * ldo;
#pragma unroll
    for (int r = 0; r < 16; ++r) { const int orow = crow(r, hi);
#pragma unroll
        for (int d0 = 0; d0 < 4; ++d0) { const float v = o[d0][r] * rli[r]; const float vn = __shfl_xor(v, 1);
            if ((r32 & 1) == 0) *(unsigned*)(Ow + (size_t)orow * ldo + d0 * 32 + r32) = cvtpk(v, vn); } }
}

template <int DQK, int MODE>
__device__ __forceinline__ void attn_phase(const bf16_t* Qb, int ldq, int hq, const bf16_t* Kb, int ldk, int hk, const bf16_t* Vb, int ldv, int hv, bf16_t* Ob, const float* cf, float C2, LAS unsigned char* lds) {
#ifdef TESTCOPY
    if (MODE == 0) {
        for (size_t i = (size_t)blockIdx.x * 512 + threadIdx.x; i < (size_t)NTOK * DM; i += (size_t)gridDim.x * 512) {
            const float a = __uint_as_float((unsigned)Qb[i] << 16) + __uint_as_float((unsigned)Kb[i] << 16) + __uint_as_float((unsigned)Vb[i] << 16);
            Ob[i] = (bf16_t)(__float_as_uint(sinf(300.f * a)) >> 16); }
        return;
    }
#endif
#ifdef TESTNAN
    for (int i = threadIdx.x; i < LDS_BYTES / 4; i += 512) ((LAS unsigned*)lds)[i] = 0xFFFFFFFFu;
    __syncthreads();
#endif
    for (int w = blockIdx.x; w < 256; w += gridDim.x) {
        const int xcd = w & 7, slot = w >> 3, bh = xcd * 8 + (slot >> 2), y = slot & 3, b = bh >> 4, hd = bh & 15;
        if (MODE == 1) { LAS float* cfl = (LAS float*)(lds + AT_OFF_CF);
            for (int s = threadIdx.x; s < SEQ; s += 512) cfl[s] = cf[(size_t)bh * SEQ + s] * LOG2E;
            __syncthreads(); }
        const bf16_t* Q = Qb + (size_t)b * SEQ * ldq + hd * hq; const bf16_t* K = Kb + (size_t)b * SEQ * ldk + hd * hk; const bf16_t* V = Vb + (size_t)b * SEQ * ldv + hd * hv;
        bf16_t* O = Ob + (size_t)b * SEQ * DM + hd * HD;
        attn_block<DQK, MODE>(Q, ldq, K, ldk, V, ldv, O, DM, (7 - y) * 256, C2, lds);
        attn_block<DQK, MODE>(Q, ldq, K, ldk, V, ldv, O, DM, y * 256, C2, lds);
        __syncthreads();
    }
}

#define XB_TMO      128
#define XB_XCNT(j)  (256  + 64 * (j))
#define XB_XSUB(j)  (1280 + 64 * (j))
#define XB_XGEN(j)  (2304 + 64 * (j))
#define XB_TOP      3328
#define XB_TOPGEN   3392
#define XCD_BAR_WORDS 3456
#define XB_SPIN_CAP (1u << 18)
__device__ __forceinline__ unsigned xb_ld(unsigned* p)              { return __hip_atomic_load(p, __ATOMIC_RELAXED, __HIP_MEMORY_SCOPE_AGENT); }
__device__ __forceinline__ unsigned xb_add(unsigned* p, unsigned v) { return __hip_atomic_fetch_add(p, v, __ATOMIC_RELAXED, __HIP_MEMORY_SCOPE_AGENT); }
__device__ __forceinline__ unsigned xb_xcc_id() { return (unsigned)__builtin_amdgcn_s_getreg((3 << 11) | 20) & 0xFu; }
#define XB_SPIN(cond, bar) do { unsigned _sp = 0; while (cond) { __builtin_amdgcn_s_sleep(1); \
    if ((++_sp & 255u) == 0u) { if (xb_ld(&(bar)[XB_TMO])) break; if (_sp > XB_SPIN_CAP) { atomicAdd(&(bar)[XB_TMO], 1u); break; } } } } while (0)
struct XcdBarrier { unsigned* bar; unsigned x; volatile LAS unsigned* st; };
__device__ __forceinline__ XcdBarrier xcd_barrier_post(unsigned* bar, volatile LAS unsigned* st) {
    XcdBarrier b; b.bar = bar; b.x = xb_xcc_id(); b.st = st;
    if (threadIdx.x == 0) (void)xb_add(&bar[XB_XCNT(b.x)], 1u);
    return b;
}
__device__ __forceinline__ void xcd_barrier_complete(unsigned* bar, unsigned x, unsigned& nloc, unsigned& nx) {
    const unsigned G = gridDim.x * gridDim.y * gridDim.z;
    unsigned sum, cnt, mine, sp = 0u;
    for (;;) {
        sum = 0u; cnt = 0u; mine = 0u;
#pragma unroll
        for (unsigned j = 0; j < 16; ++j) { const unsigned c = xb_ld(&bar[XB_XCNT(j)]); sum += c; cnt += (c > 0u) ? 1u : 0u; mine = (j == x) ? c : mine; }
        if (sum == G) break;
        __builtin_amdgcn_s_sleep(1);
        if ((++sp & 255u) == 0u) { if (xb_ld(&bar[XB_TMO])) break; if (sp > XB_SPIN_CAP) { atomicAdd(&bar[XB_TMO], 1u); break; } }
    }
    nloc = mine > 0u ? mine : 1u; nx = cnt > 0u ? cnt : 1u;
}
__device__ __forceinline__ void xcd_barrier(const XcdBarrier& b) {
    asm volatile("s_waitcnt vmcnt(0)" ::: "memory");
    __syncthreads();
    if (threadIdx.x == 0) {
        unsigned* bar = b.bar;
        __builtin_amdgcn_s_waitcnt(0);
        unsigned nloc = b.st[0], nx = b.st[1];
        if (nloc == 0u) { xcd_barrier_complete(bar, b.x, nloc, nx); b.st[0] = nloc; b.st[1] = nx; }
        const unsigned old = xb_add(&bar[XB_XSUB(b.x)], 1u);
        const unsigned gen = old / nloc;
        if (old + 1u == (gen + 1u) * nloc) {
            __builtin_amdgcn_fence(__ATOMIC_RELEASE, "agent");
            asm volatile("s_waitcnt vmcnt(0)" ::: "memory");
            const unsigned og = xb_add(&bar[XB_TOP], 1u);
            const unsigned tg = og / nx;
            if (og + 1u == (tg + 1u) * nx) xb_add(&bar[XB_TOPGEN], 1u);
            else XB_SPIN(xb_ld(&bar[XB_TOPGEN]) == tg, bar);
            __builtin_amdgcn_fence(__ATOMIC_ACQUIRE, "agent");
            xb_add(&bar[XB_XGEN(b.x)], 1u);
            asm volatile("s_waitcnt vmcnt(0)" ::: "memory");
        } else {
            XB_SPIN(xb_ld(&bar[XB_XGEN(b.x)]) == gen, bar);
            __builtin_amdgcn_fence(__ATOMIC_ACQUIRE, "agent");
            asm volatile("s_waitcnt vmcnt(0)" ::: "memory");
        }
    }
    __syncthreads();
}

#ifndef NLAYERS
#define NLAYERS 4
#endif
constexpr int N_PHASES = 1 + 10 * NLAYERS;
__host__ __device__ inline bool phase_active(int ph) {
    if (ph == 0) return true;
    const int layer = (ph - 1) / 10, s = (ph - 1) % 10, kind = layer % 3;
    if (s == 2) return kind != 0;
    if (s == 3 || s == 4) return kind == 2;
    return true;
}

__global__ void __launch_bounds__(512, 2) fwd_megakernel(Params p) {
    extern __shared__ __attribute__((aligned(16))) unsigned char shm_raw[];
    LAS unsigned char* lds = (LAS unsigned char*)shm_raw;
    unsigned char* ws = p.ws;
    float* X = (float*)(ws + WS_X); bf16_t* H = (bf16_t*)(ws + WS_H); bf16_t* AO = p.alt ? (bf16_t*)(ws + WS_SCR + (size_t)NTOK * DFF * 2) : (bf16_t*)(ws + WS_AO);
    float* LOGF = (float*)(ws + WS_LOGF); float* CF = (float*)(ws + WS_CF); float* ROPE = (float*)(ws + WS_ROPE); float* KR = (float*)(ws + WS_KR);
    unsigned char* scr = ws + WS_SCR;
    bool first = true;
#if COOP
    volatile LAS unsigned* st = (volatile LAS unsigned*)(lds + 131072);
    if (threadIdx.x == 0) { st[0] = 0u; st[1] = 0u; }
    __syncthreads();
    const XcdBarrier xb = xcd_barrier_post((unsigned*)(ws + WS_BAR), st);
    int nsync = 0;
#endif
    for (int ph = (int)p.ph_lo; ph < (int)p.ph_hi; ++ph) {
        if (!phase_active(ph)) continue;
#if COOP
        if (!first) { if (nsync == 0) cg::this_grid().sync(); else xcd_barrier(xb); ++nsync; }
#endif
        first = false;
        if (ph == 0) { if (EN(100)) {
            for (int j = 0; j < 2; ++j) {
                conv_job(lds, p.sb_w_in + (size_t)j * 2048 * 6144, 6144, 0, 6144, 6144, 2048, (bf16_t*)(ws + W_SB_IN + j * SZ_QKVW));
                conv_job(lds, p.sb_w_out + (size_t)j * 2048 * 2048, 2048, 0, 2048, 2048, 2048, (bf16_t*)(ws + W_SB_OUT + j * SZ_SQW));
            }
            conv_job(lds, p.fox_w_in, 6160, 0, 6144, 6144, 2048, (bf16_t*)(ws + W_FOX_IN));
            conv_job(lds, p.fox_w_in, 6160, 6144, 16, 128, 2048, (bf16_t*)(ws + W_FOX_F));
            conv_job(lds, p.fox_w_out, 2048, 0, 2048, 2048, 2048, (bf16_t*)(ws + W_FOX_OUT));
            conv_job(lds, p.mla_w_in, MLA_DOWN, 0, MLA_DOWN, MLA_DOWN_PAD, 2048, (bf16_t*)(ws + W_MLA_IN));
            conv_job(lds, p.mla_w_uq, 3072, 0, 3072, 3072, 768, (bf16_t*)(ws + W_MLA_UQ));
            conv_job(lds, p.mla_w_ukv, 4096, 0, 4096, 4096, 512, (bf16_t*)(ws + W_MLA_UKV));
            conv_job(lds, p.mla_w_out, 2048, 0, 2048, 2048, 2048, (bf16_t*)(ws + W_MLA_OUT));
            for (int j = 0; j < 4; ++j) {
                conv_job(lds, p.mlp_w1 + (size_t)j * 2048 * 8192, 8192, 0, 8192, 8192, 2048, (bf16_t*)(ws + W_W1 + j * SZ_FFW));
                conv_job(lds, p.mlp_w2 + (size_t)j * 8192 * 2048, 2048, 0, 2048, 2048, 8192, (bf16_t*)(ws + W_W2 + j * SZ_FFW));
            } }
            continue;
        }
        const int layer = (ph - 1) / 10, s = (ph - 1) % 10, kind = layer % 3, j = layer / 3;
        const float* xin = (layer == 0) ? p.x : X;
        int ng = 0; GemmJob g0{}, g1{}; bool do_fgate = false;
        g0.M = NTOK; g1.M = NTOK;
        if (s == 0 || s == 7) { if (EN(0)) rmsnorm_phase(s == 0 ? xin : X, (s == 0 ? p.mix_norm : p.mlp_norm) + layer * DM, H); }
        else if (s == 1) {
            ng = 1; g0.A = H; g0.K = DM;
            if (kind == 2) { g0.Bt = (const bf16_t*)(ws + W_MLA_IN); g0.N = MLA_DOWN_PAD; g0.E = pg8::EpiGen{0, (bf16_t*)(scr + SC_DOWN), MLA_DOWN_PAD, 0, 0, nullptr, nullptr}; }
            else { g0.Bt = (const bf16_t*)(ws + (kind == 0 ? W_SB_IN + j * SZ_QKVW : W_FOX_IN)); g0.N = 3 * DM; g0.E = pg8::EpiGen{0, (bf16_t*)(scr + SC_Q), DM, DM, (size_t)NTOK * DM, nullptr, nullptr}; do_fgate = kind == 1; }
        } else if (s == 2) {
            if (kind == 1) { if (EN(2)) fox_prep_phase((bf16_t*)(scr + SC_Q), p.fox_q_gain, p.fox_k_gain, LOGF, CF); }
            else { if (EN(2)) mla_prep1_phase((const bf16_t*)(scr + SC_DOWN), p.pos, p.mla_q_norm, p.mla_kv_norm, (bf16_t*)(scr + SC_CQ), (bf16_t*)(scr + SC_CKV), ROPE, KR); }
        } else if (s == 3) {
            ng = 2;
            g0.A = (const bf16_t*)(scr + SC_CQ); g0.Bt = (const bf16_t*)(ws + W_MLA_UQ); g0.N = 3072; g0.K = MLA_QR; g0.E = pg8::EpiGen{0, (bf16_t*)(scr + SC_QUP), 3072, 0, 0, nullptr, nullptr};
            g1.A = (const bf16_t*)(scr + SC_CKV); g1.Bt = (const bf16_t*)(ws + W_MLA_UKV); g1.N = 4096; g1.K = MLA_KVR; g1.E = pg8::EpiGen{0, (bf16_t*)(scr + SC_KV), 4096, 0, 0, nullptr, nullptr};
        } else if (s == 4) { if (EN(4)) mla_prep2_phase((const bf16_t*)(scr + SC_QUP), (const bf16_t*)(scr + SC_KV), ROPE, KR, p.mla_q_gain, p.mla_k_gain, (bf16_t*)(scr + SC_QN), (bf16_t*)(scr + SC_KN)); }
        else if (s == 5) {
            if (kind == 0) { if (EN(50)) attn_phase<128, TESTMODE2 ? 2 : 0>((const bf16_t*)(scr + SC_Q), DM, HD, (const bf16_t*)(scr + SC_K), DM, HD, (const bf16_t*)(scr + SC_V), DM, HD, AO, nullptr, 0.08838834764831845f * LOG2E, lds); }
            else if (kind == 1) { if (EN(51)) attn_phase<128, 1>((const bf16_t*)(scr + SC_Q), DM, HD, (const bf16_t*)(scr + SC_K), DM, HD, (const bf16_t*)(scr + SC_V), DM, HD, AO, CF, 0.08838834764831845f * LOG2E, lds); }
            else { if (EN(52)) attn_phase<192, 2>((const bf16_t*)(scr + SC_QN), 3072, 192, (const bf16_t*)(scr + SC_KN), 3072, 192, (const bf16_t*)(scr + SC_KV) + 128, 4096, 256, AO, nullptr, 0.07216878364870323f * LOG2E, lds); }
        } else if (s == 6) {
            ng = 1; g0.A = AO; g0.K = DM; g0.N = DM; g0.Bt = (const bf16_t*)(ws + (kind == 0 ? W_SB_OUT + j * SZ_SQW : (kind == 1 ? W_FOX_OUT : W_MLA_OUT)));
            g0.E = pg8::EpiGen{2, nullptr, DM, 0, 0, xin, X};
        } else if (s == 8) {
            ng = 1; g0.A = H; g0.K = DM; g0.N = DFF; g0.Bt = (const bf16_t*)(ws + W_W1 + layer * SZ_FFW); g0.E = pg8::EpiGen{1, (bf16_t*)scr, DFF, 0, 0, nullptr, nullptr};
        } else {
            ng = 1; g0.A = (const bf16_t*)scr; g0.K = DFF; g0.N = DM; g0.Bt = (const bf16_t*)(ws + W_W2 + layer * SZ_FFW); g0.E = pg8::EpiGen{2, nullptr, DM, 0, 0, X, (layer == NLAYERS - 1) ? p.out : X};
        }
        if (EN(1)) {
#pragma nounroll
            for (int gi = 0; gi < ng; ++gi) run_gemm(lds, gi ? g1 : g0);
        }
        if (do_fgate && EN(2)) fgate_phase(H, (const bf16_t*)(ws + W_FOX_F), p.fox_b_f, LOGF);
    }
}

__global__ void k_cmp(const unsigned* a, const unsigned* b, size_t n, unsigned* cnt) {
    unsigned c = 0;
    for (size_t i = (size_t)blockIdx.x * blockDim.x + threadIdx.x; i < n; i += (size_t)gridDim.x * blockDim.x) c += (a[i] != b[i]) ? 1u : 0u;
    if (c) atomicAdd(cnt, c);
}
__global__ void k_out(float* out, size_t n, const unsigned* cnt) {
    for (size_t i = (size_t)blockIdx.x * blockDim.x + threadIdx.x; i < n; i += (size_t)gridDim.x * blockDim.x) out[i] = 0.f;
    if (blockIdx.x == 0 && threadIdx.x == 0) out[0] = cnt[0] ? 3.0e5f : 1.0e5f;
}
extern "C" void kernel_launch(void* const* d_in, const int* in_sizes, int n_in, void* d_out, int out_size, void* d_ws, size_t ws_size, hipStream_t stream) {
    static int grid = 0;
    if (grid == 0) {
        if (n_in != 21 || out_size != NTOK * DM || ws_size < WS_END) { fprintf(stderr, "kernel_launch: unexpected shapes (n_in %d out %d ws %zu need %zu)\n", n_in, out_size, ws_size, (size_t)WS_END); grid = -1; return; }
        int dev = 0, cus = 0, per_cu = 0;
        hipGetDevice(&dev); hipDeviceGetAttribute(&cus, hipDeviceAttributeMultiprocessorCount, dev);
        if (hipFuncSetAttribute((const void*)fwd_megakernel, hipFuncAttributeMaxDynamicSharedMemorySize, LDS_BYTES) != hipSuccess) { fprintf(stderr, "kernel_launch: hipFuncSetAttribute failed\n"); grid = -1; return; }
        if (hipOccupancyMaxActiveBlocksPerMultiprocessor(&per_cu, (const void*)fwd_megakernel, 512, LDS_BYTES) != hipSuccess || per_cu < 1) { fprintf(stderr, "kernel_launch: occupancy query says %d\n", per_cu); per_cu = 1; }
        (void)hipGetLastError();
        grid = cus * 1;
        if (grid > 256) grid = 256;
    }
    if (grid < 0) return;
    Params p{};
    p.x = (const float*)d_in[0]; p.pos = (const int*)d_in[1]; p.mix_norm = (const float*)d_in[2]; p.mlp_norm = (const float*)d_in[3];
    p.sb_w_in = (const float*)d_in[4]; p.sb_w_out = (const float*)d_in[5]; p.fox_w_in = (const float*)d_in[6]; p.fox_b_f = (const float*)d_in[7];
    p.fox_q_gain = (const float*)d_in[8]; p.fox_k_gain = (const float*)d_in[9]; p.fox_w_out = (const float*)d_in[10];
    p.mla_w_in = (const float*)d_in[11]; p.mla_q_norm = (const float*)d_in[12]; p.mla_kv_norm = (const float*)d_in[13]; p.mla_w_uq = (const float*)d_in[14]; p.mla_w_ukv = (const float*)d_in[15];
    p.mla_q_gain = (const float*)d_in[16]; p.mla_k_gain = (const float*)d_in[17]; p.mla_w_out = (const float*)d_in[18]; p.mlp_w1 = (const float*)d_in[19]; p.mlp_w2 = (const float*)d_in[20];
    p.out = (float*)d_out; p.ws = (unsigned char*)d_ws;
#if COOP
    hipMemsetAsync((char*)d_ws + WS_BAR, 0, 16384, stream);
    p.ph_lo = 0; p.ph_hi = N_PHASES;
    void* args[] = {&p};
    hipError_t e = hipLaunchCooperativeKernel((const void*)fwd_megakernel, dim3(grid), dim3(512), args, LDS_BYTES, stream);
    if (e != hipSuccess) fprintf(stderr, "cooperative launch failed: %s (grid %d)\n", hipGetErrorString(e), grid);
#else
    for (int ph = 0; ph < N_PHASES; ++ph) {
        if (!phase_active(ph)) continue;
        p.ph_lo = ph; p.ph_hi = ph + 1;
        hipLaunchKernelGGL(fwd_megakernel, dim3(grid), dim3(512), LDS_BYTES, stream, p);
#ifdef TESTDUP
        if (ph == 6) { p.alt = 1; hipLaunchKernelGGL(fwd_megakernel, dim3(grid), dim3(512), LDS_BYTES, stream, p); p.alt = 0; }
#endif
    }
#ifdef TESTDUP
    unsigned* cnt = (unsigned*)((char*)d_ws + WS_LOGF);
    hipMemsetAsync(cnt, 0, 4, stream);
    hipLaunchKernelGGL(k_cmp, dim3(1024), dim3(256), 0, stream, (const unsigned*)((char*)d_ws + WS_AO), (const unsigned*)((char*)d_ws + WS_SCR + (size_t)NTOK * DFF * 2), (size_t)NTOK * DM / 2, cnt);
    hipLaunchKernelGGL(k_out, dim3(1024), dim3(256), 0, stream, (float*)d_out, (size_t)NTOK * DM, (const unsigned*)cnt);
#endif
#endif
}
```

```cpp
#include <hip/hip_runtime.h>
#include <hip/hip_cooperative_groups.h>
#include <cstdio>
#include <cstdint>
namespace cg = cooperative_groups;

#ifndef COOP
#define COOP 1
#endif
#ifndef ONLY
#define ONLY -1
#endif
#ifndef ATT_DMA
#define ATT_DMA 1
#endif
#define TESTMODE2 0

#ifndef SKIP
#define SKIP -5
#endif
#define EN(x) ((ONLY < 0 || ONLY == (x)) && (x) != SKIP)

#define LAS __attribute__((address_space(3)))
typedef unsigned short bf16_t;
typedef short bf16x8 __attribute__((ext_vector_type(8)));
typedef short s16x4 __attribute__((ext_vector_type(4)));
typedef float f32x4 __attribute__((ext_vector_type(4)));
typedef float f32x16 __attribute__((ext_vector_type(16)));
typedef unsigned u32x4 __attribute__((ext_vector_type(4)));
typedef unsigned u32x2 __attribute__((ext_vector_type(2)));

constexpr int DM = 2048, NTOK = 8192, SEQ = 2048, NH = 16, HD = 128, DFF = 8192, DEPTH = 4;
constexpr int MLA_QR = 768, MLA_KVR = 512, MLA_ROPE = 64, MLA_QK = 192, MLA_DOWN = 1344, MLA_DOWN_PAD = 1536;
constexpr float EPS = 1e-6f;
constexpr float LOG2E = 1.4426950408889634f;

constexpr size_t SZ_QKVW = (size_t)6144 * 2048 * 2, SZ_SQW = (size_t)2048 * 2048 * 2, SZ_FFW = (size_t)8192 * 2048 * 2;
constexpr size_t W_SB_IN = 0;
constexpr size_t W_SB_OUT = W_SB_IN + 2 * SZ_QKVW;
constexpr size_t W_FOX_IN = W_SB_OUT + 2 * SZ_SQW;
constexpr size_t W_FOX_F = W_FOX_IN + SZ_QKVW;
constexpr size_t W_FOX_OUT = W_FOX_F + (size_t)128 * 2048 * 2;
constexpr size_t W_MLA_IN = W_FOX_OUT + SZ_SQW;
constexpr size_t W_MLA_UQ = W_MLA_IN + (size_t)1536 * 2048 * 2;
constexpr size_t W_MLA_UKV = W_MLA_UQ + (size_t)3072 * 768 * 2;
constexpr size_t W_MLA_OUT = W_MLA_UKV + (size_t)4096 * 512 * 2;
constexpr size_t W_W1 = W_MLA_OUT + SZ_SQW;
constexpr size_t W_W2 = W_W1 + 4 * SZ_FFW;
constexpr size_t WS_X = W_W2 + 4 * SZ_FFW;
constexpr size_t WS_H = WS_X + (size_t)NTOK * DM * 4;
constexpr size_t WS_AO = WS_H + (size_t)NTOK * DM * 2;
constexpr size_t WS_LOGF = WS_AO + (size_t)NTOK * DM * 2;
constexpr size_t WS_CF = WS_LOGF + (size_t)NTOK * 16 * 4;
constexpr size_t WS_ROPE = WS_CF + (size_t)64 * 2048 * 4;
constexpr size_t WS_KR = WS_ROPE + (size_t)NTOK * 64 * 4;
constexpr size_t WS_SCR = WS_KR + (size_t)NTOK * 64 * 4;
constexpr size_t SC_Q = 0, SC_K = (size_t)NTOK * DM * 2, SC_V = 2 * (size_t)NTOK * DM * 2;
constexpr size_t SC_DOWN = 0;
constexpr size_t SC_CQ = SC_DOWN + (size_t)NTOK * MLA_DOWN_PAD * 2;
constexpr size_t SC_CKV = SC_CQ + (size_t)NTOK * MLA_QR * 2;
constexpr size_t SC_QUP = SC_CKV + (size_t)NTOK * MLA_KVR * 2;
constexpr size_t SC_KV = SC_QUP + (size_t)NTOK * 3072 * 2;
constexpr size_t SC_QN = SC_KV + (size_t)NTOK * 4096 * 2;
constexpr size_t SC_KN = SC_QN + (size_t)NTOK * 3072 * 2;
constexpr size_t SC_END = SC_KN + (size_t)NTOK * 3072 * 2;
constexpr size_t WS_BAR = WS_SCR + SC_END;
constexpr size_t WS_END = WS_BAR + 16384;

constexpr int LDS_BYTES = 131072 + 16;

struct Params {
    const float* x; const int* pos; const float* mix_norm; const float* mlp_norm;
    const float* sb_w_in; const float* sb_w_out; const float* fox_w_in; const float* fox_b_f; const float* fox_q_gain; const float* fox_k_gain; const float* fox_w_out;
    const float* mla_w_in; const float* mla_q_norm; const float* mla_kv_norm; const float* mla_w_uq; const float* mla_w_ukv; const float* mla_q_gain; const float* mla_k_gain; const float* mla_w_out;
    const float* mlp_w1; const float* mlp_w2;
    float* out; unsigned char* ws;
    long long ph_lo, ph_hi, alt;
};

__device__ __forceinline__ unsigned cvtpk(float lo, float hi) { unsigned r; asm volatile("v_cvt_pk_bf16_f32 %0, %1, %2" : "=v"(r) : "v"(lo), "v"(hi)); return r; }
__device__ __forceinline__ float bflo(unsigned w) { return __uint_as_float(w << 16); }
__device__ __forceinline__ float bfhi(unsigned w) { return __uint_as_float(w & 0xffff0000u); }
__device__ __forceinline__ int opq(int x) { asm volatile("" : "+v"(x)); return x; }
__device__ __forceinline__ float wave_sum(float v) {
#pragma unroll
    for (int o = 32; o > 0; o >>= 1) v += __shfl_xor(v, o);
    return v;
}
__device__ __forceinline__ float sum16(float v) {
#pragma unroll
    for (int o = 8; o > 0; o >>= 1) v += __shfl_xor(v, o);
    return v;
}

namespace pg8 {
constexpr int BM = 256, BK = 64, HALF = 128, HTB = HALF * BK * 2, STAGE_BYTES = 8 * HTB, NXCD = 8, WGM = 8;
__host__ __device__ __forceinline__ int lds_byte(int r, int c) { const int st = (r >> 4) * 2 + (c >> 5), rr = r & 15, cc = c & 31, ob = rr * 64 + cc * 2; return st * 1024 + (ob ^ (((ob >> 9) & 1) << 5)); }
__host__ __device__ __forceinline__ void stage_rc(int b, int& R, int& C) { const int st = b / 1024, sb = b % 1024, swz = sb ^ (((sb >> 9) & 1) << 5); R = (st >> 1) * 16 + swz / 64; C = (st & 1) * 32 + (swz % 64) / 2; }
__host__ __device__ __forceinline__ int perm32(int rho) { const int n = rho >> 4, i = rho & 15; return 8 * (i >> 2) + 4 * n + (i & 3); }
struct Unit { int pm, pn; };
struct Gemm { const bf16_t* A; const bf16_t* Bt; int M, N, K; };
struct StaticOrder {
    int nM, nN, nwg, G, c;
    __device__ void init(int M, int N, int G_, int c_) { nM = M / BM; nN = N / BM; nwg = nM * nN; G = G_; c = c_; }
    __device__ bool next(int i, Unit& u) const {
        const long L = (long)i * G + c; if (L >= nwg) return false;
        int wgid = (int)L; { const int q = nwg / NXCD, r = nwg % NXCD, xcd = wgid % NXCD, off = wgid / NXCD; wgid = (xcd < r ? xcd * (q + 1) : r * (q + 1) + (xcd - r) * q) + off; }
        const int nig = WGM * nN, gid = wgid / nig, fm = gid * WGM, gsz = (nM - fm) < WGM ? (nM - fm) : WGM;
        u.pm = fm + ((wgid % nig) % gsz); u.pn = (wgid % nig) / gsz; return true;
    }
};
struct EpiGen {
    int mode; bf16_t* O; int ldc; int split_cols; size_t split_stride; const float* R; float* C;
    __device__ __forceinline__ void operator()(const f32x4 (&acc)[2][2][4][2], const Unit& u, int wr, int wc, int fr, int fq) const {
        const int row0 = u.pm * BM + wr * 64 + fr;
        if (mode == 2) {
            const int col0 = u.pn * BM + wc * 32 + 4 * fq;
#pragma unroll
            for (int ai = 0; ai < 2; ++ai) {
                f32x4 rv[4][2][2];
#pragma unroll
                for (int m = 0; m < 4; ++m) { const size_t ro = (size_t)(row0 + ai * HALF + m * 16) * ldc + col0;
#pragma unroll
                    for (int bj = 0; bj < 2; ++bj)
#pragma unroll
                        for (int n = 0; n < 2; ++n) rv[m][bj][n] = *(const f32x4*)(R + ro + bj * HALF + n * 16); }
#pragma unroll
                for (int m = 0; m < 4; ++m) { const size_t ro = (size_t)(row0 + ai * HALF + m * 16) * ldc + col0;
#pragma unroll
                    for (int bj = 0; bj < 2; ++bj)
#pragma unroll
                        for (int n = 0; n < 2; ++n) *(f32x4*)(C + ro + bj * HALF + n * 16) = acc[ai][bj][m][n] + rv[m][bj][n]; }
            }
        } else {
            int colt = u.pn * BM; bf16_t* base = O;
            if (split_cols) { const int t = colt / split_cols; base += (size_t)t * split_stride; colt -= t * split_cols; }
            const int col0 = colt + wc * 32 + 8 * fq; const bool act = mode == 1;
#pragma unroll
            for (int ai = 0; ai < 2; ++ai)
#pragma unroll
                for (int m = 0; m < 4; ++m) { bf16_t* rowp = base + (size_t)(row0 + ai * HALF + m * 16) * ldc + col0;
#pragma unroll
                    for (int bj = 0; bj < 2; ++bj) { f32x4 v0 = acc[ai][bj][m][0], v1 = acc[ai][bj][m][1];
                        if (act) {
#pragma unroll
                            for (int j = 0; j < 4; ++j) { float x = fmaxf(v0[j], 0.f), y = fmaxf(v1[j], 0.f); v0[j] = x * x; v1[j] = y * y; } }
                        u32x4 w; w.x = cvtpk(v0[0], v0[1]); w.y = cvtpk(v0[2], v0[3]); w.z = cvtpk(v1[0], v1[1]); w.w = cvtpk(v1[2], v1[3]);
                        *(u32x4*)(rowp + bj * HALF) = w; } }
        }
    }
};

template <class Epi, class Sched>
__device__ __forceinline__ void gemm_phase(LAS unsigned char* lds, const Gemm g, const Sched& S, const Epi& E) {
    const int tid = opq(threadIdx.x), wid = __builtin_amdgcn_readfirstlane(tid >> 6), lane = tid & 63, wr = wid >> 2, wc = wid & 3, fr = lane & 15, fq = lane >> 4;
    const int K = g.K, nt = K / BK;
    unsigned voffA[2], voffB[2];
#pragma unroll
    for (int i = 0; i < 2; ++i) { int R, C; stage_rc(tid * 16 + i * 8192, R, C); const int Rb = (E.mode != 2) ? ((R & ~31) + perm32(R & 31)) : R;
        voffA[i] = (unsigned)(R * K + C) * 2u; voffB[i] = (unsigned)(Rb * K + C) * 2u; }
    const size_t kstep = (size_t)(BK * 2);
    const size_t hstep = (size_t)HALF * K * 2;
    const size_t tstep = 2 * hstep;
    const unsigned ldsw = (unsigned)wid * 1024u;
    const int aoff = lds_byte(wr * 64 + fr, fq * 8), boff = lds_byte(wc * 32 + fr, fq * 8);
#define PG8_SA(b, h) (((b) * 2 + (h)) * HTB)
#define PG8_SB(b, h) ((4 + (b) * 2 + (h)) * HTB)
#define PG8_STAGE(bufoff, gbase, voff) do { _Pragma("unroll") for (int _i = 0; _i < 2; ++_i) \
        __builtin_amdgcn_global_load_lds((const unsigned*)((const char*)(gbase) + (voff)[_i]), (LAS unsigned*)(lds + (bufoff) + ldsw + _i * 8192), 16, 0, 0); } while (0)
#define PG8_LDA(dst, b, h) do { _Pragma("unroll") for (int m = 0; m < 4; ++m) _Pragma("unroll") for (int k = 0; k < 2; ++k) dst[m][k] = *(const LAS bf16x8*)(lds + PG8_SA(b, h) + aoff + m * 2048 + k * 1024); } while (0)
#define PG8_LDB(dst, b, h) do { _Pragma("unroll") for (int n = 0; n < 2; ++n) _Pragma("unroll") for (int k = 0; k < 2; ++k) dst[n][k] = *(const LAS bf16x8*)(lds + PG8_SB(b, h) + boff + n * 2048 + k * 1024); } while (0)
#define PG8_MMA(ai, bj, At, Bt) do { __builtin_amdgcn_s_setprio(1); _Pragma("unroll") for (int m = 0; m < 4; ++m) _Pragma("unroll") for (int n = 0; n < 2; ++n) _Pragma("unroll") for (int k = 0; k < 2; ++k) \
        acc[ai][bj][m][n] = __builtin_amdgcn_mfma_f32_16x16x32_bf16(Bt[n][k], At[m][k], acc[ai][bj][m][n], 0, 0, 0); __builtin_amdgcn_s_setprio(0); } while (0)
#define PG8_WAIT_V(n) asm volatile("s_waitcnt vmcnt(" #n ")" ::: "memory")
#define PG8_WAIT_L(n) asm volatile("s_waitcnt lgkmcnt(" #n ")" ::: "memory")
#define PG8_BAR __builtin_amdgcn_s_barrier()
#define PG8_SCHED __builtin_amdgcn_sched_barrier(0)
    Unit cur, nxt; int ui = 0;
    if (!S.next(0, cur)) return;
    f32x4 acc[2][2][4][2];
#pragma unroll
    for (int a = 0; a < 2; ++a)
#pragma unroll
        for (int b = 0; b < 2; ++b)
#pragma unroll
            for (int m = 0; m < 4; ++m)
#pragma unroll
                for (int n = 0; n < 2; ++n) acc[a][b][m][n] = (f32x4){0.f, 0.f, 0.f, 0.f};
    bf16x8 At[4][2], B0[2][2], B1[2][2];
    const char* cA = (const char*)g.A + (size_t)cur.pm * tstep; const char* cB = (const char*)g.Bt + (size_t)cur.pn * tstep;
    PG8_STAGE(PG8_SB(0, 0), cB, voffB); PG8_STAGE(PG8_SA(0, 0), cA, voffA); PG8_STAGE(PG8_SB(0, 1), cB + hstep, voffB); PG8_STAGE(PG8_SA(0, 1), cA + hstep, voffA);
    if (wr == 1) PG8_BAR;
    PG8_WAIT_V(4); PG8_BAR;
    PG8_STAGE(PG8_SB(1, 0), cB + kstep, voffB); PG8_STAGE(PG8_SA(1, 0), cA + kstep, voffA); PG8_STAGE(PG8_SB(1, 1), cB + hstep + kstep, voffB);
    PG8_WAIT_V(6); PG8_BAR;
    for (;;) {
        const bool has_next = S.next(ui + 1, nxt);
        const char* nA = has_next ? (const char*)g.A + (size_t)nxt.pm * tstep : cA; const char* nB = has_next ? (const char*)g.Bt + (size_t)nxt.pn * tstep : cB;
        for (int t = 0; t < nt; t += 2) {
            const bool last = (t == nt - 2);
            const char* a1 = cA + (size_t)(t + 1) * kstep;
            const char* a2 = last ? nA : cA + (size_t)(t + 2) * kstep; const char* b2 = last ? nB : cB + (size_t)(t + 2) * kstep;
            const char* a3 = a2 + kstep; const char* b3 = b2 + kstep;
            PG8_LDB(B0, 0, 0); PG8_SCHED; PG8_LDA(At, 0, 0); PG8_STAGE(PG8_SA(1, 1), a1 + hstep, voffA);
            PG8_WAIT_L(8); PG8_BAR; PG8_WAIT_L(0); PG8_MMA(0, 0, At, B0); PG8_BAR; PG8_SCHED;
            PG8_LDB(B1, 0, 1); PG8_STAGE(PG8_SB(0, 0), b2, voffB);
            PG8_BAR; PG8_WAIT_L(0); PG8_MMA(0, 1, At, B1); PG8_BAR;
            PG8_LDA(At, 0, 1); PG8_STAGE(PG8_SA(0, 0), a2, voffA);
            PG8_BAR; PG8_WAIT_L(0); PG8_MMA(1, 0, At, B0); PG8_BAR; PG8_SCHED;
            PG8_STAGE(PG8_SB(0, 1), b2 + hstep, voffB);
            PG8_WAIT_V(6); PG8_BAR; PG8_MMA(1, 1, At, B1); PG8_BAR;
            PG8_LDB(B0, 1, 0); PG8_SCHED; PG8_LDA(At, 1, 0); PG8_STAGE(PG8_SA(0, 1), a2 + hstep, voffA);
            PG8_WAIT_L(8); PG8_BAR; PG8_WAIT_L(0); PG8_MMA(0, 0, At, B0); PG8_BAR; PG8_SCHED;
            PG8_LDB(B1, 1, 1); PG8_STAGE(PG8_SB(1, 0), b3, voffB);
            PG8_BAR; PG8_WAIT_L(0); PG8_MMA(0, 1, At, B1); PG8_BAR;
            PG8_LDA(At, 1, 1); PG8_STAGE(PG8_SA(1, 0), a3, voffA);
            PG8_BAR; PG8_WAIT_L(0); PG8_MMA(1, 0, At, B0); PG8_BAR; PG8_SCHED;
            PG8_STAGE(PG8_SB(1, 1), b3 + hstep, voffB);
            PG8_WAIT_V(6); PG8_BAR; PG8_MMA(1, 1, At, B1); PG8_BAR;
        }
        E(acc, cur, wr, wc, fr, fq);
        if (!has_next) break;
#pragma unroll
        for (int a = 0; a < 2; ++a)
#pragma unroll
            for (int b = 0; b < 2; ++b)
#pragma unroll
                for (int m = 0; m < 4; ++m)
#pragma unroll
                    for (int n = 0; n < 2; ++n) acc[a][b][m][n] = (f32x4){0.f, 0.f, 0.f, 0.f};
        cur = nxt; cA = nA; cB = nB; ++ui;
    }
    PG8_WAIT_V(0);
    if (wr == 0) PG8_BAR;
    PG8_BAR;
#undef PG8_SA
#undef PG8_SB
#undef PG8_STAGE
#undef PG8_LDA
#undef PG8_LDB
#undef PG8_MMA
#undef PG8_WAIT_V
#undef PG8_WAIT_L
#undef PG8_BAR
#undef PG8_SCHED
}
}

struct GemmJob { const bf16_t* A; const bf16_t* Bt; int M, N, K; pg8::EpiGen E; };
__device__ __forceinline__ void run_gemm(LAS unsigned char* lds, const GemmJob& j) {
    pg8::Gemm g{j.A, j.Bt, j.M, j.N, j.K};
    pg8::StaticOrder S; S.init(j.M, j.N, (int)gridDim.x, (int)blockIdx.x);
    pg8::gemm_phase<pg8::EpiGen, pg8::StaticOrder>(lds, g, S, j.E);
    __syncthreads();
}

__device__ __forceinline__ void conv_job(LAS unsigned char* lds, const float* __restrict__ src, int ldn, int col0, int ncols, int npad, int K, bf16_t* __restrict__ dst) {
    constexpr int LR = 132;
    LAS float* T = (LAS float*)lds;
    const int tid = opq(threadIdx.x), n4 = tid & 31, kr = tid >> 5;
    const int rn = tid & 127, rk = tid >> 7;
    const int ntn = npad / 128, ntk = K / 128, ntiles = ntn * ntk;
    f32x4 r[8];
    int t = blockIdx.x;
#define CONV_LOAD(tt_) do { const int tn_ = (tt_) % ntn, tk_ = (tt_) / ntn; const int n_ = tn_ * 128 + n4 * 4; const bool ok_ = n_ < ncols; \
        const float* p_ = src + (size_t)(tk_ * 128 + kr) * ldn + col0 + (ok_ ? n_ : 0); \
        _Pragma("unroll") for (int j_ = 0; j_ < 8; ++j_) { r[j_] = __builtin_nontemporal_load((const f32x4*)(p_ + (size_t)(16 * j_) * ldn)); if (!ok_) r[j_] = (f32x4){0.f, 0.f, 0.f, 0.f}; } } while (0)
    if (t < ntiles) CONV_LOAD(t);
    for (; t < ntiles; t += gridDim.x) {
        const int tn = t % ntn, tk = t / ntn;
#pragma unroll
        for (int j = 0; j < 8; ++j) *(LAS f32x4*)(T + (kr + 16 * j) * LR + n4 * 4) = r[j];
        if (t + (int)gridDim.x < ntiles) CONV_LOAD(t + (int)gridDim.x);
        __syncthreads();
#pragma unroll
        for (int j = 0; j < 4; ++j) { const int kc = rk + 4 * j; float v[8];
#pragma unroll
            for (int i = 0; i < 8; ++i) v[i] = T[(kc * 8 + i) * LR + rn];
            u32x4 w; w.x = cvtpk(v[0], v[1]); w.y = cvtpk(v[2], v[3]); w.z = cvtpk(v[4], v[5]); w.w = cvtpk(v[6], v[7]);
            *(u32x4*)(dst + (size_t)(tn * 128 + rn) * K + tk * 128 + kc * 8) = w; }
        __syncthreads();
    }
}

__device__ __forceinline__ void rmsnorm_phase(const float* __restrict__ x, const float* __restrict__ g, bf16_t* __restrict__ h) {
    const int tid = opq(threadIdx.x), lane = tid & 63, gw = blockIdx.x * 8 + (tid >> 6), nw = gridDim.x * 8;
    for (int row = gw; row < NTOK; row += nw) {
        const float* xr = x + (size_t)row * DM; f32x4 v[8]; float ss = 0.f;
#pragma unroll
        for (int j = 0; j < 8; ++j) { v[j] = *(const f32x4*)(xr + j * 256 + lane * 4); ss += v[j][0] * v[j][0] + v[j][1] * v[j][1] + v[j][2] * v[j][2] + v[j][3] * v[j][3]; }
        ss = wave_sum(ss); const float rs = rsqrtf(ss * (1.f / DM) + EPS);
#pragma unroll
        for (int j = 0; j < 8; ++j) { const f32x4 gv = *(const f32x4*)(g + j * 256 + lane * 4);
            u32x2 w; w.x = cvtpk(v[j][0] * rs * gv[0], v[j][1] * rs * gv[1]); w.y = cvtpk(v[j][2] * rs * gv[2], v[j][3] * rs * gv[3]);
            *(u32x2*)(h + (size_t)row * DM + j * 256 + lane * 4) = w; }
    }
}

__device__ __forceinline__ void fgate_phase(const bf16_t* __restrict__ h, const bf16_t* __restrict__ wft, const float* __restrict__ bfv, float* __restrict__ logf) {
    const int tid = opq(threadIdx.x), lane = tid & 63, gw = blockIdx.x * 8 + (tid >> 6), nw = gridDim.x * 8;
    const int fr = lane & 15, fq = lane >> 4;
    if ((gw & 3) != 0) return;
    for (int job = gw >> 2; job < NTOK / 16; job += (nw >> 2)) {
        const bf16_t* ap = h + (size_t)(job * 16 + fr) * DM + fq * 8; const bf16_t* bp = wft + (size_t)fr * DM + fq * 8;
        f32x4 acc = {0.f, 0.f, 0.f, 0.f};
#pragma unroll 8
        for (int k = 0; k < DM; k += 32) { const bf16x8 a = *(const bf16x8*)(ap + k), b = *(const bf16x8*)(bp + k); acc = __builtin_amdgcn_mfma_f32_16x16x32_bf16(a, b, acc, 0, 0, 0); }
        const float bb = bfv[fr];
#pragma unroll
        for (int j = 0; j < 4; ++j) { const float u = acc[j] + bb; logf[(size_t)(job * 16 + fq * 4 + j) * 16 + fr] = -(fmaxf(-u, 0.f) + log1pf(__expf(-fabsf(u)))); }
    }
}

__device__ __forceinline__ void fox_prep_phase(bf16_t* __restrict__ qk  , const float* __restrict__ qg, const float* __restrict__ kg, const float* __restrict__ logf, float* __restrict__ cf) {
    const int tid = opq(threadIdx.x), lane = tid & 63, gw = blockIdx.x * 8 + (tid >> 6), nw = gridDim.x * 8;
    const int sub = lane >> 4, l16 = lane & 15;
    const int nrows = 2 * NTOK * NH;
    for (int r0 = gw * 4; r0 < nrows; r0 += nw * 4) {
        const int row = r0 + sub; const bool isk = row >= NTOK * NH;
        bf16_t* p = qk + (size_t)row * HD + l16 * 8;
        const u32x4 w = *(const u32x4*)p; float v[8] = {bflo(w.x), bfhi(w.x), bflo(w.y), bfhi(w.y), bflo(w.z), bfhi(w.z), bflo(w.w), bfhi(w.w)};
        float ss = 0.f;
#pragma unroll
        for (int i = 0; i < 8; ++i) ss += v[i] * v[i];
        ss = sum16(ss); const float rs = rsqrtf(ss * (1.f / HD) + EPS);
        const float* gp = (isk ? kg : qg) + l16 * 8; const f32x4 g0 = *(const f32x4*)gp, g1 = *(const f32x4*)(gp + 4);
        u32x4 o; o.x = cvtpk(v[0] * rs * g0[0], v[1] * rs * g0[1]); o.y = cvtpk(v[2] * rs * g0[2], v[3] * rs * g0[3]);
        o.z = cvtpk(v[4] * rs * g1[0], v[5] * rs * g1[1]); o.w = cvtpk(v[6] * rs * g1[2], v[7] * rs * g1[3]);
        *(u32x4*)p = o;
    }
    for (int bh = blockIdx.x; bh < 64; bh += gridDim.x) {
        if ((threadIdx.x >> 6) != 0) continue;
        const int b = bh >> 4, hd = bh & 15; const float* lp = logf + (size_t)(b * SEQ + lane * 32) * 16 + hd;
        float v[32]; float tot = 0.f;
#pragma unroll
        for (int i = 0; i < 32; ++i) { tot += lp[(size_t)i * 16]; v[i] = tot; }
        float inc = tot;
#pragma unroll
        for (int o = 1; o < 64; o <<= 1) { const float up = __shfl_up(inc, o); if (lane >= o) inc += up; }
        const float base = inc - tot;
        float* cp = cf + (size_t)bh * SEQ + lane * 32;
#pragma unroll
        for (int i = 0; i < 32; ++i) cp[i] = base + v[i];
    }
}

__device__ __forceinline__ void mla_prep1_phase(const bf16_t* __restrict__ down, const int* __restrict__ pos, const float* __restrict__ qn, const float* __restrict__ kvn,
                                                bf16_t* __restrict__ cq, bf16_t* __restrict__ ckv, float* __restrict__ ropet, float* __restrict__ kr) {
    const int tid = opq(threadIdx.x), lane = tid & 63, gw = blockIdx.x * 8 + (tid >> 6), nw = gridDim.x * 8;
    for (int row = gw; row < NTOK; row += nw) {
        const bf16_t* dr = down + (size_t)row * MLA_DOWN_PAD;
        {   float v[12]; float ss = 0.f;
#pragma unroll
            for (int j = 0; j < 3; ++j) { const u32x2 w = *(const u32x2*)(dr + j * 256 + lane * 4); v[4 * j] = bflo(w.x); v[4 * j + 1] = bfhi(w.x); v[4 * j + 2] = bflo(w.y); v[4 * j + 3] = bfhi(w.y); }
#pragma unroll
            for (int i = 0; i < 12; ++i) ss += v[i] * v[i];
            ss = wave_sum(ss); const float rs = rsqrtf(ss * (1.f / MLA_QR) + EPS);
#pragma unroll
            for (int j = 0; j < 3; ++j) { const f32x4 g = *(const f32x4*)(qn + j * 256 + lane * 4);
                u32x2 w; w.x = cvtpk(v[4 * j] * rs * g[0], v[4 * j + 1] * rs * g[1]); w.y = cvtpk(v[4 * j + 2] * rs * g[2], v[4 * j + 3] * rs * g[3]);
                *(u32x2*)(cq + (size_t)row * MLA_QR + j * 256 + lane * 4) = w; } }
        {   float v[8]; float ss = 0.f;
#pragma unroll
            for (int j = 0; j < 2; ++j) { const u32x2 w = *(const u32x2*)(dr + MLA_QR + j * 256 + lane * 4); v[4 * j] = bflo(w.x); v[4 * j + 1] = bfhi(w.x); v[4 * j + 2] = bflo(w.y); v[4 * j + 3] = bfhi(w.y); }
#pragma unroll
            for (int i = 0; i < 8; ++i) ss += v[i] * v[i];
            ss = wave_sum(ss); const float rs = rsqrtf(ss * (1.f / MLA_KVR) + EPS);
#pragma unroll
            for (int j = 0; j < 2; ++j) { const f32x4 g = *(const f32x4*)(kvn + j * 256 + lane * 4);
                u32x2 w; w.x = cvtpk(v[4 * j] * rs * g[0], v[4 * j + 1] * rs * g[1]); w.y = cvtpk(v[4 * j + 2] * rs * g[2], v[4 * j + 3] * rs * g[3]);
                *(u32x2*)(ckv + (size_t)row * MLA_KVR + j * 256 + lane * 4) = w; } }
        if (lane < 32) {
            const float invf = powf(10000.0f, -(float)(2 * lane) / 64.0f);
            const float ang = (float)pos[row] * invf; const float cs = cosf(ang), sn = sinf(ang);
            ropet[(size_t)row * 64 + lane] = cs; ropet[(size_t)row * 64 + 32 + lane] = sn;
            const float x1 = __uint_as_float((unsigned)dr[MLA_QR + MLA_KVR + lane] << 16), x2 = __uint_as_float((unsigned)dr[MLA_QR + MLA_KVR + 32 + lane] << 16);
            kr[(size_t)row * 64 + lane] = x1 * cs - x2 * sn; kr[(size_t)row * 64 + 32 + lane] = x1 * sn + x2 * cs;
        }
    }
}

__device__ __forceinline__ void mla_prep2_phase(const bf16_t* __restrict__ qup, const bf16_t* __restrict__ kv, const float* __restrict__ ropet, const float* __restrict__ kr,
                                                const float* __restrict__ qg, const float* __restrict__ kg, bf16_t* __restrict__ Qn, bf16_t* __restrict__ Kn) {
    const int tid = opq(threadIdx.x), lane = tid & 63, gw = blockIdx.x * 8 + (tid >> 6), nw = gridDim.x * 8;
    const int sub = lane >> 4, j = lane & 15;
    const int nrows = 2 * NTOK * NH;
    for (int r0 = gw * 4; r0 < nrows; r0 += nw * 4) {
        int row = r0 + sub; const bool isk = row >= NTOK * NH; if (isk) row -= NTOK * NH;
        const int tok = row >> 4, hd = row & 15;
        float v[8], ra[2], rb[2];
        if (!isk) {
            const bf16_t* p = qup + (size_t)tok * 3072 + hd * 192;
            const u32x4 w = *(const u32x4*)(p + j * 8);
            v[0] = bflo(w.x); v[1] = bfhi(w.x); v[2] = bflo(w.y); v[3] = bfhi(w.y); v[4] = bflo(w.z); v[5] = bfhi(w.z); v[6] = bflo(w.w); v[7] = bfhi(w.w);
            const unsigned w1 = *(const unsigned*)(p + 128 + 2 * j), w2 = *(const unsigned*)(p + 160 + 2 * j);
            const float x1a = bflo(w1), x1b = bfhi(w1), x2a = bflo(w2), x2b = bfhi(w2);
            const float* rt = ropet + (size_t)tok * 64; const float c0 = rt[2 * j], c1 = rt[2 * j + 1], s0 = rt[32 + 2 * j], s1 = rt[32 + 2 * j + 1];
            ra[0] = x1a * c0 - x2a * s0; ra[1] = x1b * c1 - x2b * s1; rb[0] = x1a * s0 + x2a * c0; rb[1] = x1b * s1 + x2b * c1;
        } else {
            const bf16_t* p = kv + (size_t)tok * 4096 + hd * 256;
            const u32x4 w = *(const u32x4*)(p + j * 8);
            v[0] = bflo(w.x); v[1] = bfhi(w.x); v[2] = bflo(w.y); v[3] = bfhi(w.y); v[4] = bflo(w.z); v[5] = bfhi(w.z); v[6] = bflo(w.w); v[7] = bfhi(w.w);
            const float* kp = kr + (size_t)tok * 64; ra[0] = kp[2 * j]; ra[1] = kp[2 * j + 1]; rb[0] = kp[32 + 2 * j]; rb[1] = kp[32 + 2 * j + 1];
        }
        float ss = ra[0] * ra[0] + ra[1] * ra[1] + rb[0] * rb[0] + rb[1] * rb[1];
#pragma unroll
        for (int i = 0; i < 8; ++i) ss += v[i] * v[i];
        ss = sum16(ss); const float rs = rsqrtf(ss * (1.f / MLA_QK) + EPS);
        const float* g = isk ? kg : qg; const f32x4 g0 = *(const f32x4*)(g + j * 8), g1 = *(const f32x4*)(g + j * 8 + 4);
        bf16_t* o = (isk ? Kn : Qn) + (size_t)tok * 3072 + hd * 192;
        u32x4 ow; ow.x = cvtpk(v[0] * rs * g0[0], v[1] * rs * g0[1]); ow.y = cvtpk(v[2] * rs * g0[2], v[3] * rs * g0[3]);
        ow.z = cvtpk(v[4] * rs * g1[0], v[5] * rs * g1[1]); ow.w = cvtpk(v[6] * rs * g1[2], v[7] * rs * g1[3]);
        *(u32x4*)(o + j * 8) = ow;
        *(unsigned*)(o + 128 + 2 * j) = cvtpk(ra[0] * rs * g[128 + 2 * j], ra[1] * rs * g[128 + 2 * j + 1]);
        *(unsigned*)(o + 160 + 2 * j) = cvtpk(rb[0] * rs * g[160 + 2 * j], rb[1] * rs * g[160 + 2 * j + 1]);
    }
}

__device__ __forceinline__ int v_st(int k, int c) { const int kk = (k & ~0xC) | ((k & 4) << 1) | ((k & 8) >> 1); return ((kk >> 3) * 4 + (c >> 5)) * 512 + ((kk & 7) * 32 + (c & 31)) * 2; }
__device__ __forceinline__ int v_rd_base(int lane) { return ((lane & 3) << 3) | (((lane >> 2) & 3) << 6) | (((lane >> 4) & 1) << 5) | (((lane >> 5) & 1) << 8); }
constexpr int v_rd_off(int d0, int ks, int half) { return d0 * 512 + ks * 4096 + half * 2048; }
__device__ __forceinline__ int crow(int r, int hi) { return (r & 3) + 8 * (r >> 2) + 4 * hi; }

constexpr int AT_SHM_V = 16384, AT_KBUF = 24576;
constexpr int AT_OFF_K = 2 * AT_SHM_V, AT_OFF_WS = AT_OFF_K + 2 * AT_KBUF, AT_OFF_CF = AT_OFF_WS + 2048;

#ifdef TESTB
#define SB_LG(y) fmaxf(1.f - 0.5f * fabsf(y), 0.f)
#else
#define SB_LG(y) __builtin_amdgcn_logf(1.f + __builtin_amdgcn_exp2f(-fabsf(y)))
#endif
#ifndef SB_BLOCK_EXIT
#define SB_BLOCK_EXIT 0
#endif
template <int DQK, int MODE>
__device__ __forceinline__ void attn_block(const bf16_t* __restrict__ Qg, int ldq, const bf16_t* __restrict__ Kg, int ldk, const bf16_t* __restrict__ Vg, int ldv,
                                           bf16_t* __restrict__ Og, int ldo, int q0, float C2, LAS unsigned char* lds) {
    constexpr int NQ = DQK / 16, ROWB = DQK * 2, SHM_K = 64 * ROWB, NCH = DQK / 8, KCH = NCH / 8;
    const int tid = opq(threadIdx.x), wid = __builtin_amdgcn_readfirstlane(tid >> 6), lane = tid & 63, r32 = lane & 31, hi = lane >> 5;
    LAS unsigned char* V_lds = lds; LAS unsigned char* K_lds = lds + AT_OFF_K;
    LAS float* li_l = (LAS float*)(lds + AT_OFF_WS) + wid * 64; LAS float* al_l = li_l + 32;
    const LAS float* cfl = (const LAS float*)(lds + AT_OFF_CF);
    const int qlo = q0 + wid * 32, trow = qlo + r32;
    bf16x8 qr[NQ];
#pragma unroll
    for (int d0 = 0; d0 < NQ; ++d0) qr[d0] = *(const bf16x8*)(Qg + (size_t)trow * ldq + d0 * 16 + hi * 8);
    const int NT = q0 / 64 + 4;
    int kso[KCH], vso[2];
#pragma unroll
    for (int i = 0; i < KCH; ++i) { const int L = (i * 8 + wid) * 1024 + lane * 16, row = L / ROWB, wi = L % ROWB; kso[i] = row * ldk + ((wi ^ ((row & 7) << 4)) >> 1); }
#pragma unroll
    for (int i = 0; i < 2; ++i) { const int L = (i * 8 + wid) * 1024 + lane * 16, sub = L >> 9, we = (L & 511) >> 1, kk = (sub >> 2) * 8 + (we >> 5), c = (sub & 3) * 32 + (we & 31);
        const int k = (kk & ~0xC) | ((kk & 4) << 1) | ((kk & 8) >> 1); vso[i] = k * ldv + c; }
#define AT_DMA(kb_, buf_) do { const bf16_t* kp_ = Kg + (size_t)(kb_) * ldk; const bf16_t* vp_ = Vg + (size_t)(kb_) * ldv; \
        _Pragma("unroll") for (int i_ = 0; i_ < KCH; ++i_) __builtin_amdgcn_global_load_lds((const unsigned*)(kp_ + kso[i_]), (LAS unsigned*)(K_lds + (buf_) * SHM_K + (i_ * 8 + wid) * 1024), 16, 0, 0); \
        _Pragma("unroll") for (int i_ = 0; i_ < 2; ++i_) __builtin_amdgcn_global_load_lds((const unsigned*)(vp_ + vso[i_]), (LAS unsigned*)(V_lds + (buf_) * AT_SHM_V + (i_ * 8 + wid) * 1024), 16, 0, 0); } while (0)
#if ATT_DMA
    AT_DMA((NT - 1) * 64, 0);
    asm volatile("s_waitcnt vmcnt(0)" ::: "memory");
    __syncthreads();
#else
    bf16x8 stk[KCH], stv[2];
    const int vk = tid >> 4, vc = (tid & 15) * 8;
#define AT_LOAD(kb_) do { _Pragma("unroll") for (int i_ = 0; i_ < KCH; ++i_) { const int c_ = tid + 512 * i_, row_ = c_ / NCH, cc_ = c_ % NCH; stk[i_] = *(const bf16x8*)(Kg + (size_t)((kb_) + row_) * ldk + cc_ * 8); } \
        _Pragma("unroll") for (int i_ = 0; i_ < 2; ++i_) stv[i_] = *(const bf16x8*)(Vg + (size_t)((kb_) + vk + 32 * i_) * ldv + vc); } while (0)
#define AT_WRITE(buf_) do { _Pragma("unroll") for (int i_ = 0; i_ < KCH; ++i_) { const int c_ = tid + 512 * i_, row_ = c_ / NCH, cc_ = c_ % NCH; \
            *(LAS bf16x8*)(K_lds + (buf_) * SHM_K + row_ * ROWB + ((cc_ * 16) ^ ((row_ & 7) << 4))) = stk[i_]; } \
        _Pragma("unroll") for (int i_ = 0; i_ < 2; ++i_) *(LAS bf16x8*)(V_lds + (buf_) * AT_SHM_V + v_st(vk + 32 * i_, vc)) = stv[i_]; } while (0)
    AT_LOAD((NT - 1) * 64); AT_WRITE(0);
    if (NT > 1) AT_LOAD((NT - 2) * 64);
    __syncthreads();
#endif
    f32x16 o[4];
#pragma unroll
    for (int d = 0; d < 4; ++d)
#pragma unroll
        for (int r = 0; r < 16; ++r) o[d][r] = 0.f;
    float m_reg = -1e30f, l_reg = 0.f, carry = (MODE == 0) ? 1.f : 0.f;
    float cft = 0.f; if (MODE == 1) cft = cfl[trow];
    int koff[4];
#pragma unroll
    for (int dd = 0; dd < 4; ++dd) koff[dd] = r32 * ROWB + ((dd * 32 + hi * 16) ^ ((r32 & 7) << 4));
    const int vbase = (int)(uintptr_t)V_lds + v_rd_base(lane);
    bool wdone = false;
    LAS unsigned* dflag = (LAS unsigned*)(lds + AT_OFF_CF);
    for (int it = 0; it < NT; ++it) {
        const int kb = (NT - 1 - it) * 64, cur = it & 1;
        bool alld = false;
        if (MODE == 0 && it > 0) {
            const LAS unsigned* fp = dflag + ((it - 1) & 1) * 8; const u32x4 f0 = *(const LAS u32x4*)fp, f1 = *(const LAS u32x4*)(fp + 4);
            alld = __builtin_amdgcn_readfirstlane(f0.x & f0.y & f0.z & f0.w & f1.x & f1.y & f1.z & f1.w) != 0u;
        }
        const bool act = (kb <= qlo + 31) && !wdone;
#if ATT_DMA
        if (it + 1 < NT && !alld) AT_DMA(kb - 64, cur ^ 1);
#endif
        if (act) {
            f32x16 p0, p1;
#pragma unroll
            for (int r = 0; r < 16; ++r) { p0[r] = 0.f; p1[r] = 0.f; }
            const LAS unsigned char* kbase = K_lds + cur * SHM_K;
#pragma unroll
            for (int dg = 0; dg < NQ / 4; ++dg) {
                bf16x8 kf0[4], kf1[4];
#pragma unroll
                for (int dd = 0; dd < 4; ++dd) { const LAS unsigned char* a = kbase + koff[dd] + dg * 128; kf0[dd] = *(const LAS bf16x8*)a; kf1[dd] = *(const LAS bf16x8*)(a + 32 * ROWB); }
#pragma unroll
                for (int dd = 0; dd < 4; ++dd) { p0 = __builtin_amdgcn_mfma_f32_32x32x16_bf16(kf0[dd], qr[dg * 4 + dd], p0, 0, 0, 0); p1 = __builtin_amdgcn_mfma_f32_32x32x16_bf16(kf1[dd], qr[dg * 4 + dd], p1, 0, 0, 0); }
                __builtin_amdgcn_sched_barrier(0);
            }
            const int dq = trow - kb - 4 * hi;
            if (MODE == 0) {
                const bool needm = kb + 63 >= qlo;
                f32x16 kA, kB;
#pragma unroll
                for (int r = 0; r < 16; ++r) { p0[r] = fminf(p0[r] * C2, 80.f); p1[r] = fminf(p1[r] * C2, 80.f); }
#pragma unroll
                for (int r = 0; r < 16; ++r) { p0[r] = __builtin_amdgcn_exp2f(p0[r]); p1[r] = __builtin_amdgcn_exp2f(p1[r]); }
                __builtin_amdgcn_sched_barrier(0);
#pragma unroll
                for (int r = 0; r < 16; ++r) { kA[r] = 1.f + p0[r]; kB[r] = 1.f + p1[r]; }
                __builtin_amdgcn_sched_barrier(0);
#pragma unroll
                for (int r = 0; r < 16; ++r) { kA[r] = __builtin_amdgcn_rcpf(kA[r]); kB[r] = __builtin_amdgcn_rcpf(kB[r]); }
                __builtin_amdgcn_sched_barrier(0);
#pragma unroll
                for (int r = 0; r < 16; ++r) { p0[r] *= kA[r]; p1[r] *= kB[r]; }
                if (needm) {
#pragma unroll
                    for (int r = 0; r < 16; ++r) { const int c = (r & 3) + 8 * (r >> 2);
                        if (!(c < dq)) { kA[r] = 1.f; p0[r] = 0.f; } if (!(c + 32 < dq)) { kB[r] = 1.f; p1[r] = 0.f; } }
                }
                __builtin_amdgcn_sched_barrier(0);
                float run = carry;
#pragma unroll
                for (int g = 7; g >= 0; --g) {
                    const float gp = (g < 4) ? (kA[4 * g] * kA[4 * g + 1]) * (kA[4 * g + 2] * kA[4 * g + 3]) : (kB[4 * (g - 4)] * kB[4 * (g - 4) + 1]) * (kB[4 * (g - 4) + 2] * kB[4 * (g - 4) + 3]);
                    auto rr = __builtin_amdgcn_permlane32_swap(__float_as_uint(gp), __float_as_uint(gp), false, false);
                    const float e = __uint_as_float(rr[0]), od = __uint_as_float(rr[1]);
                    const float base = hi ? run : run * od;
                    if (g < 4) { const int b = 4 * g; const float l3 = base, l2 = l3 * kA[b + 3], l1 = l2 * kA[b + 2], l0 = l1 * kA[b + 1];
                        p0[b] *= l0; p0[b + 1] *= l1; p0[b + 2] *= l2; p0[b + 3] *= l3; }
                    else { const int b = 4 * (g - 4); const float l3 = base, l2 = l3 * kB[b + 3], l1 = l2 * kB[b + 2], l0 = l1 * kB[b + 1];
                        p1[b] *= l0; p1[b + 1] *= l1; p1[b + 2] *= l2; p1[b + 3] *= l3; }
                    run *= e * od;
                }
                carry = run;
                __builtin_amdgcn_sched_barrier(0);
            } else {
                if (MODE == 1) {
#pragma unroll
                    for (int g = 0; g < 4; ++g) { const f32x4 c0 = *(const LAS f32x4*)(cfl + kb + 8 * g + 4 * hi), c1 = *(const LAS f32x4*)(cfl + kb + 32 + 8 * g + 4 * hi);
#pragma unroll
                        for (int i = 0; i < 4; ++i) { p0[4 * g + i] = fmaf(p0[4 * g + i], C2, cft - c0[i]); p1[4 * g + i] = fmaf(p1[4 * g + i], C2, cft - c1[i]); } }
                } else {
#pragma unroll
                    for (int r = 0; r < 16; ++r) { p0[r] *= C2; p1[r] *= C2; }
                }
                if (kb + 63 > qlo) {
#pragma unroll
                    for (int r = 0; r < 16; ++r) { const int c = (r & 3) + 8 * (r >> 2); if (!(c <= dq)) p0[r] = -__builtin_inff(); if (!(c + 32 <= dq)) p1[r] = -__builtin_inff(); }
                }
                float pmax = p0[0];
#pragma unroll
                for (int r = 1; r < 16; ++r) pmax = fmaxf(pmax, p0[r]);
#pragma unroll
                for (int r = 0; r < 16; ++r) pmax = fmaxf(pmax, p1[r]);
                { auto rr = __builtin_amdgcn_permlane32_swap(__float_as_uint(pmax), __float_as_uint(pmax), false, false); pmax = fmaxf(__uint_as_float(rr[0]), __uint_as_float(rr[1])); }
                const float mn = fmaxf(m_reg, pmax); const float alpha = __builtin_amdgcn_exp2f(m_reg - mn); m_reg = mn;
                float ps = 0.f;
#pragma unroll
                for (int r = 0; r < 16; ++r) { p0[r] = __builtin_amdgcn_exp2f(p0[r] - mn); p1[r] = __builtin_amdgcn_exp2f(p1[r] - mn); ps += p0[r] + p1[r]; }
                { auto rr = __builtin_amdgcn_permlane32_swap(__float_as_uint(ps), __float_as_uint(ps), false, false); ps = __uint_as_float(rr[0]) + __uint_as_float(rr[1]); }
                l_reg = l_reg * alpha + ps;
                if (__any(alpha < 1.f)) {
                    if (hi == 0) al_l[r32] = alpha;
                    asm volatile("s_waitcnt lgkmcnt(0)" ::: "memory");
#pragma unroll
                    for (int g = 0; g < 4; ++g) { const f32x4 av = *(const LAS f32x4*)(al_l + 8 * g + 4 * hi);
#pragma unroll
                        for (int d = 0; d < 4; ++d)
#pragma unroll
                            for (int i = 0; i < 4; ++i) o[d][4 * g + i] *= av[i]; }
                }
            }
            bf16x8 pa0, pa1, pa2, pa3;
#define PK4(P, B_, OUT) do { unsigned a0 = cvtpk(P[B_+0], P[B_+1]), a1 = cvtpk(P[B_+2], P[B_+3]); unsigned b0 = cvtpk(P[B_+4], P[B_+5]), b1 = cvtpk(P[B_+6], P[B_+7]); \
        auto r0 = __builtin_amdgcn_permlane32_swap(a0, b0, false, false); auto r1 = __builtin_amdgcn_permlane32_swap(a1, b1, false, false); \
        u32x4 w = {r0[0], r1[0], r0[1], r1[1]}; OUT = *reinterpret_cast<bf16x8*>(&w); } while (0)
            PK4(p0, 0, pa0); PK4(p0, 8, pa1); PK4(p1, 0, pa2); PK4(p1, 8, pa3);
#undef PK4
            const int vb0 = vbase + cur * AT_SHM_V;
#define TRRD(dst, off) asm volatile("ds_read_b64_tr_b16 %0, %1 offset:%2" : "=&v"(dst) : "v"(vb0), "i"(off) : "memory")
#define PV_D0(d0) do { s16x4 l0, l1, l2, l3, h0, h1, h2, h3; constexpr int b_ = v_rd_off(d0, 0, 0); \
        TRRD(l0, b_); TRRD(h0, b_ + 2048); TRRD(l1, b_ + 4096); TRRD(h1, b_ + 6144); TRRD(l2, b_ + 8192); TRRD(h2, b_ + 10240); TRRD(l3, b_ + 12288); TRRD(h3, b_ + 14336); \
        asm volatile("s_waitcnt lgkmcnt(0)" ::: "memory"); __builtin_amdgcn_sched_barrier(0); \
        o[d0] = __builtin_amdgcn_mfma_f32_32x32x16_bf16(pa0, (bf16x8){l0[0], l0[1], l0[2], l0[3], h0[0], h0[1], h0[2], h0[3]}, o[d0], 0, 0, 0); \
        o[d0] = __builtin_amdgcn_mfma_f32_32x32x16_bf16(pa1, (bf16x8){l1[0], l1[1], l1[2], l1[3], h1[0], h1[1], h1[2], h1[3]}, o[d0], 0, 0, 0); \
        o[d0] = __builtin_amdgcn_mfma_f32_32x32x16_bf16(pa2, (bf16x8){l2[0], l2[1], l2[2], l2[3], h2[0], h2[1], h2[2], h2[3]}, o[d0], 0, 0, 0); \
        o[d0] = __builtin_amdgcn_mfma_f32_32x32x16_bf16(pa3, (bf16x8){l3[0], l3[1], l3[2], l3[3], h3[0], h3[1], h3[2], h3[3]}, o[d0], 0, 0, 0); } while (0)
            PV_D0(0); PV_D0(1); PV_D0(2); PV_D0(3);
#undef PV_D0
#undef TRRD
        }
        if (MODE == 0) { if (kb <= qlo + 31) wdone = __all(carry < 1e-37f) != 0; if (lane == 0) dflag[(it & 1) * 8 + wid] = wdone ? 1u : 0u; }
#if ATT_DMA
        asm volatile("s_waitcnt vmcnt(0)" ::: "memory");
#else
        if (it + 1 < NT) { AT_WRITE(cur ^ 1); if (it + 2 < NT) AT_LOAD((NT - 3 - it) * 64); }
#endif
        __syncthreads();
    }
#undef AT_DMA
    float rli[16];
    if (MODE != 0) {
        if (hi == 0) li_l[r32] = l_reg;
        asm volatile("s_waitcnt lgkmcnt(0)" ::: "memory");
#pragma unroll
        for (int g = 0; g < 4; ++g) { const f32x4 lv = *(const LAS f32x4*)(li_l + 8 * g + 4 * hi);
#pragma unroll
            for (int i = 0; i < 4; ++i) rli[4 * g + i] = 1.0f / lv[i]; }
    } else {
#pragma unroll
        for (int r = 0; r < 16; ++r) rli[r] = 1.f;
    }
    bf16_t* Ow = Og + (size_t)qlo * ldo;
#pragma unroll
    for (int r = 0; r < 16; ++r) { const int orow = crow(r, hi);
#pragma unroll
        for (int d0 = 0; d0 < 4; ++d0) { const float v = o[d0][r] * rli[r]; const float vn = __shfl_xor(v, 1);
            if ((r32 & 1) == 0) *(unsigned*)(Ow + (size_t)orow * ldo + d0 * 32 + r32) = cvtpk(v, vn); } }
}

template <int DQK, int MODE>
__device__ __forceinline__ void attn_phase(const bf16_t* Qb, int ldq, int hq, const bf16_t* Kb, int ldk, int hk, const bf16_t* Vb, int ldv, int hv, bf16_t* Ob, const float* cf, float C2, LAS unsigned char* lds) {
#ifdef TESTCOPY
    if (MODE == 0) {
        for (size_t i = (size_t)blockIdx.x * 512 + threadIdx.x; i < (size_t)NTOK * DM; i += (size_t)gridDim.x * 512) {
            const float a = __uint_as_float((unsigned)Qb[i] << 16) + __uint_as_float((unsigned)Kb[i] << 16) + __uint_as_float((unsigned)Vb[i] << 16);
            Ob[i] = (bf16_t)(__float_as_uint(sinf(300.f * a)) >> 16); }
        return;
    }
#endif
#ifdef TESTNAN
    for (int i = threadIdx.x; i < LDS_BYTES / 4; i += 512) ((LAS unsigned*)lds)[i] = 0xFFFFFFFFu;
    __syncthreads();
#endif
    for (int w = blockIdx.x; w < 256; w += gridDim.x) {
        const int xcd = w & 7, slot = w >> 3, bh = xcd * 8 + (slot >> 2), y = slot & 3, b = bh >> 4, hd = bh & 15;
        if (MODE == 1) { LAS float* cfl = (LAS float*)(lds + AT_OFF_CF);
            for (int s = threadIdx.x; s < SEQ; s += 512) cfl[s] = cf[(size_t)bh * SEQ + s] * LOG2E;
            __syncthreads(); }
        const bf16_t* Q = Qb + (size_t)b * SEQ * ldq + hd * hq; const bf16_t* K = Kb + (size_t)b * SEQ * ldk + hd * hk; const bf16_t* V = Vb + (size_t)b * SEQ * ldv + hd * hv;
        bf16_t* O = Ob + (size_t)b * SEQ * DM + hd * HD;
        attn_block<DQK, MODE>(Q, ldq, K, ldk, V, ldv, O, DM, (7 - y) * 256, C2, lds);
        attn_block<DQK, MODE>(Q, ldq, K, ldk, V, ldv, O, DM, y * 256, C2, lds);
        __syncthreads();
    }
}

#define XB_TMO      128
#define XB_XCNT(j)  (256  + 64 * (j))
#define XB_XSUB(j)  (1280 + 64 * (j))
#define XB_XGEN(j)  (2304 + 64 * (j))
#define XB_TOP      3328
#define XB_TOPGEN   3392
#define XCD_BAR_WORDS 3456
#define XB_SPIN_CAP (1u << 18)
__device__ __forceinline__ unsigned xb_ld(unsigned* p)              { return __hip_atomic_load(p, __ATOMIC_RELAXED, __HIP_MEMORY_SCOPE_AGENT); }
__device__ __forceinline__ unsigned xb_add(unsigned* p, unsigned v) { return __hip_atomic_fetch_add(p, v, __ATOMIC_RELAXED, __HIP_MEMORY_SCOPE_AGENT); }
__device__ __forceinline__ unsigned xb_xcc_id() { return (unsigned)__builtin_amdgcn_s_getreg((3 << 11) | 20) & 0xFu; }
#define XB_SPIN(cond, bar) do { unsigned _sp = 0; while (cond) { __builtin_amdgcn_s_sleep(1); \
    if ((++_sp & 255u) == 0u) { if (xb_ld(&(bar)[XB_TMO])) break; if (_sp > XB_SPIN_CAP) { atomicAdd(&(bar)[XB_TMO], 1u); break; } } } } while (0)
struct XcdBarrier { unsigned* bar; unsigned x; volatile LAS unsigned* st; };
__device__ __forceinline__ XcdBarrier xcd_barrier_post(unsigned* bar, volatile LAS unsigned* st) {
    XcdBarrier b; b.bar = bar; b.x = xb_xcc_id(); b.st = st;
    if (threadIdx.x == 0) (void)xb_add(&bar[XB_XCNT(b.x)], 1u);
    return b;
}
__device__ __forceinline__ void xcd_barrier_complete(unsigned* bar, unsigned x, unsigned& nloc, unsigned& nx) {
    const unsigned G = gridDim.x * gridDim.y * gridDim.z;
    unsigned sum, cnt, mine, sp = 0u;
    for (;;) {
        sum = 0u; cnt = 0u; mine = 0u;
#pragma unroll
        for (unsigned j = 0; j < 16; ++j) { const unsigned c = xb_ld(&bar[XB_XCNT(j)]); sum += c; cnt += (c > 0u) ? 1u : 0u; mine = (j == x) ? c : mine; }
        if (sum == G) break;
        __builtin_amdgcn_s_sleep(1);
        if ((++sp & 255u) == 0u) { if (xb_ld(&bar[XB_TMO])) break; if (sp > XB_SPIN_CAP) { atomicAdd(&bar[XB_TMO], 1u); break; } }
    }
    nloc = mine > 0u ? mine : 1u; nx = cnt > 0u ? cnt : 1u;
}
__device__ __forceinline__ void xcd_barrier(const XcdBarrier& b) {
    asm volatile("s_waitcnt vmcnt(0)" ::: "memory");
    __syncthreads();
    if (threadIdx.x == 0) {
        unsigned* bar = b.bar;
        __builtin_amdgcn_s_waitcnt(0);
        unsigned nloc = b.st[0], nx = b.st[1];
        if (nloc == 0u) { xcd_barrier_complete(bar, b.x, nloc, nx); b.st[0] = nloc; b.st[1] = nx; }
        const unsigned old = xb_add(&bar[XB_XSUB(b.x)], 1u);
        const unsigned gen = old / nloc;
        if (old + 1u == (gen + 1u) * nloc) {
            __builtin_amdgcn_fence(__ATOMIC_RELEASE, "agent");
            asm volatile("s_waitcnt vmcnt(0)" ::: "memory");
            const unsigned og = xb_add(&bar[XB_TOP], 1u);
            const unsigned tg = og / nx;
            if (og + 1u == (tg + 1u) * nx) xb_add(&bar[XB_TOPGEN], 1u);
            else XB_SPIN(xb_ld(&bar[XB_TOPGEN]) == tg, bar);
            __builtin_amdgcn_fence(__ATOMIC_ACQUIRE, "agent");
            xb_add(&bar[XB_XGEN(b.x)], 1u);
            asm volatile("s_waitcnt vmcnt(0)" ::: "memory");
        } else {
            XB_SPIN(xb_ld(&bar[XB_XGEN(b.x)]) == gen, bar);
            __builtin_amdgcn_fence(__ATOMIC_ACQUIRE, "agent");
            asm volatile("s_waitcnt vmcnt(0)" ::: "memory");
        }
    }
    __syncthreads();
}

#ifndef NLAYERS
#define NLAYERS 4
#endif
constexpr int N_PHASES = 1 + 10 * NLAYERS;
__host__ __device__ inline bool phase_active(int ph) {
    if (ph == 0) return false;
    const int layer = (ph - 1) / 10, s = (ph - 1) % 10, kind = layer % 3;
    if (s == 2) return kind != 0;
    if (s == 3 || s == 4) return kind == 2;
    return true;
}

__global__ void __launch_bounds__(512, 2) fwd_megakernel(Params p) {
    extern __shared__ __attribute__((aligned(16))) unsigned char shm_raw[];
    LAS unsigned char* lds = (LAS unsigned char*)shm_raw;
    unsigned char* ws = p.ws;
    float* X = (float*)(ws + WS_X); bf16_t* H = (bf16_t*)(ws + WS_H); bf16_t* AO = p.alt ? (bf16_t*)(ws + WS_SCR + (size_t)NTOK * DFF * 2) : (bf16_t*)(ws + WS_AO);
    float* LOGF = (float*)(ws + WS_LOGF); float* CF = (float*)(ws + WS_CF); float* ROPE = (float*)(ws + WS_ROPE); float* KR = (float*)(ws + WS_KR);
    unsigned char* scr = ws + WS_SCR;
    bool first = true;
#if COOP
    volatile LAS unsigned* st = (volatile LAS unsigned*)(lds + 131072);
    if (threadIdx.x == 0) { st[0] = 0u; st[1] = 0u; }
    __syncthreads();
    const XcdBarrier xb = xcd_barrier_post((unsigned*)(ws + WS_BAR), st);
    int nsync = 0;
#endif
    for (int ph = (int)p.ph_lo; ph < (int)p.ph_hi; ++ph) {
        if (!phase_active(ph)) continue;
#if COOP
        if (!first) { if (nsync == 0) cg::this_grid().sync(); else xcd_barrier(xb); ++nsync; }
#endif
        first = false;
        const int layer = (ph - 1) / 10, s = (ph - 1) % 10, kind = layer % 3, j = layer / 3;
        const float* xin = (layer == 0) ? p.x : X;
        int ng = 0; GemmJob g0{}, g1{}; bool do_fgate = false;
        g0.M = NTOK; g1.M = NTOK;
        if (s == 0 || s == 7) {
            if (s == 0 && EN(100)) {
                if (kind == 0) {
                    conv_job(lds, p.sb_w_in + (size_t)j * 2048 * 6144, 6144, 0, 6144, 6144, 2048, (bf16_t*)(ws + W_SB_IN + j * SZ_QKVW));
                    conv_job(lds, p.sb_w_out + (size_t)j * 2048 * 2048, 2048, 0, 2048, 2048, 2048, (bf16_t*)(ws + W_SB_OUT + j * SZ_SQW));
                } else if (kind == 1) {
                    conv_job(lds, p.fox_w_in, 6160, 0, 6144, 6144, 2048, (bf16_t*)(ws + W_FOX_IN));
                    conv_job(lds, p.fox_w_in, 6160, 6144, 16, 128, 2048, (bf16_t*)(ws + W_FOX_F));
                    conv_job(lds, p.fox_w_out, 2048, 0, 2048, 2048, 2048, (bf16_t*)(ws + W_FOX_OUT));
                } else {
                    conv_job(lds, p.mla_w_in, MLA_DOWN, 0, MLA_DOWN, MLA_DOWN_PAD, 2048, (bf16_t*)(ws + W_MLA_IN));
                    conv_job(lds, p.mla_w_uq, 3072, 0, 3072, 3072, 768, (bf16_t*)(ws + W_MLA_UQ));
                    conv_job(lds, p.mla_w_ukv, 4096, 0, 4096, 4096, 512, (bf16_t*)(ws + W_MLA_UKV));
                    conv_job(lds, p.mla_w_out, 2048, 0, 2048, 2048, 2048, (bf16_t*)(ws + W_MLA_OUT));
                }
                conv_job(lds, p.mlp_w1 + (size_t)layer * 2048 * 8192, 8192, 0, 8192, 8192, 2048, (bf16_t*)(ws + W_W1 + layer * SZ_FFW));
                conv_job(lds, p.mlp_w2 + (size_t)layer * 8192 * 2048, 2048, 0, 2048, 2048, 8192, (bf16_t*)(ws + W_W2 + layer * SZ_FFW));
            }
            if (EN(0)) rmsnorm_phase(s == 0 ? xin : X, (s == 0 ? p.mix_norm : p.mlp_norm) + layer * DM, H);
        }
        else if (s == 1) {
            ng = 1; g0.A = H; g0.K = DM;
            if (kind == 2) { g0.Bt = (const bf16_t*)(ws + W_MLA_IN); g0.N = MLA_DOWN_PAD; g0.E = pg8::EpiGen{0, (bf16_t*)(scr + SC_DOWN), MLA_DOWN_PAD, 0, 0, nullptr, nullptr}; }
            else { g0.Bt = (const bf16_t*)(ws + (kind == 0 ? W_SB_IN + j * SZ_QKVW : W_FOX_IN)); g0.N = 3 * DM; g0.E = pg8::EpiGen{0, (bf16_t*)(scr + SC_Q), DM, DM, (size_t)NTOK * DM, nullptr, nullptr}; do_fgate = kind == 1; }
        } else if (s == 2) {
            if (kind == 1) { if (EN(2)) fox_prep_phase((bf16_t*)(scr + SC_Q), p.fox_q_gain, p.fox_k_gain, LOGF, CF); }
            else { if (EN(2)) mla_prep1_phase((const bf16_t*)(scr + SC_DOWN), p.pos, p.mla_q_norm, p.mla_kv_norm, (bf16_t*)(scr + SC_CQ), (bf16_t*)(scr + SC_CKV), ROPE, KR); }
        } else if (s == 3) {
            ng = 2;
            g0.A = (const bf16_t*)(scr + SC_CQ); g0.Bt = (const bf16_t*)(ws + W_MLA_UQ); g0.N = 3072; g0.K = MLA_QR; g0.E = pg8::EpiGen{0, (bf16_t*)(scr + SC_QUP), 3072, 0, 0, nullptr, nullptr};
            g1.A = (const bf16_t*)(scr + SC_CKV); g1.Bt = (const bf16_t*)(ws + W_MLA_UKV); g1.N = 4096; g1.K = MLA_KVR; g1.E = pg8::EpiGen{0, (bf16_t*)(scr + SC_KV), 4096, 0, 0, nullptr, nullptr};
        } else if (s == 4) { if (EN(4)) mla_prep2_phase((const bf16_t*)(scr + SC_QUP), (const bf16_t*)(scr + SC_KV), ROPE, KR, p.mla_q_gain, p.mla_k_gain, (bf16_t*)(scr + SC_QN), (bf16_t*)(scr + SC_KN)); }
        else if (s == 5) {
            if (kind == 0) { if (EN(50)) attn_phase<128, TESTMODE2 ? 2 : 0>((const bf16_t*)(scr + SC_Q), DM, HD, (const bf16_t*)(scr + SC_K), DM, HD, (const bf16_t*)(scr + SC_V), DM, HD, AO, nullptr, 0.08838834764831845f * LOG2E, lds); }
            else if (kind == 1) { if (EN(51)) attn_phase<128, 1>((const bf16_t*)(scr + SC_Q), DM, HD, (const bf16_t*)(scr + SC_K), DM, HD, (const bf16_t*)(scr + SC_V), DM, HD, AO, CF, 0.08838834764831845f * LOG2E, lds); }
            else { if (EN(52)) attn_phase<192, 2>((const bf16_t*)(scr + SC_QN), 3072, 192, (const bf16_t*)(scr + SC_KN), 3072, 192, (const bf16_t*)(scr + SC_KV) + 128, 4096, 256, AO, nullptr, 0.07216878364870323f * LOG2E, lds); }
        } else if (s == 6) {
            ng = 1; g0.A = AO; g0.K = DM; g0.N = DM; g0.Bt = (const bf16_t*)(ws + (kind == 0 ? W_SB_OUT + j * SZ_SQW : (kind == 1 ? W_FOX_OUT : W_MLA_OUT)));
            g0.E = pg8::EpiGen{2, nullptr, DM, 0, 0, xin, X};
        } else if (s == 8) {
            ng = 1; g0.A = H; g0.K = DM; g0.N = DFF; g0.Bt = (const bf16_t*)(ws + W_W1 + layer * SZ_FFW); g0.E = pg8::EpiGen{1, (bf16_t*)scr, DFF, 0, 0, nullptr, nullptr};
        } else {
            ng = 1; g0.A = (const bf16_t*)scr; g0.K = DFF; g0.N = DM; g0.Bt = (const bf16_t*)(ws + W_W2 + layer * SZ_FFW); g0.E = pg8::EpiGen{2, nullptr, DM, 0, 0, X, (layer == NLAYERS - 1) ? p.out : X};
        }
        if (EN(1)) {
#pragma nounroll
            for (int gi = 0; gi < ng; ++gi) run_gemm(lds, gi ? g1 : g0);
        }
        if (do_fgate && EN(2)) fgate_phase(H, (const bf16_t*)(ws + W_FOX_F), p.fox_b_f, LOGF);
    }
}

__global__ void k_cmp(const unsigned* a, const unsigned* b, size_t n, unsigned* cnt) {
    unsigned c = 0;
    for (size_t i = (size_t)blockIdx.x * blockDim.x + threadIdx.x; i < n; i += (size_t)gridDim.x * blockDim.x) c += (a[i] != b[i]) ? 1u : 0u;
    if (c) atomicAdd(cnt, c);
}
__global__ void k_out(float* out, size_t n, const unsigned* cnt) {
    for (size_t i = (size_t)blockIdx.x * blockDim.x + threadIdx.x; i < n; i += (size_t)gridDim.x * blockDim.x) out[i] = 0.f;
    if (blockIdx.x == 0 && threadIdx.x == 0) out[0] = cnt[0] ? 3.0e5f : 1.0e5f;
}
extern "C" void kernel_launch(void* const* d_in, const int* in_sizes, int n_in, void* d_out, int out_size, void* d_ws, size_t ws_size, hipStream_t stream) {
    static int grid = 0;
    if (grid == 0) {
        if (n_in != 21 || out_size != NTOK * DM || ws_size < WS_END) { fprintf(stderr, "kernel_launch: unexpected shapes (n_in %d out %d ws %zu need %zu)\n", n_in, out_size, ws_size, (size_t)WS_END); grid = -1; return; }
        int dev = 0, cus = 0, per_cu = 0;
        hipGetDevice(&dev); hipDeviceGetAttribute(&cus, hipDeviceAttributeMultiprocessorCount, dev);
        if (hipFuncSetAttribute((const void*)fwd_megakernel, hipFuncAttributeMaxDynamicSharedMemorySize, LDS_BYTES) != hipSuccess) { fprintf(stderr, "kernel_launch: hipFuncSetAttribute failed\n"); grid = -1; return; }
        if (hipOccupancyMaxActiveBlocksPerMultiprocessor(&per_cu, (const void*)fwd_megakernel, 512, LDS_BYTES) != hipSuccess || per_cu < 1) { fprintf(stderr, "kernel_launch: occupancy query says %d\n", per_cu); per_cu = 1; }
        (void)hipGetLastError();
        grid = cus * 1;
        if (grid > 256) grid = 256;
    }
    if (grid < 0) return;
    Params p{};
    p.x = (const float*)d_in[0]; p.pos = (const int*)d_in[1]; p.mix_norm = (const float*)d_in[2]; p.mlp_norm = (const float*)d_in[3];
    p.sb_w_in = (const float*)d_in[4]; p.sb_w_out = (const float*)d_in[5]; p.fox_w_in = (const float*)d_in[6]; p.fox_b_f = (const float*)d_in[7];
    p.fox_q_gain = (const float*)d_in[8]; p.fox_k_gain = (const float*)d_in[9]; p.fox_w_out = (const float*)d_in[10];
    p.mla_w_in = (const float*)d_in[11]; p.mla_q_norm = (const float*)d_in[12]; p.mla_kv_norm = (const float*)d_in[13]; p.mla_w_uq = (const float*)d_in[14]; p.mla_w_ukv = (const float*)d_in[15];
    p.mla_q_gain = (const float*)d_in[16]; p.mla_k_gain = (const float*)d_in[17]; p.mla_w_out = (const float*)d_in[18]; p.mlp_w1 = (const float*)d_in[19]; p.mlp_w2 = (const float*)d_in[20];
    p.out = (float*)d_out; p.ws = (unsigned char*)d_ws;
#if COOP
    hipMemsetAsync((char*)d_ws + WS_BAR, 0, 16384, stream);
    p.ph_lo = 0; p.ph_hi = N_PHASES;
    void* args[] = {&p};
    hipError_t e = hipLaunchCooperativeKernel((const void*)fwd_megakernel, dim3(grid), dim3(512), args, LDS_BYTES, stream);
    if (e != hipSuccess) fprintf(stderr, "cooperative launch failed: %s (grid %d)\n", hipGetErrorString(e), grid);
#else
    for (int ph = 0; ph < N_PHASES; ++ph) {
        if (!phase_active(ph)) continue;
        p.ph_lo = ph; p.ph_hi = ph + 1;
        hipLaunchKernelGGL(fwd_megakernel, dim3(grid), dim3(512), LDS_BYTES, stream, p);
#ifdef TESTDUP
        if (ph == 6) { p.alt = 1; hipLaunchKernelGGL(fwd_megakernel, dim3(grid), dim3(512), LDS_BYTES, stream, p); p.alt = 0; }
#endif
    }
#ifdef TESTDUP
    unsigned* cnt = (unsigned*)((char*)d_ws + WS_LOGF);
    hipMemsetAsync(cnt, 0, 4, stream);
    hipLaunchKernelGGL(k_cmp, dim3(1024), dim3(256), 0, stream, (const unsigned*)((char*)d_ws + WS_AO), (const unsigned*)((char*)d_ws + WS_SCR + (size_t)NTOK * DFF * 2), (size_t)NTOK * DM / 2, cnt);
    hipLaunchKernelGGL(k_out, dim3(1024), dim3(256), 0, stream, (float*)d_out, (size_t)NTOK * DM, (const unsigned*)cnt);
#endif
#endif
}
```

```cpp
#include <hip/hip_runtime.h>
#include <hip/hip_cooperative_groups.h>
#include <cstdio>
#include <cstdint>
namespace cg = cooperative_groups;

#ifndef COOP
#define COOP 1
#endif
#ifndef ONLY
#define ONLY -1
#endif
#ifndef ATT_DMA
#define ATT_DMA 1
#endif
#define TESTMODE2 0

#ifndef SKIP
#define SKIP -5
#endif
#define EN(x) ((ONLY < 0 || ONLY == (x)) && (x) != SKIP)

#define LAS __attribute__((address_space(3)))
typedef unsigned short bf16_t;
typedef short bf16x8 __attribute__((ext_vector_type(8)));
typedef short s16x4 __attribute__((ext_vector_type(4)));
typedef float f32x4 __attribute__((ext_vector_type(4)));
typedef float f32x16 __attribute__((ext_vector_type(16)));
typedef unsigned u32x4 __attribute__((ext_vector_type(4)));
typedef unsigned u32x2 __attribute__((ext_vector_type(2)));

constexpr int DM = 2048, NTOK = 8192, SEQ = 2048, NH = 16, HD = 128, DFF = 8192, DEPTH = 4;
constexpr int MLA_QR = 768, MLA_KVR = 512, MLA_ROPE = 64, MLA_QK = 192, MLA_DOWN = 1344, MLA_DOWN_PAD = 1536;
constexpr float EPS = 1e-6f;
constexpr float LOG2E = 1.4426950408889634f;

constexpr size_t SZ_QKVW = (size_t)6144 * 2048 * 2, SZ_SQW = (size_t)2048 * 2048 * 2, SZ_FFW = (size_t)8192 * 2048 * 2;
constexpr size_t W_SB_IN = 0;
constexpr size_t W_SB_OUT = W_SB_IN + 2 * SZ_QKVW;
constexpr size_t W_FOX_IN = W_SB_OUT + 2 * SZ_SQW;
constexpr size_t W_FOX_F = W_FOX_IN + SZ_QKVW;
constexpr size_t W_FOX_OUT = W_FOX_F + (size_t)128 * 2048 * 2;
constexpr size_t W_MLA_IN = W_FOX_OUT + SZ_SQW;
constexpr size_t W_MLA_UQ = W_MLA_IN + (size_t)1536 * 2048 * 2;
constexpr size_t W_MLA_UKV = W_MLA_UQ + (size_t)3072 * 768 * 2;
constexpr size_t W_MLA_OUT = W_MLA_UKV + (size_t)4096 * 512 * 2;
constexpr size_t W_W1 = W_MLA_OUT + SZ_SQW;
constexpr size_t W_W2 = W_W1 + 4 * SZ_FFW;
constexpr size_t WS_X = W_W2 + 4 * SZ_FFW;
constexpr size_t WS_H = WS_X + (size_t)NTOK * DM * 4;
constexpr size_t WS_AO = WS_H + (size_t)NTOK * DM * 2;
constexpr size_t WS_LOGF = WS_AO + (size_t)NTOK * DM * 2;
constexpr size_t WS_CF = WS_LOGF + (size_t)NTOK * 16 * 4;
constexpr size_t WS_ROPE = WS_CF + (size_t)64 * 2048 * 4;
constexpr size_t WS_KR = WS_ROPE + (size_t)NTOK * 64 * 4;
constexpr size_t WS_SCR = WS_KR + (size_t)NTOK * 64 * 4;
constexpr size_t SC_Q = 0, SC_K = (size_t)NTOK * DM * 2, SC_V = 2 * (size_t)NTOK * DM * 2;
constexpr size_t SC_DOWN = 0;
constexpr size_t SC_CQ = SC_DOWN + (size_t)NTOK * MLA_DOWN_PAD * 2;
constexpr size_t SC_CKV = SC_CQ + (size_t)NTOK * MLA_QR * 2;
constexpr size_t SC_QUP = SC_CKV + (size_t)NTOK * MLA_KVR * 2;
constexpr size_t SC_KV = SC_QUP + (size_t)NTOK * 3072 * 2;
constexpr size_t SC_QN = SC_KV + (size_t)NTOK * 4096 * 2;
constexpr size_t SC_KN = SC_QN + (size_t)NTOK * 3072 * 2;
constexpr size_t SC_END = SC_KN + (size_t)NTOK * 3072 * 2;
constexpr size_t WS_BAR = WS_SCR + SC_END;
constexpr size_t WS_END = WS_BAR + 16384;

constexpr int LDS_BYTES = 131072 + 16;

struct Params {
    const float* x; const int* pos; const float* mix_norm; const float* mlp_norm;
    const float* sb_w_in; const float* sb_w_out; const float* fox_w_in; const float* fox_b_f; const float* fox_q_gain; const float* fox_k_gain; const float* fox_w_out;
    const float* mla_w_in; const float* mla_q_norm; const float* mla_kv_norm; const float* mla_w_uq; const float* mla_w_ukv; const float* mla_q_gain; const float* mla_k_gain; const float* mla_w_out;
    const float* mlp_w1; const float* mlp_w2;
    float* out; unsigned char* ws;
    long long ph_lo, ph_hi, alt;
};

__device__ __forceinline__ unsigned cvtpk(float lo, float hi) { unsigned r; asm volatile("v_cvt_pk_bf16_f32 %0, %1, %2" : "=v"(r) : "v"(lo), "v"(hi)); return r; }
__device__ __forceinline__ float bflo(unsigned w) { return __uint_as_float(w << 16); }
__device__ __forceinline__ float bfhi(unsigned w) { return __uint_as_float(w & 0xffff0000u); }
__device__ __forceinline__ int opq(int x) { asm volatile("" : "+v"(x)); return x; }
__device__ __forceinline__ float wave_sum(float v) {
#pragma unroll
    for (int o = 32; o > 0; o >>= 1) v += __shfl_xor(v, o);
    return v;
}
__device__ __forceinline__ float sum16(float v) {
#pragma unroll
    for (int o = 8; o > 0; o >>= 1) v += __shfl_xor(v, o);
    return v;
}

namespace pg8 {
constexpr int BM = 256, BK = 64, HALF = 128, HTB = HALF * BK * 2, STAGE_BYTES = 8 * HTB, NXCD = 8, WGM = 8;
__host__ __device__ __forceinline__ int lds_byte(int r, int c) { const int st = (r >> 4) * 2 + (c >> 5), rr = r & 15, cc = c & 31, ob = rr * 64 + cc * 2; return st * 1024 + (ob ^ (((ob >> 9) & 1) << 5)); }
__host__ __device__ __forceinline__ void stage_rc(int b, int& R, int& C) { const int st = b / 1024, sb = b % 1024, swz = sb ^ (((sb >> 9) & 1) << 5); R = (st >> 1) * 16 + swz / 64; C = (st & 1) * 32 + (swz % 64) / 2; }
__host__ __device__ __forceinline__ int perm32(int rho) { const int n = rho >> 4, i = rho & 15; return 8 * (i >> 2) + 4 * n + (i & 3); }
struct Unit { int pm, pn; };
struct Gemm { const bf16_t* A; const bf16_t* Bt; int M, N, K; };
struct StaticOrder {
    int nM, nN, nwg, G, c;
    __device__ void init(int M, int N, int G_, int c_) { nM = M / BM; nN = N / BM; nwg = nM * nN; G = G_; c = c_; }
    __device__ bool next(int i, Unit& u) const {
        const long L = (long)i * G + c; if (L >= nwg) return false;
        int wgid = (int)L; { const int q = nwg / NXCD, r = nwg % NXCD, xcd = wgid % NXCD, off = wgid / NXCD; wgid = (xcd < r ? xcd * (q + 1) : r * (q + 1) + (xcd - r) * q) + off; }
        const int nig = WGM * nN, gid = wgid / nig, fm = gid * WGM, gsz = (nM - fm) < WGM ? (nM - fm) : WGM;
        u.pm = fm + ((wgid % nig) % gsz); u.pn = (wgid % nig) / gsz; return true;
    }
};
struct EpiGen {
    int mode; bf16_t* O; int ldc; int split_cols; size_t split_stride; const float* R; float* C;
    __device__ __forceinline__ void operator()(const f32x4 (&acc)[2][2][4][2], const Unit& u, int wr, int wc, int fr, int fq) const {
        const int row0 = u.pm * BM + wr * 64 + fr;
        if (mode == 2) {
            const int col0 = u.pn * BM + wc * 32 + 4 * fq;
#pragma unroll
            for (int ai = 0; ai < 2; ++ai) {
                f32x4 rv[4][2][2];
#pragma unroll
                for (int m = 0; m < 4; ++m) { const size_t ro = (size_t)(row0 + ai * HALF + m * 16) * ldc + col0;
#pragma unroll
                    for (int bj = 0; bj < 2; ++bj)
#pragma unroll
                        for (int n = 0; n < 2; ++n) rv[m][bj][n] = *(const f32x4*)(R + ro + bj * HALF + n * 16); }
#pragma unroll
                for (int m = 0; m < 4; ++m) { const size_t ro = (size_t)(row0 + ai * HALF + m * 16) * ldc + col0;
#pragma unroll
                    for (int bj = 0; bj < 2; ++bj)
#pragma unroll
                        for (int n = 0; n < 2; ++n) *(f32x4*)(C + ro + bj * HALF + n * 16) = acc[ai][bj][m][n] + rv[m][bj][n]; }
            }
        } else {
            int colt = u.pn * BM; bf16_t* base = O;
            if (split_cols) { const int t = colt / split_cols; base += (size_t)t * split_stride; colt -= t * split_cols; }
            const int col0 = colt + wc * 32 + 8 * fq; const bool act = mode == 1;
#pragma unroll
            for (int ai = 0; ai < 2; ++ai)
#pragma unroll
                for (int m = 0; m < 4; ++m) { bf16_t* rowp = base + (size_t)(row0 + ai * HALF + m * 16) * ldc + col0;
#pragma unroll
                    for (int bj = 0; bj < 2; ++bj) { f32x4 v0 = acc[ai][bj][m][0], v1 = acc[ai][bj][m][1];
                        if (act) {
#pragma unroll
                            for (int j = 0; j < 4; ++j) { float x = fmaxf(v0[j], 0.f), y = fmaxf(v1[j], 0.f); v0[j] = x * x; v1[j] = y * y; } }
                        u32x4 w; w.x = cvtpk(v0[0], v0[1]); w.y = cvtpk(v0[2], v0[3]); w.z = cvtpk(v1[0], v1[1]); w.w = cvtpk(v1[2], v1[3]);
                        *(u32x4*)(rowp + bj * HALF) = w; } }
        }
    }
};

template <class Epi, class Sched>
__device__ __forceinline__ void gemm_phase(LAS unsigned char* lds, const Gemm g, const Sched& S, const Epi& E) {
    const int tid = opq(threadIdx.x), wid = __builtin_amdgcn_readfirstlane(tid >> 6), lane = tid & 63, wr = wid >> 2, wc = wid & 3, fr = lane & 15, fq = lane >> 4;
    const int K = g.K, nt = K / BK;
    unsigned voffA[2], voffB[2];
#pragma unroll
    for (int i = 0; i < 2; ++i) { int R, C; stage_rc(tid * 16 + i * 8192, R, C); const int Rb = (E.mode != 2) ? ((R & ~31) + perm32(R & 31)) : R;
        voffA[i] = (unsigned)(R * K + C) * 2u; voffB[i] = (unsigned)(Rb * K + C) * 2u; }
    const size_t kstep = (size_t)(BK * 2);
    const size_t hstep = (size_t)HALF * K * 2;
    const size_t tstep = 2 * hstep;
    const unsigned ldsw = (unsigned)wid * 1024u;
    const int aoff = lds_byte(wr * 64 + fr, fq * 8), boff = lds_byte(wc * 32 + fr, fq * 8);
#define PG8_SA(b, h) (((b) * 2 + (h)) * HTB)
#define PG8_SB(b, h) ((4 + (b) * 2 + (h)) * HTB)
#define PG8_STAGE(bufoff, gbase, voff) do { _Pragma("unroll") for (int _i = 0; _i < 2; ++_i) \
        __builtin_amdgcn_global_load_lds((const unsigned*)((const char*)(gbase) + (voff)[_i]), (LAS unsigned*)(lds + (bufoff) + ldsw + _i * 8192), 16, 0, 0); } while (0)
#define PG8_LDA(dst, b, h) do { _Pragma("unroll") for (int m = 0; m < 4; ++m) _Pragma("unroll") for (int k = 0; k < 2; ++k) dst[m][k] = *(const LAS bf16x8*)(lds + PG8_SA(b, h) + aoff + m * 2048 + k * 1024); } while (0)
#define PG8_LDB(dst, b, h) do { _Pragma("unroll") for (int n = 0; n < 2; ++n) _Pragma("unroll") for (int k = 0; k < 2; ++k) dst[n][k] = *(const LAS bf16x8*)(lds + PG8_SB(b, h) + boff + n * 2048 + k * 1024); } while (0)
#define PG8_MMA(ai, bj, At, Bt) do { __builtin_amdgcn_s_setprio(1); _Pragma("unroll") for (int m = 0; m < 4; ++m) _Pragma("unroll") for (int n = 0; n < 2; ++n) _Pragma("unroll") for (int k = 0; k < 2; ++k) \
        acc[ai][bj][m][n] = __builtin_amdgcn_mfma_f32_16x16x32_bf16(Bt[n][k], At[m][k], acc[ai][bj][m][n], 0, 0, 0); __builtin_amdgcn_s_setprio(0); } while (0)
#define PG8_WAIT_V(n) asm volatile("s_waitcnt vmcnt(" #n ")" ::: "memory")
#define PG8_WAIT_L(n) asm volatile("s_waitcnt lgkmcnt(" #n ")" ::: "memory")
#define PG8_BAR __builtin_amdgcn_s_barrier()
#define PG8_SCHED __builtin_amdgcn_sched_barrier(0)
    Unit cur, nxt; int ui = 0;
    if (!S.next(0, cur)) return;
    f32x4 acc[2][2][4][2];
#pragma unroll
    for (int a = 0; a < 2; ++a)
#pragma unroll
        for (int b = 0; b < 2; ++b)
#pragma unroll
            for (int m = 0; m < 4; ++m)
#pragma unroll
                for (int n = 0; n < 2; ++n) acc[a][b][m][n] = (f32x4){0.f, 0.f, 0.f, 0.f};
    bf16x8 At[4][2], B0[2][2], B1[2][2];
    const char* cA = (const char*)g.A + (size_t)cur.pm * tstep; const char* cB = (const char*)g.Bt + (size_t)cur.pn * tstep;
    PG8_STAGE(PG8_SB(0, 0), cB, voffB); PG8_STAGE(PG8_SA(0, 0), cA, voffA); PG8_STAGE(PG8_SB(0, 1), cB + hstep, voffB); PG8_STAGE(PG8_SA(0, 1), cA + hstep, voffA);
    if (wr == 1) PG8_BAR;
    PG8_WAIT_V(4); PG8_BAR;
    PG8_STAGE(PG8_SB(1, 0), cB + kstep, voffB); PG8_STAGE(PG8_SA(1, 0), cA + kstep, voffA); PG8_STAGE(PG8_SB(1, 1), cB + hstep + kstep, voffB);
    PG8_WAIT_V(6); PG8_BAR;
    for (;;) {
        const bool has_next = S.next(ui + 1, nxt);
        const char* nA = has_next ? (const char*)g.A + (size_t)nxt.pm * tstep : cA; const char* nB = has_next ? (const char*)g.Bt + (size_t)nxt.pn * tstep : cB;
        for (int t = 0; t < nt; t += 2) {
            const bool last = (t == nt - 2);
            const char* a1 = cA + (size_t)(t + 1) * kstep;
            const char* a2 = last ? nA : cA + (size_t)(t + 2) * kstep; const char* b2 = last ? nB : cB + (size_t)(t + 2) * kstep;
            const char* a3 = a2 + kstep; const char* b3 = b2 + kstep;
            PG8_LDB(B0, 0, 0); PG8_SCHED; PG8_LDA(At, 0, 0); PG8_STAGE(PG8_SA(1, 1), a1 + hstep, voffA);
            PG8_WAIT_L(8); PG8_BAR; PG8_WAIT_L(0); PG8_MMA(0, 0, At, B0); PG8_BAR; PG8_SCHED;
            PG8_LDB(B1, 0, 1); PG8_STAGE(PG8_SB(0, 0), b2, voffB);
            PG8_BAR; PG8_WAIT_L(0); PG8_MMA(0, 1, At, B1); PG8_BAR;
            PG8_LDA(At, 0, 1); PG8_STAGE(PG8_SA(0, 0), a2, voffA);
            PG8_BAR; PG8_WAIT_L(0); PG8_MMA(1, 0, At, B0); PG8_BAR; PG8_SCHED;
            PG8_STAGE(PG8_SB(0, 1), b2 + hstep, voffB);
            PG8_WAIT_V(6); PG8_BAR; PG8_MMA(1, 1, At, B1); PG8_BAR;
            PG8_LDB(B0, 1, 0); PG8_SCHED; PG8_LDA(At, 1, 0); PG8_STAGE(PG8_SA(0, 1), a2 + hstep, voffA);
            PG8_WAIT_L(8); PG8_BAR; PG8_WAIT_L(0); PG8_MMA(0, 0, At, B0); PG8_BAR; PG8_SCHED;
            PG8_LDB(B1, 1, 1); PG8_STAGE(PG8_SB(1, 0), b3, voffB);
            PG8_BAR; PG8_WAIT_L(0); PG8_MMA(0, 1, At, B1); PG8_BAR;
            PG8_LDA(At, 1, 1); PG8_STAGE(PG8_SA(1, 0), a3, voffA);
            PG8_BAR; PG8_WAIT_L(0); PG8_MMA(1, 0, At, B0); PG8_BAR; PG8_SCHED;
            PG8_STAGE(PG8_SB(1, 1), b3 + hstep, voffB);
            PG8_WAIT_V(6); PG8_BAR; PG8_MMA(1, 1, At, B1); PG8_BAR;
        }
        E(acc, cur, wr, wc, fr, fq);
        if (!has_next) break;
#pragma unroll
        for (int a = 0; a < 2; ++a)
#pragma unroll
            for (int b = 0; b < 2; ++b)
#pragma unroll
                for (int m = 0; m < 4; ++m)
#pragma unroll
                    for (int n = 0; n < 2; ++n) acc[a][b][m][n] = (f32x4){0.f, 0.f, 0.f, 0.f};
        cur = nxt; cA = nA; cB = nB; ++ui;
    }
    PG8_WAIT_V(0);
    if (wr == 0) PG8_BAR;
    PG8_BAR;
#undef PG8_SA
#undef PG8_SB
#undef PG8_STAGE
#undef PG8_LDA
#undef PG8_LDB
#undef PG8_MMA
#undef PG8_WAIT_V
#undef PG8_WAIT_L
#undef PG8_BAR
#undef PG8_SCHED
}
}

struct GemmJob { const bf16_t* A; const bf16_t* Bt; int M, N, K; pg8::EpiGen E; };
__device__ __forceinline__ void run_gemm(LAS unsigned char* lds, const GemmJob& j) {
    pg8::Gemm g{j.A, j.Bt, j.M, j.N, j.K};
    pg8::StaticOrder S; S.init(j.M, j.N, (int)gridDim.x, (int)blockIdx.x);
    pg8::gemm_phase<pg8::EpiGen, pg8::StaticOrder>(lds, g, S, j.E);
    __syncthreads();
}

__device__ __forceinline__ void conv_job(LAS unsigned char* lds, const float* __restrict__ src, int ldn, int col0, int ncols, int npad, int K, bf16_t* __restrict__ dst) {
    constexpr int LR = 132;
    LAS float* T = (LAS float*)lds;
    const int tid = opq(threadIdx.x), n4 = tid & 31, kr = tid >> 5;
    const int rn = tid & 127, rk = tid >> 7;
    const int ntn = npad / 128, ntk = K / 128, ntiles = ntn * ntk;
    f32x4 r[8];
    int t = blockIdx.x;
#define CONV_LOAD(tt_) do { const int tn_ = (tt_) % ntn, tk_ = (tt_) / ntn; const int n_ = tn_ * 128 + n4 * 4; const bool ok_ = n_ < ncols; \
        const float* p_ = src + (size_t)(tk_ * 128 + kr) * ldn + col0 + (ok_ ? n_ : 0); \
        _Pragma("unroll") for (int j_ = 0; j_ < 8; ++j_) { r[j_] = __builtin_nontemporal_load((const f32x4*)(p_ + (size_t)(16 * j_) * ldn)); if (!ok_) r[j_] = (f32x4){0.f, 0.f, 0.f, 0.f}; } } while (0)
    if (t < ntiles) CONV_LOAD(t);
    for (; t < ntiles; t += gridDim.x) {
        const int tn = t % ntn, tk = t / ntn;
#pragma unroll
        for (int j = 0; j < 8; ++j) *(LAS f32x4*)(T + (kr + 16 * j) * LR + n4 * 4) = r[j];
        if (t + (int)gridDim.x < ntiles) CONV_LOAD(t + (int)gridDim.x);
        __syncthreads();
#pragma unroll
        for (int j = 0; j < 4; ++j) { const int kc = rk + 4 * j; float v[8];
#pragma unroll
            for (int i = 0; i < 8; ++i) v[i] = T[(kc * 8 + i) * LR + rn];
            u32x4 w; w.x = cvtpk(v[0], v[1]); w.y = cvtpk(v[2], v[3]); w.z = cvtpk(v[4], v[5]); w.w = cvtpk(v[6], v[7]);
            *(u32x4*)(dst + (size_t)(tn * 128 + rn) * K + tk * 128 + kc * 8) = w; }
        __syncthreads();
    }
}

__device__ __forceinline__ void rmsnorm_phase(const float* __restrict__ x, const float* __restrict__ g, bf16_t* __restrict__ h) {
    const int tid = opq(threadIdx.x), lane = tid & 63, gw = blockIdx.x * 8 + (tid >> 6), nw = gridDim.x * 8;
    for (int row = gw; row < NTOK; row += nw) {
        const float* xr = x + (size_t)row * DM; f32x4 v[8]; float ss = 0.f;
#pragma unroll
        for (int j = 0; j < 8; ++j) { v[j] = *(const f32x4*)(xr + j * 256 + lane * 4); ss += v[j][0] * v[j][0] + v[j][1] * v[j][1] + v[j][2] * v[j][2] + v[j][3] * v[j][3]; }
        ss = wave_sum(ss); const float rs = rsqrtf(ss * (1.f / DM) + EPS);
#pragma unroll
        for (int j = 0; j < 8; ++j) { const f32x4 gv = *(const f32x4*)(g + j * 256 + lane * 4);
            u32x2 w; w.x = cvtpk(v[j][0] * rs * gv[0], v[j][1] * rs * gv[1]); w.y = cvtpk(v[j][2] * rs * gv[2], v[j][3] * rs * gv[3]);
            *(u32x2*)(h + (size_t)row * DM + j * 256 + lane * 4) = w; }
    }
}

__device__ __forceinline__ void fgate_phase(const bf16_t* __restrict__ h, const bf16_t* __restrict__ wft, const float* __restrict__ bfv, float* __restrict__ logf) {
    const int tid = opq(threadIdx.x), lane = tid & 63, gw = blockIdx.x * 8 + (tid >> 6), nw = gridDim.x * 8;
    const int fr = lane & 15, fq = lane >> 4;
    if ((gw & 3) != 0) return;
    for (int job = gw >> 2; job < NTOK / 16; job += (nw >> 2)) {
        const bf16_t* ap = h + (size_t)(job * 16 + fr) * DM + fq * 8; const bf16_t* bp = wft + (size_t)fr * DM + fq * 8;
        f32x4 acc = {0.f, 0.f, 0.f, 0.f};
#pragma unroll 8
        for (int k = 0; k < DM; k += 32) { const bf16x8 a = *(const bf16x8*)(ap + k), b = *(const bf16x8*)(bp + k); acc = __builtin_amdgcn_mfma_f32_16x16x32_bf16(a, b, acc, 0, 0, 0); }
        const float bb = bfv[fr];
#pragma unroll
        for (int j = 0; j < 4; ++j) { const float u = acc[j] + bb; logf[(size_t)(job * 16 + fq * 4 + j) * 16 + fr] = -(fmaxf(-u, 0.f) + log1pf(__expf(-fabsf(u)))); }
    }
}

__device__ __forceinline__ void fox_prep_phase(bf16_t* __restrict__ qk  , const float* __restrict__ qg, const float* __restrict__ kg, const float* __restrict__ logf, float* __restrict__ cf) {
    const int tid = opq(threadIdx.x), lane = tid & 63, gw = blockIdx.x * 8 + (tid >> 6), nw = gridDim.x * 8;
    const int sub = lane >> 4, l16 = lane & 15;
    const int nrows = 2 * NTOK * NH;
    for (int r0 = gw * 4; r0 < nrows; r0 += nw * 4) {
        const int row = r0 + sub; const bool isk = row >= NTOK * NH;
        bf16_t* p = qk + (size_t)row * HD + l16 * 8;
        const u32x4 w = *(const u32x4*)p; float v[8] = {bflo(w.x), bfhi(w.x), bflo(w.y), bfhi(w.y), bflo(w.z), bfhi(w.z), bflo(w.w), bfhi(w.w)};
        float ss = 0.f;
#pragma unroll
        for (int i = 0; i < 8; ++i) ss += v[i] * v[i];
        ss = sum16(ss); const float rs = rsqrtf(ss * (1.f / HD) + EPS);
        const float* gp = (isk ? kg : qg) + l16 * 8; const f32x4 g0 = *(const f32x4*)gp, g1 = *(const f32x4*)(gp + 4);
        u32x4 o; o.x = cvtpk(v[0] * rs * g0[0], v[1] * rs * g0[1]); o.y = cvtpk(v[2] * rs * g0[2], v[3] * rs * g0[3]);
        o.z = cvtpk(v[4] * rs * g1[0], v[5] * rs * g1[1]); o.w = cvtpk(v[6] * rs * g1[2], v[7] * rs * g1[3]);
        *(u32x4*)p = o;
    }
    for (int bh = blockIdx.x; bh < 64; bh += gridDim.x) {
        if ((threadIdx.x >> 6) != 0) continue;
        const int b = bh >> 4, hd = bh & 15; const float* lp = logf + (size_t)(b * SEQ + lane * 32) * 16 + hd;
        float v[32]; float tot = 0.f;
#pragma unroll
        for (int i = 0; i < 32; ++i) { tot += lp[(size_t)i * 16]; v[i] = tot; }
        float inc = tot;
#pragma unroll
        for (int o = 1; o < 64; o <<= 1) { const float up = __shfl_up(inc, o); if (lane >= o) inc += up; }
        const float base = inc - tot;
        float* cp = cf + (size_t)bh * SEQ + lane * 32;
#pragma unroll
        for (int i = 0; i < 32; ++i) cp[i] = base + v[i];
    }
}

__device__ __forceinline__ void mla_prep1_phase(const bf16_t* __restrict__ down, const int* __restrict__ pos, const float* __restrict__ qn, const float* __restrict__ kvn,
                                                bf16_t* __restrict__ cq, bf16_t* __restrict__ ckv, float* __restrict__ ropet, float* __restrict__ kr) {
    const int tid = opq(threadIdx.x), lane = tid & 63, gw = blockIdx.x * 8 + (tid >> 6), nw = gridDim.x * 8;
    for (int row = gw; row < NTOK; row += nw) {
        const bf16_t* dr = down + (size_t)row * MLA_DOWN_PAD;
        {   float v[12]; float ss = 0.f;
#pragma unroll
            for (int j = 0; j < 3; ++j) { const u32x2 w = *(const u32x2*)(dr + j * 256 + lane * 4); v[4 * j] = bflo(w.x); v[4 * j + 1] = bfhi(w.x); v[4 * j + 2] = bflo(w.y); v[4 * j + 3] = bfhi(w.y); }
#pragma unroll
            for (int i = 0; i < 12; ++i) ss += v[i] * v[i];
            ss = wave_sum(ss); const float rs = rsqrtf(ss * (1.f / MLA_QR) + EPS);
#pragma unroll
            for (int j = 0; j < 3; ++j) { const f32x4 g = *(const f32x4*)(qn + j * 256 + lane * 4);
                u32x2 w; w.x = cvtpk(v[4 * j] * rs * g[0], v[4 * j + 1] * rs * g[1]); w.y = cvtpk(v[4 * j + 2] * rs * g[2], v[4 * j + 3] * rs * g[3]);
                *(u32x2*)(cq + (size_t)row * MLA_QR + j * 256 + lane * 4) = w; } }
        {   float v[8]; float ss = 0.f;
#pragma unroll
            for (int j = 0; j < 2; ++j) { const u32x2 w = *(const u32x2*)(dr + MLA_QR + j * 256 + lane * 4); v[4 * j] = bflo(w.x); v[4 * j + 1] = bfhi(w.x); v[4 * j + 2] = bflo(w.y); v[4 * j + 3] = bfhi(w.y); }
#pragma unroll
            for (int i = 0; i < 8; ++i) ss += v[i] * v[i];
            ss = wave_sum(ss); const float rs = rsqrtf(ss * (1.f / MLA_KVR) + EPS);
#pragma unroll
            for (int j = 0; j < 2; ++j) { const f32x4 g = *(const f32x4*)(kvn + j * 256 + lane * 4);
                u32x2 w; w.x = cvtpk(v[4 * j] * rs * g[0], v[4 * j + 1] * rs * g[1]); w.y = cvtpk(v[4 * j + 2] * rs * g[2], v[4 * j + 3] * rs * g[3]);
                *(u32x2*)(ckv + (size_t)row * MLA_KVR + j * 256 + lane * 4) = w; } }
        if (lane < 32) {
            const float invf = powf(10000.0f, -(float)(2 * lane) / 64.0f);
            const float ang = (float)pos[row] * invf; const float cs = cosf(ang), sn = sinf(ang);
            ropet[(size_t)row * 64 + lane] = cs; ropet[(size_t)row * 64 + 32 + lane] = sn;
            const float x1 = __uint_as_float((unsigned)dr[MLA_QR + MLA_KVR + lane] << 16), x2 = __uint_as_float((unsigned)dr[MLA_QR + MLA_KVR + 32 + lane] << 16);
            kr[(size_t)row * 64 + lane] = x1 * cs - x2 * sn; kr[(size_t)row * 64 + 32 + lane] = x1 * sn + x2 * cs;
        }
    }
}

__device__ __forceinline__ void mla_prep2_phase(const bf16_t* __restrict__ qup, const bf16_t* __restrict__ kv, const float* __restrict__ ropet, const float* __restrict__ kr,
                                                const float* __restrict__ qg, const float* __restrict__ kg, bf16_t* __restrict__ Qn, bf16_t* __restrict__ Kn) {
    const int tid = opq(threadIdx.x), lane = tid & 63, gw = blockIdx.x * 8 + (tid >> 6), nw = gridDim.x * 8;
    const int sub = lane >> 4, j = lane & 15;
    const int nrows = 2 * NTOK * NH;
    for (int r0 = gw * 4; r0 < nrows; r0 += nw * 4) {
        int row = r0 + sub; const bool isk = row >= NTOK * NH; if (isk) row -= NTOK * NH;
        const int tok = row >> 4, hd = row & 15;
        float v[8], ra[2], rb[2];
        if (!isk) {
            const bf16_t* p = qup + (size_t)tok * 3072 + hd * 192;
            const u32x4 w = *(const u32x4*)(p + j * 8);
            v[0] = bflo(w.x); v[1] = bfhi(w.x); v[2] = bflo(w.y); v[3] = bfhi(w.y); v[4] = bflo(w.z); v[5] = bfhi(w.z); v[6] = bflo(w.w); v[7] = bfhi(w.w);
            const unsigned w1 = *(const unsigned*)(p + 128 + 2 * j), w2 = *(const unsigned*)(p + 160 + 2 * j);
            const float x1a = bflo(w1), x1b = bfhi(w1), x2a = bflo(w2), x2b = bfhi(w2);
            const float* rt = ropet + (size_t)tok * 64; const float c0 = rt[2 * j], c1 = rt[2 * j + 1], s0 = rt[32 + 2 * j], s1 = rt[32 + 2 * j + 1];
            ra[0] = x1a * c0 - x2a * s0; ra[1] = x1b * c1 - x2b * s1; rb[0] = x1a * s0 + x2a * c0; rb[1] = x1b * s1 + x2b * c1;
        } else {
            const bf16_t* p = kv + (size_t)tok * 4096 + hd * 256;
            const u32x4 w = *(const u32x4*)(p + j * 8);
            v[0] = bflo(w.x); v[1] = bfhi(w.x); v[2] = bflo(w.y); v[3] = bfhi(w.y); v[4] = bflo(w.z); v[5] = bfhi(w.z); v[6] = bflo(w.w); v[7] = bfhi(w.w);
            const float* kp = kr + (size_t)tok * 64; ra[0] = kp[2 * j]; ra[1] = kp[2 * j + 1]; rb[0] = kp[32 + 2 * j]; rb[1] = kp[32 + 2 * j + 1];
        }
        float ss = ra[0] * ra[0] + ra[1] * ra[1] + rb[0] * rb[0] + rb[1] * rb[1];
#pragma unroll
        for (int i = 0; i < 8; ++i) ss += v[i] * v[i];
        ss = sum16(ss); const float rs = rsqrtf(ss * (1.f / MLA_QK) + EPS);
        const float* g = isk ? kg : qg; const f32x4 g0 = *(const f32x4*)(g + j * 8), g1 = *(const f32x4*)(g + j * 8 + 4);
        bf16_t* o = (isk ? Kn : Qn) + (size_t)tok * 3072 + hd * 192;
        u32x4 ow; ow.x = cvtpk(v[0] * rs * g0[0], v[1] * rs * g0[1]); ow.y = cvtpk(v[2] * rs * g0[2], v[3] * rs * g0[3]);
        ow.z = cvtpk(v[4] * rs * g1[0], v[5] * rs * g1[1]); ow.w = cvtpk(v[6] * rs * g1[2], v[7] * rs * g1[3]);
        *(u32x4*)(o + j * 8) = ow;
        *(unsigned*)(o + 128 + 2 * j) = cvtpk(ra[0] * rs * g[128 + 2 * j], ra[1] * rs * g[128 + 2 * j + 1]);
        *(unsigned*)(o + 160 + 2 * j) = cvtpk(rb[0] * rs * g[160 + 2 * j], rb[1] * rs * g[160 + 2 * j + 1]);
    }
}

__device__ __forceinline__ int v_st(int k, int c) { const int kk = (k & ~0xC) | ((k & 4) << 1) | ((k & 8) >> 1); return ((kk >> 3) * 4 + (c >> 5)) * 512 + ((kk & 7) * 32 + (c & 31)) * 2; }
__device__ __forceinline__ int v_rd_base(int lane) { return ((lane & 3) << 3) | (((lane >> 2) & 3) << 6) | (((lane >> 4) & 1) << 5) | (((lane >> 5) & 1) << 8); }
constexpr int v_rd_off(int d0, int ks, int half) { return d0 * 512 + ks * 4096 + half * 2048; }
__device__ __forceinline__ int crow(int r, int hi) { return (r & 3) + 8 * (r >> 2) + 4 * hi; }

constexpr int AT_SHM_V = 16384, AT_KBUF = 24576;
constexpr int AT_OFF_K = 2 * AT_SHM_V, AT_OFF_WS = AT_OFF_K + 2 * AT_KBUF, AT_OFF_CF = AT_OFF_WS + 2048;

#ifdef TESTB
#define SB_LG(y) fmaxf(1.f - 0.5f * fabsf(y), 0.f)
#else
#define SB_LG(y) __builtin_amdgcn_logf(1.f + __builtin_amdgcn_exp2f(-fabsf(y)))
#endif
#ifndef SB_BLOCK_EXIT
#define SB_BLOCK_EXIT 0
#endif
template <int DQK, int MODE>
__device__ __forceinline__ void attn_block(const bf16_t* __restrict__ Qg, int ldq, const bf16_t* __restrict__ Kg, int ldk, const bf16_t* __restrict__ Vg, int ldv,
                                           bf16_t* __restrict__ Og, int ldo, int q0, float C2, LAS unsigned char* lds) {
    constexpr int NQ = DQK / 16, ROWB = DQK * 2, SHM_K = 64 * ROWB, NCH = DQK / 8, KCH = NCH / 8;
    const int tid = opq(threadIdx.x), wid = __builtin_amdgcn_readfirstlane(tid >> 6), lane = tid & 63, r32 = lane & 31, hi = lane >> 5;
    LAS unsigned char* V_lds = lds; LAS unsigned char* K_lds = lds + AT_OFF_K;
    LAS float* li_l = (LAS float*)(lds + AT_OFF_WS) + wid * 64; LAS float* al_l = li_l + 32;
    const LAS float* cfl = (const LAS float*)(lds + AT_OFF_CF);
    const int qlo = q0 + wid * 32, trow = qlo + r32;
    bf16x8 qr[NQ];
#pragma unroll
    for (int d0 = 0; d0 < NQ; ++d0) qr[d0] = *(const bf16x8*)(Qg + (size_t)trow * ldq + d0 * 16 + hi * 8);
    const int NT = q0 / 64 + 4;
    int kso[KCH], vso[2];
#pragma unroll
    for (int i = 0; i < KCH; ++i) { const int L = (i * 8 + wid) * 1024 + lane * 16, row = L / ROWB, wi = L % ROWB; kso[i] = row * ldk + ((wi ^ ((row & 7) << 4)) >> 1); }
#pragma unroll
    for (int i = 0; i < 2; ++i) { const int L = (i * 8 + wid) * 1024 + lane * 16, sub = L >> 9, we = (L & 511) >> 1, kk = (sub >> 2) * 8 + (we >> 5), c = (sub & 3) * 32 + (we & 31);
        const int k = (kk & ~0xC) | ((kk & 4) << 1) | ((kk & 8) >> 1); vso[i] = k * ldv + c; }
#define AT_DMA(kb_, buf_) do { const bf16_t* kp_ = Kg + (size_t)(kb_) * ldk; const bf16_t* vp_ = Vg + (size_t)(kb_) * ldv; \
        _Pragma("unroll") for (int i_ = 0; i_ < KCH; ++i_) __builtin_amdgcn_global_load_lds((const unsigned*)(kp_ + kso[i_]), (LAS unsigned*)(K_lds + (buf_) * SHM_K + (i_ * 8 + wid) * 1024), 16, 0, 0); \
        _Pragma("unroll") for (int i_ = 0; i_ < 2; ++i_) __builtin_amdgcn_global_load_lds((const unsigned*)(vp_ + vso[i_]), (LAS unsigned*)(V_lds + (buf_) * AT_SHM_V + (i_ * 8 + wid) * 1024), 16, 0, 0); } while (0)
#if ATT_DMA
    AT_DMA((NT - 1) * 64, 0);
    asm volatile("s_waitcnt vmcnt(0)" ::: "memory");
    __syncthreads();
#else
    bf16x8 stk[KCH], stv[2];
    const int vk = tid >> 4, vc = (tid & 15) * 8;
#define AT_LOAD(kb_) do { _Pragma("unroll") for (int i_ = 0; i_ < KCH; ++i_) { const int c_ = tid + 512 * i_, row_ = c_ / NCH, cc_ = c_ % NCH; stk[i_] = *(const bf16x8*)(Kg + (size_t)((kb_) + row_) * ldk + cc_ * 8); } \
        _Pragma("unroll") for (int i_ = 0; i_ < 2; ++i_) stv[i_] = *(const bf16x8*)(Vg + (size_t)((kb_) + vk + 32 * i_) * ldv + vc); } while (0)
#define AT_WRITE(buf_) do { _Pragma("unroll") for (int i_ = 0; i_ < KCH; ++i_) { const int c_ = tid + 512 * i_, row_ = c_ / NCH, cc_ = c_ % NCH; \
            *(LAS bf16x8*)(K_lds + (buf_) * SHM_K + row_ * ROWB + ((cc_ * 16) ^ ((row_ & 7) << 4))) = stk[i_]; } \
        _Pragma("unroll") for (int i_ = 0; i_ < 2; ++i_) *(LAS bf16x8*)(V_lds + (buf_) * AT_SHM_V + v_st(vk + 32 * i_, vc)) = stv[i_]; } while (0)
    AT_LOAD((NT - 1) * 64); AT_WRITE(0);
    if (NT > 1) AT_LOAD((NT - 2) * 64);
    __syncthreads();
#endif
    f32x16 o[4];
#pragma unroll
    for (int d = 0; d < 4; ++d)
#pragma unroll
        for (int r = 0; r < 16; ++r) o[d][r] = 0.f;
    float m_reg = -1e30f, l_reg = 0.f, carry = (MODE == 0) ? 1.f : 0.f;
    float cft = 0.f; if (MODE == 1) cft = cfl[trow];
    int koff[4];
#pragma unroll
    for (int dd = 0; dd < 4; ++dd) koff[dd] = r32 * ROWB + ((dd * 32 + hi * 16) ^ ((r32 & 7) << 4));
    const int vbase = (int)(uintptr_t)V_lds + v_rd_base(lane);
    bool wdone = false;
    LAS unsigned* dflag = (LAS unsigned*)(lds + AT_OFF_CF);
    for (int it = 0; it < NT; ++it) {
        const int kb = (NT - 1 - it) * 64, cur = it & 1;
        bool alld = false;
        if (MODE == 0 && it > 0) {
            const LAS unsigned* fp = dflag + ((it - 1) & 1) * 8; const u32x4 f0 = *(const LAS u32x4*)fp, f1 = *(const LAS u32x4*)(fp + 4);
            alld = __builtin_amdgcn_readfirstlane(f0.x & f0.y & f0.z & f0.w & f1.x & f1.y & f1.z & f1.w) != 0u;
        }
        const bool act = (kb <= qlo + 31) && !wdone;
#if ATT_DMA
        if (it + 1 < NT && !alld) AT_DMA(kb - 64, cur ^ 1);
#endif
        if (act) {
            f32x16 p0, p1;
#pragma unroll
            for (int r = 0; r < 16; ++r) { p0[r] = 0.f; p1[r] = 0.f; }
            const LAS unsigned char* kbase = K_lds + cur * SHM_K;
#pragma unroll
            for (int dg = 0; dg < NQ / 4; ++dg) {
                bf16x8 kf0[4], kf1[4];
#pragma unroll
                for (int dd = 0; dd < 4; ++dd) { const LAS unsigned char* a = kbase + koff[dd] + dg * 128; kf0[dd] = *(const LAS bf16x8*)a; kf1[dd] = *(const LAS bf16x8*)(a + 32 * ROWB); }
#pragma unroll
                for (int dd = 0; dd < 4; ++dd) { p0 = __builtin_amdgcn_mfma_f32_32x32x16_bf16(kf0[dd], qr[dg * 4 + dd], p0, 0, 0, 0); p1 = __builtin_amdgcn_mfma_f32_32x32x16_bf16(kf1[dd], qr[dg * 4 + dd], p1, 0, 0, 0); }
                __builtin_amdgcn_sched_barrier(0);
            }
            const int dq = trow - kb - 4 * hi;
            if (MODE == 0) {
                const bool needm = kb + 63 >= qlo;
                f32x16 kA, kB;
#pragma unroll
                for (int r = 0; r < 16; ++r) { p0[r] = fminf(p0[r] * C2, 80.f); p1[r] = fminf(p1[r] * C2, 80.f); }
#pragma unroll
                for (int r = 0; r < 16; ++r) { p0[r] = __builtin_amdgcn_exp2f(p0[r]); p1[r] = __builtin_amdgcn_exp2f(p1[r]); }
                __builtin_amdgcn_sched_barrier(0);
#pragma unroll
                for (int r = 0; r < 16; ++r) { kA[r] = 1.f + p0[r]; kB[r] = 1.f + p1[r]; }
                __builtin_amdgcn_sched_barrier(0);
#pragma unroll
                for (int r = 0; r < 16; ++r) { kA[r] = __builtin_amdgcn_rcpf(kA[r]); kB[r] = __builtin_amdgcn_rcpf(kB[r]); }
                __builtin_amdgcn_sched_barrier(0);
#pragma unroll
                for (int r = 0; r < 16; ++r) { p0[r] *= kA[r]; p1[r] *= kB[r]; }
                if (needm) {
#pragma unroll
                    for (int r = 0; r < 16; ++r) { const int c = (r & 3) + 8 * (r >> 2);
                        if (!(c < dq)) { kA[r] = 1.f; p0[r] = 0.f; } if (!(c + 32 < dq)) { kB[r] = 1.f; p1[r] = 0.f; } }
                }
                __builtin_amdgcn_sched_barrier(0);
                float run = carry;
#pragma unroll
                for (int g = 7; g >= 0; --g) {
                    const float gp = (g < 4) ? (kA[4 * g] * kA[4 * g + 1]) * (kA[4 * g + 2] * kA[4 * g + 3]) : (kB[4 * (g - 4)] * kB[4 * (g - 4) + 1]) * (kB[4 * (g - 4) + 2] * kB[4 * (g - 4) + 3]);
                    auto rr = __builtin_amdgcn_permlane32_swap(__float_as_uint(gp), __float_as_uint(gp), false, false);
                    const float e = __uint_as_float(rr[0]), od = __uint_as_float(rr[1]);
                    const float base = hi ? run : run * od;
                    if (g < 4) { const int b = 4 * g; const float l3 = base, l2 = l3 * kA[b + 3], l1 = l2 * kA[b + 2], l0 = l1 * kA[b + 1];
                        p0[b] *= l0; p0[b + 1] *= l1; p0[b + 2] *= l2; p0[b + 3] *= l3; }
                    else { const int b = 4 * (g - 4); const float l3 = base, l2 = l3 * kB[b + 3], l1 = l2 * kB[b + 2], l0 = l1 * kB[b + 1];
                        p1[b] *= l0; p1[b + 1] *= l1; p1[b + 2] *= l2; p1[b + 3] *= l3; }
                    run *= e * od;
                }
                carry = run;
                __builtin_amdgcn_sched_barrier(0);
            } else {
                if (MODE == 1) {
#pragma unroll
                    for (int g = 0; g < 4; ++g) { const f32x4 c0 = *(const LAS f32x4*)(cfl + kb + 8 * g + 4 * hi), c1 = *(const LAS f32x4*)(cfl + kb + 32 + 8 * g + 4 * hi);
#pragma unroll
                        for (int i = 0; i < 4; ++i) { p0[4 * g + i] = fmaf(p0[4 * g + i], C2, cft - c0[i]); p1[4 * g + i] = fmaf(p1[4 * g + i], C2, cft - c1[i]); } }
                } else {
#pragma unroll
                    for (int r = 0; r < 16; ++r) { p0[r] *= C2; p1[r] *= C2; }
                }
                if (kb + 63 > qlo) {
#pragma unroll
                    for (int r = 0; r < 16; ++r) { const int c = (r & 3) + 8 * (r >> 2); if (!(c <= dq)) p0[r] = -__builtin_inff(); if (!(c + 32 <= dq)) p1[r] = -__builtin_inff(); }
                }
                float pmax = p0[0];
#pragma unroll
                for (int r = 1; r < 16; ++r) pmax = fmaxf(pmax, p0[r]);
#pragma unroll
                for (int r = 0; r < 16; ++r) pmax = fmaxf(pmax, p1[r]);
                { auto rr = __builtin_amdgcn_permlane32_swap(__float_as_uint(pmax), __float_as_uint(pmax), false, false); pmax = fmaxf(__uint_as_float(rr[0]), __uint_as_float(rr[1])); }
                const float mn = fmaxf(m_reg, pmax); const float alpha = __builtin_amdgcn_exp2f(m_reg - mn); m_reg = mn;
                float ps = 0.f;
#pragma unroll
                for (int r = 0; r < 16; ++r) { p0[r] = __builtin_amdgcn_exp2f(p0[r] - mn); p1[r] = __builtin_amdgcn_exp2f(p1[r] - mn); ps += p0[r] + p1[r]; }
                { auto rr = __builtin_amdgcn_permlane32_swap(__float_as_uint(ps), __float_as_uint(ps), false, false); ps = __uint_as_float(rr[0]) + __uint_as_float(rr[1]); }
                l_reg = l_reg * alpha + ps;
                if (__any(alpha < 1.f)) {
                    if (hi == 0) al_l[r32] = alpha;
                    asm volatile("s_waitcnt lgkmcnt(0)" ::: "memory");
#pragma unroll
                    for (int g = 0; g < 4; ++g) { const f32x4 av = *(const LAS f32x4*)(al_l + 8 * g + 4 * hi);
#pragma unroll
                        for (int d = 0; d < 4; ++d)
#pragma unroll
                            for (int i = 0; i < 4; ++i) o[d][4 * g + i] *= av[i]; }
                }
            }
            bf16x8 pa0, pa1, pa2, pa3;
#define PK4(P, B_, OUT) do { unsigned a0 = cvtpk(P[B_+0], P[B_+1]), a1 = cvtpk(P[B_+2], P[B_+3]); unsigned b0 = cvtpk(P[B_+4], P[B_+5]), b1 = cvtpk(P[B_+6], P[B_+7]); \
        auto r0 = __builtin_amdgcn_permlane32_swap(a0, b0, false, false); auto r1 = __builtin_amdgcn_permlane32_swap(a1, b1, false, false); \
        u32x4 w = {r0[0], r1[0], r0[1], r1[1]}; OUT = *reinterpret_cast<bf16x8*>(&w); } while (0)
            PK4(p0, 0, pa0); PK4(p0, 8, pa1); PK4(p1, 0, pa2); PK4(p1, 8, pa3);
#undef PK4
            const int vb0 = vbase + cur * AT_SHM_V;
#define TRRD(dst, off) asm volatile("ds_read_b64_tr_b16 %0, %1 offset:%2" : "=&v"(dst) : "v"(vb0), "i"(off) : "memory")
#define PV_D0(d0) do { s16x4 l0, l1, l2, l3, h0, h1, h2, h3; constexpr int b_ = v_rd_off(d0, 0, 0); \
        TRRD(l0, b_); TRRD(h0, b_ + 2048); TRRD(l1, b_ + 4096); TRRD(h1, b_ + 6144); TRRD(l2, b_ + 8192); TRRD(h2, b_ + 10240); TRRD(l3, b_ + 12288); TRRD(h3, b_ + 14336); \
        asm volatile("s_waitcnt lgkmcnt(0)" ::: "memory"); __builtin_amdgcn_sched_barrier(0); \
        o[d0] = __builtin_amdgcn_mfma_f32_32x32x16_bf16(pa0, (bf16x8){l0[0], l0[1], l0[2], l0[3], h0[0], h0[1], h0[2], h0[3]}, o[d0], 0, 0, 0); \
        o[d0] = __builtin_amdgcn_mfma_f32_32x32x16_bf16(pa1, (bf16x8){l1[0], l1[1], l1[2], l1[3], h1[0], h1[1], h1[2], h1[3]}, o[d0], 0, 0, 0); \
        o[d0] = __builtin_amdgcn_mfma_f32_32x32x16_bf16(pa2, (bf16x8){l2[0], l2[1], l2[2], l2[3], h2[0], h2[1], h2[2], h2[3]}, o[d0], 0, 0, 0); \
        o[d0] = __builtin_amdgcn_mfma_f32_32x32x16_bf16(pa3, (bf16x8){l3[0], l3[1], l3[2], l3[3], h3[0], h3[1], h3[2], h3[3]}, o[d0], 0, 0, 0); } while (0)
            PV_D0(0); PV_D0(1); PV_D0(2); PV_D0(3);
#undef PV_D0
#undef TRRD
        }
        if (MODE == 0) { if (kb <= qlo + 31) wdone = __all(carry < 1e-37f) != 0; if (lane == 0) dflag[(it & 1) * 8 + wid] = wdone ? 1u : 0u; }
#if ATT_DMA
        asm volatile("s_waitcnt vmcnt(0)" ::: "memory");
#else
        if (it + 1 < NT) { AT_WRITE(cur ^ 1); if (it + 2 < NT) AT_LOAD((NT - 3 - it) * 64); }
#endif
        __syncthreads();
    }
#undef AT_DMA
    float rli[16];
    if (MODE != 0) {
        if (hi == 0) li_l[r32] = l_reg;
        asm volatile("s_waitcnt lgkmcnt(0)" ::: "memory");
#pragma unroll
        for (int g = 0; g < 4; ++g) { const f32x4 lv = *(const LAS f32x4*)(li_l + 8 * g + 4 * hi);
#pragma unroll
            for (int i = 0; i < 4; ++i) rli[4 * g + i] = 1.0f / lv[i]; }
    } else {
#pragma unroll
        for (int r = 0; r < 16; ++r) rli[r] = 1.f;
    }
    bf16_t* Ow = Og + (size_t)qlo * ldo;
#pragma unroll
    for (int r = 0; r < 16; ++r) { const int orow = crow(r, hi);
#pragma unroll
        for (int d0 = 0; d0 < 4; ++d0) { const float v = o[d0][r] * rli[r]; const float vn = __shfl_xor(v, 1);
            if ((r32 & 1) == 0) *(unsigned*)(Ow + (size_t)orow * ldo + d0 * 32 + r32) = cvtpk(v, vn); } }
}

template <int DQK, int MODE>
__device__ __forceinline__ void attn_phase(const bf16_t* Qb, int ldq, int hq, const bf16_t* Kb, int ldk, int hk, const bf16_t* Vb, int ldv, int hv, bf16_t* Ob, const float* cf, float C2, LAS unsigned char* lds) {
#ifdef TESTCOPY
    if (MODE == 0) {
        for (size_t i = (size_t)blockIdx.x * 512 + threadIdx.x; i < (size_t)NTOK * DM; i += (size_t)gridDim.x * 512) {
            const float a = __uint_as_float((unsigned)Qb[i] << 16) + __uint_as_float((unsigned)Kb[i] << 16) + __uint_as_float((unsigned)Vb[i] << 16);
            Ob[i] = (bf16_t)(__float_as_uint(sinf(300.f * a)) >> 16); }
        return;
    }
#endif
#ifdef TESTNAN
    for (int i = threadIdx.x; i < LDS_BYTES / 4; i += 512) ((LAS unsigned*)lds)[i] = 0xFFFFFFFFu;
    __syncthreads();
#endif
    for (int w = blockIdx.x; w < 256; w += gridDim.x) {
        const int xcd = w & 7, slot = w >> 3, bh = xcd * 8 + (slot >> 2), y = slot & 3, b = bh >> 4, hd = bh & 15;
        if (MODE == 1) { LAS float* cfl = (LAS float*)(lds + AT_OFF_CF);
            for (int s = threadIdx.x; s < SEQ; s += 512) cfl[s] = cf[(size_t)bh * SEQ + s] * LOG2E;
            __syncthreads(); }
        const bf16_t* Q = Qb + (size_t)b * SEQ * ldq + hd * hq; const bf16_t* K = Kb + (size_t)b * SEQ * ldk + hd * hk; const bf16_t* V = Vb + (size_t)b * SEQ * ldv + hd * hv;
        bf16_t* O = Ob + (size_t)b * SEQ * DM + hd * HD;
        attn_block<DQK, MODE>(Q, ldq, K, ldk, V, ldv, O, DM, (7 - y) * 256, C2, lds);
        attn_block<DQK, MODE>(Q, ldq, K, ldk, V, ldv, O, DM, y * 256, C2, lds);
        __syncthreads();
    }
}

#define XB_TMO      128
#define XB_XCNT(j)  (256  + 64 * (j))
#define XB_XSUB(j)  (1280 + 64 * (j))
#define XB_XGEN(j)  (2304 + 64 * (j))
#define XB_TOP      3328
#define XB_TOPGEN   3392
#define XCD_BAR_WORDS 3456
#define XB_SPIN_CAP (1u << 18)
__device__ __forceinline__ unsigned xb_ld(unsigned* p)              { return __hip_atomic_load(p, __ATOMIC_RELAXED, __HIP_MEMORY_SCOPE_AGENT); }
__device__ __forceinline__ unsigned xb_add(unsigned* p, unsigned v) { return __hip_atomic_fetch_add(p, v, __ATOMIC_RELAXED, __HIP_MEMORY_SCOPE_AGENT); }
__device__ __forceinline__ unsigned xb_xcc_id() { return (unsigned)__builtin_amdgcn_s_getreg((3 << 11) | 20) & 0xFu; }
#define XB_SPIN(cond, bar) do { unsigned _sp = 0; while (cond) { __builtin_amdgcn_s_sleep(1); \
    if ((++_sp & 255u) == 0u) { if (xb_ld(&(bar)[XB_TMO])) break; if (_sp > XB_SPIN_CAP) { atomicAdd(&(bar)[XB_TMO], 1u); break; } } } } while (0)
struct XcdBarrier { unsigned* bar; unsigned x; volatile LAS unsigned* st; };
__device__ __forceinline__ XcdBarrier xcd_barrier_post(unsigned* bar, volatile LAS unsigned* st) {
    XcdBarrier b; b.bar = bar; b.x = xb_xcc_id(); b.st = st;
    if (threadIdx.x == 0) (void)xb_add(&bar[XB_XCNT(b.x)], 1u);
    return b;
}
__device__ __forceinline__ void xcd_barrier_complete(unsigned* bar, unsigned x, unsigned& nloc, unsigned& nx) {
    const unsigned G = gridDim.x * gridDim.y * gridDim.z;
    unsigned sum, cnt, mine, sp = 0u;
    for (;;) {
        sum = 0u; cnt = 0u; mine = 0u;
#pragma unroll
        for (unsigned j = 0; j < 16; ++j) { const unsigned c = xb_ld(&bar[XB_XCNT(j)]); sum += c; cnt += (c > 0u) ? 1u : 0u; mine = (j == x) ? c : mine; }
        if (sum == G) break;
        __builtin_amdgcn_s_sleep(1);
        if ((++sp & 255u) == 0u) { if (xb_ld(&bar[XB_TMO])) break; if (sp > XB_SPIN_CAP) { atomicAdd(&bar[XB_TMO], 1u); break; } }
    }
    nloc = mine > 0u ? mine : 1u; nx = cnt > 0u ? cnt : 1u;
}
__device__ __forceinline__ void xcd_barrier(const XcdBarrier& b) {
    asm volatile("s_waitcnt vmcnt(0)" ::: "memory");
    __syncthreads();
    if (threadIdx.x == 0) {
        unsigned* bar = b.bar;
        __builtin_amdgcn_s_waitcnt(0);
        unsigned nloc = b.st[0], nx = b.st[1];
        if (nloc == 0u) { xcd_barrier_complete(bar, b.x, nloc, nx); b.st[0] = nloc; b.st[1] = nx; }
        const unsigned old = xb_add(&bar[XB_XSUB(b.x)], 1u);
        const unsigned gen = old / nloc;
        if (old + 1u == (gen + 1u) * nloc) {
            __builtin_amdgcn_fence(__ATOMIC_RELEASE, "agent");
            asm volatile("s_waitcnt vmcnt(0)" ::: "memory");
            const unsigned og = xb_add(&bar[XB_TOP], 1u);
            const unsigned tg = og / nx;
            if (og + 1u == (tg + 1u) * nx) xb_add(&bar[XB_TOPGEN], 1u);
            else XB_SPIN(xb_ld(&bar[XB_TOPGEN]) == tg, bar);
            __builtin_amdgcn_fence(__ATOMIC_ACQUIRE, "agent");
            xb_add(&bar[XB_XGEN(b.x)], 1u);
            asm volatile("s_waitcnt vmcnt(0)" ::: "memory");
        } else {
            XB_SPIN(xb_ld(&bar[XB_XGEN(b.x)]) == gen, bar);
            __builtin_amdgcn_fence(__ATOMIC_ACQUIRE, "agent");
            asm volatile("s_waitcnt vmcnt(0)" ::: "memory");
        }
    }
    __syncthreads();
}

#ifndef NLAYERS
#define NLAYERS 4
#endif
constexpr int N_PHASES = 1 + 10 * NLAYERS;
__host__ __device__ inline bool phase_active(int ph) {
    if (ph == 0) return false;
    const int layer = (ph - 1) / 10, s = (ph - 1) % 10, kind = layer % 3;
    if (s == 2) return kind != 0;
    if (s == 3 || s == 4) return kind == 2;
    return true;
}

__global__ void __launch_bounds__(512, 2) fwd_megakernel(Params p) {
    extern __shared__ __attribute__((aligned(16))) unsigned char shm_raw[];
    LAS unsigned char* lds = (LAS unsigned char*)shm_raw;
    unsigned char* ws = p.ws;
    float* X = (float*)(ws + WS_X); bf16_t* H = (bf16_t*)(ws + WS_H); bf16_t* AO = p.alt ? (bf16_t*)(ws + WS_SCR + (size_t)NTOK * DFF * 2) : (bf16_t*)(ws + WS_AO);
    float* LOGF = (float*)(ws + WS_LOGF); float* CF = (float*)(ws + WS_CF); float* ROPE = (float*)(ws + WS_ROPE); float* KR = (float*)(ws + WS_KR);
    unsigned char* scr = ws + WS_SCR;
    bool first = true;
#if COOP
    volatile LAS unsigned* st = (volatile LAS unsigned*)(lds + 131072);
    if (threadIdx.x == 0) { st[0] = 0u; st[1] = 0u; }
    __syncthreads();
    const XcdBarrier xb = xcd_barrier_post((unsigned*)(ws + WS_BAR), st);
    int nsync = 0;
#endif
    for (int ph = (int)p.ph_lo; ph < (int)p.ph_hi; ++ph) {
        if (!phase_active(ph)) continue;
#if COOP
        if (!first) { if (nsync == 0) cg::this_grid().sync(); else xcd_barrier(xb); ++nsync; }
#endif
        first = false;
        const int layer = (ph - 1) / 10, s = (ph - 1) % 10, kind = layer % 3, j = layer / 3;
        const float* xin = (layer == 0) ? p.x : X;
        int ng = 0; GemmJob g0{}, g1{}; bool do_fgate = false;
        g0.M = NTOK; g1.M = NTOK;
        if (s == 0 || s == 7) {
            if (s == 0 && EN(100)) {
                if (kind == 0) conv_job(lds, p.sb_w_in + (size_t)j * 2048 * 6144, 6144, 0, 6144, 6144, 2048, (bf16_t*)(ws + W_SB_IN + j * SZ_QKVW));
                else if (kind == 1) { conv_job(lds, p.fox_w_in, 6160, 0, 6144, 6144, 2048, (bf16_t*)(ws + W_FOX_IN)); conv_job(lds, p.fox_w_in, 6160, 6144, 16, 128, 2048, (bf16_t*)(ws + W_FOX_F)); }
                else conv_job(lds, p.mla_w_in, MLA_DOWN, 0, MLA_DOWN, MLA_DOWN_PAD, 2048, (bf16_t*)(ws + W_MLA_IN));
            }
            if (s == 7 && EN(100)) conv_job(lds, p.mlp_w1 + (size_t)layer * 2048 * 8192, 8192, 0, 8192, 8192, 2048, (bf16_t*)(ws + W_W1 + layer * SZ_FFW));
            if (EN(0)) rmsnorm_phase(s == 0 ? xin : X, (s == 0 ? p.mix_norm : p.mlp_norm) + layer * DM, H);
        }
        else if (s == 1) {
            ng = 1; g0.A = H; g0.K = DM;
            if (kind == 2) { g0.Bt = (const bf16_t*)(ws + W_MLA_IN); g0.N = MLA_DOWN_PAD; g0.E = pg8::EpiGen{0, (bf16_t*)(scr + SC_DOWN), MLA_DOWN_PAD, 0, 0, nullptr, nullptr}; }
            else { g0.Bt = (const bf16_t*)(ws + (kind == 0 ? W_SB_IN + j * SZ_QKVW : W_FOX_IN)); g0.N = 3 * DM; g0.E = pg8::EpiGen{0, (bf16_t*)(scr + SC_Q), DM, DM, (size_t)NTOK * DM, nullptr, nullptr}; do_fgate = kind == 1; }
        } else if (s == 2) {
            if (kind == 1) { if (EN(2)) fox_prep_phase((bf16_t*)(scr + SC_Q), p.fox_q_gain, p.fox_k_gain, LOGF, CF); }
            else { if (EN(100)) { conv_job(lds, p.mla_w_uq, 3072, 0, 3072, 3072, 768, (bf16_t*)(ws + W_MLA_UQ)); conv_job(lds, p.mla_w_ukv, 4096, 0, 4096, 4096, 512, (bf16_t*)(ws + W_MLA_UKV)); }
                   if (EN(2)) mla_prep1_phase((const bf16_t*)(scr + SC_DOWN), p.pos, p.mla_q_norm, p.mla_kv_norm, (bf16_t*)(scr + SC_CQ), (bf16_t*)(scr + SC_CKV), ROPE, KR); }
        } else if (s == 3) {
            ng = 2;
            g0.A = (const bf16_t*)(scr + SC_CQ); g0.Bt = (const bf16_t*)(ws + W_MLA_UQ); g0.N = 3072; g0.K = MLA_QR; g0.E = pg8::EpiGen{0, (bf16_t*)(scr + SC_QUP), 3072, 0, 0, nullptr, nullptr};
            g1.A = (const bf16_t*)(scr + SC_CKV); g1.Bt = (const bf16_t*)(ws + W_MLA_UKV); g1.N = 4096; g1.K = MLA_KVR; g1.E = pg8::EpiGen{0, (bf16_t*)(scr + SC_KV), 4096, 0, 0, nullptr, nullptr};
        } else if (s == 4) { if (EN(4)) mla_prep2_phase((const bf16_t*)(scr + SC_QUP), (const bf16_t*)(scr + SC_KV), ROPE, KR, p.mla_q_gain, p.mla_k_gain, (bf16_t*)(scr + SC_QN), (bf16_t*)(scr + SC_KN)); }
        else if (s == 5) {
            if (kind == 0) { if (EN(50)) attn_phase<128, TESTMODE2 ? 2 : 0>((const bf16_t*)(scr + SC_Q), DM, HD, (const bf16_t*)(scr + SC_K), DM, HD, (const bf16_t*)(scr + SC_V), DM, HD, AO, nullptr, 0.08838834764831845f * LOG2E, lds); }
            else if (kind == 1) { if (EN(51)) attn_phase<128, 1>((const bf16_t*)(scr + SC_Q), DM, HD, (const bf16_t*)(scr + SC_K), DM, HD, (const bf16_t*)(scr + SC_V), DM, HD, AO, CF, 0.08838834764831845f * LOG2E, lds); }
            else { if (EN(52)) attn_phase<192, 2>((const bf16_t*)(scr + SC_QN), 3072, 192, (const bf16_t*)(scr + SC_KN), 3072, 192, (const bf16_t*)(scr + SC_KV) + 128, 4096, 256, AO, nullptr, 0.07216878364870323f * LOG2E, lds); }
            if (EN(100)) {
                if (kind == 0) conv_job(lds, p.sb_w_out + (size_t)j * 2048 * 2048, 2048, 0, 2048, 2048, 2048, (bf16_t*)(ws + W_SB_OUT + j * SZ_SQW));
                else if (kind == 1) conv_job(lds, p.fox_w_out, 2048, 0, 2048, 2048, 2048, (bf16_t*)(ws + W_FOX_OUT));
                else conv_job(lds, p.mla_w_out, 2048, 0, 2048, 2048, 2048, (bf16_t*)(ws + W_MLA_OUT));
            }
        } else if (s == 6) {
            ng = 1; g0.A = AO; g0.K = DM; g0.N = DM; g0.Bt = (const bf16_t*)(ws + (kind == 0 ? W_SB_OUT + j * SZ_SQW : (kind == 1 ? W_FOX_OUT : W_MLA_OUT)));
            g0.E = pg8::EpiGen{2, nullptr, DM, 0, 0, xin, X};
        } else if (s == 8) {
            ng = 1; g0.A = H; g0.K = DM; g0.N = DFF; g0.Bt = (const bf16_t*)(ws + W_W1 + layer * SZ_FFW); g0.E = pg8::EpiGen{1, (bf16_t*)scr, DFF, 0, 0, nullptr, nullptr};
        } else {
            ng = 1; g0.A = (const bf16_t*)scr; g0.K = DFF; g0.N = DM; g0.Bt = (const bf16_t*)(ws + W_W2 + layer * SZ_FFW); g0.E = pg8::EpiGen{2, nullptr, DM, 0, 0, X, (layer == NLAYERS - 1) ? p.out : X};
        }
        if (EN(1)) {
#pragma nounroll
            for (int gi = 0; gi < ng; ++gi) run_gemm(lds, gi ? g1 : g0);
        }
        if (s == 8 && EN(100)) conv_job(lds, p.mlp_w2 + (size_t)layer * 8192 * 2048, 2048, 0, 2048, 2048, 8192, (bf16_t*)(ws + W_W2 + layer * SZ_FFW));
        if (do_fgate && EN(2)) fgate_phase(H, (const bf16_t*)(ws + W_FOX_F), p.fox_b_f, LOGF);
    }
}

__global__ void k_cmp(const unsigned* a, const unsigned* b, size_t n, unsigned* cnt) {
    unsigned c = 0;
    for (size_t i = (size_t)blockIdx.x * blockDim.x + threadIdx.x; i < n; i += (size_t)gridDim.x * blockDim.x) c += (a[i] != b[i]) ? 1u : 0u;
    if (c) atomicAdd(cnt, c);
}
__global__ void k_out(float* out, size_t n, const unsigned* cnt) {
    for (size_t i = (size_t)blockIdx.x * blockDim.x + threadIdx.x; i < n; i += (size_t)gridDim.x * blockDim.x) out[i] = 0.f;
    if (blockIdx.x == 0 && threadIdx.x == 0) out[0] = cnt[0] ? 3.0e5f : 1.0e5f;
}
extern "C" void kernel_launch(void* const* d_in, const int* in_sizes, int n_in, void* d_out, int out_size, void* d_ws, size_t ws_size, hipStream_t stream) {
    static int grid = 0;
    if (grid == 0) {
        if (n_in != 21 || out_size != NTOK * DM || ws_size < WS_END) { fprintf(stderr, "kernel_launch: unexpected shapes (n_in %d out %d ws %zu need %zu)\n", n_in, out_size, ws_size, (size_t)WS_END); grid = -1; return; }
        int dev = 0, cus = 0, per_cu = 0;
        hipGetDevice(&dev); hipDeviceGetAttribute(&cus, hipDeviceAttributeMultiprocessorCount, dev);
        if (hipFuncSetAttribute((const void*)fwd_megakernel, hipFuncAttributeMaxDynamicSharedMemorySize, LDS_BYTES) != hipSuccess) { fprintf(stderr, "kernel_launch: hipFuncSetAttribute failed\n"); grid = -1; return; }
        if (hipOccupancyMaxActiveBlocksPerMultiprocessor(&per_cu, (const void*)fwd_megakernel, 512, LDS_BYTES) != hipSuccess || per_cu < 1) { fprintf(stderr, "kernel_launch: occupancy query says %d\n", per_cu); per_cu = 1; }
        (void)hipGetLastError();
        grid = cus * 1;
        if (grid > 256) grid = 256;
    }
    if (grid < 0) return;
    Params p{};
    p.x = (const float*)d_in[0]; p.pos = (const int*)d_in[1]; p.mix_norm = (const float*)d_in[2]; p.mlp_norm = (const float*)d_in[3];
    p.sb_w_in = (const float*)d_in[4]; p.sb_w_out = (const float*)d_in[5]; p.fox_w_in = (const float*)d_in[6]; p.fox_b_f = (const float*)d_in[7];
    p.fox_q_gain = (const float*)d_in[8]; p.fox_k_gain = (const float*)d_in[9]; p.fox_w_out = (const float*)d_in[10];
    p.mla_w_in = (const float*)d_in[11]; p.mla_q_norm = (const float*)d_in[12]; p.mla_kv_norm = (const float*)d_in[13]; p.mla_w_uq = (const float*)d_in[14]; p.mla_w_ukv = (const float*)d_in[15];
    p.mla_q_gain = (const float*)d_in[16]; p.mla_k_gain = (const float*)d_in[17]; p.mla_w_out = (const float*)d_in[18]; p.mlp_w1 = (const float*)d_in[19]; p.mlp_w2 = (const float*)d_in[20];
    p.out = (float*)d_out; p.ws = (unsigned char*)d_ws;
#if COOP
    hipMemsetAsync((char*)d_ws + WS_BAR, 0, 16384, stream);
    p.ph_lo = 0; p.ph_hi = N_PHASES;
    void* args[] = {&p};
    hipError_t e = hipLaunchCooperativeKernel((const void*)fwd_megakernel, dim3(grid), dim3(512), args, LDS_BYTES, stream);
    if (e != hipSuccess) fprintf(stderr, "cooperative launch failed: %s (grid %d)\n", hipGetErrorString(e), grid);
#else
    for (int ph = 0; ph < N_PHASES; ++ph) {
        if (!phase_active(ph)) continue;
        p.ph_lo = ph; p.ph_hi = ph + 1;
        hipLaunchKernelGGL(fwd_megakernel, dim3(grid), dim3(512), LDS_BYTES, stream, p);
#ifdef TESTDUP
        if (ph == 6) { p.alt = 1; hipLaunchKernelGGL(fwd_megakernel, dim3(grid), dim3(512), LDS_BYTES, stream, p); p.alt = 0; }
#endif
    }
#ifdef TESTDUP
    unsigned* cnt = (unsigned*)((char*)d_ws + WS_LOGF);
    hipMemsetAsync(cnt, 0, 4, stream);
    hipLaunchKernelGGL(k_cmp, dim3(1024), dim3(256), 0, stream, (const unsigned*)((char*)d_ws + WS_AO), (const unsigned*)((char*)d_ws + WS_SCR + (size_t)NTOK * DFF * 2), (size_t)NTOK * DM / 2, cnt);
    hipLaunchKernelGGL(k_out, dim3(1024), dim3(256), 0, stream, (float*)d_out, (size_t)NTOK * DM, (const unsigned*)cnt);
#endif
#endif
}
```

```cpp
#include <hip/hip_runtime.h>
#include <hip/hip_cooperative_groups.h>
#include <cstdio>
#include <cstdint>
namespace cg = cooperative_groups;

#ifndef COOP
#define COOP 1
#endif
#ifndef ONLY
#define ONLY -1
#endif
#ifndef ATT_DMA
#define ATT_DMA 1
#endif
#define TESTMODE2 0

#ifndef SKIP
#define SKIP -5
#endif
#define EN(x) ((ONLY < 0 || ONLY == (x)) && (x) != SKIP)

#define LAS __attribute__((address_space(3)))
typedef unsigned short bf16_t;
typedef short bf16x8 __attribute__((ext_vector_type(8)));
typedef short s16x4 __attribute__((ext_vector_type(4)));
typedef float f32x4 __attribute__((ext_vector_type(4)));
typedef float f32x16 __attribute__((ext_vector_type(16)));
typedef unsigned u32x4 __attribute__((ext_vector_type(4)));
typedef unsigned u32x2 __attribute__((ext_vector_type(2)));

constexpr int DM = 2048, NTOK = 8192, SEQ = 2048, NH = 16, HD = 128, DFF = 8192, DEPTH = 4;
constexpr int MLA_QR = 768, MLA_KVR = 512, MLA_ROPE = 64, MLA_QK = 192, MLA_DOWN = 1344, MLA_DOWN_PAD = 1536;
constexpr float EPS = 1e-6f;
constexpr float LOG2E = 1.4426950408889634f;

constexpr size_t SZ_QKVW = (size_t)6144 * 2048 * 2, SZ_SQW = (size_t)2048 * 2048 * 2, SZ_FFW = (size_t)8192 * 2048 * 2;
constexpr size_t W_SB_IN = 0;
constexpr size_t W_SB_OUT = W_SB_IN + 2 * SZ_QKVW;
constexpr size_t W_FOX_IN = W_SB_OUT + 2 * SZ_SQW;
constexpr size_t W_FOX_F = W_FOX_IN + SZ_QKVW;
constexpr size_t W_FOX_OUT = W_FOX_F + (size_t)128 * 2048 * 2;
constexpr size_t W_MLA_IN = W_FOX_OUT + SZ_SQW;
constexpr size_t W_MLA_UQ = W_MLA_IN + (size_t)1536 * 2048 * 2;
constexpr size_t W_MLA_UKV = W_MLA_UQ + (size_t)3072 * 768 * 2;
constexpr size_t W_MLA_OUT = W_MLA_UKV + (size_t)4096 * 512 * 2;
constexpr size_t W_W1 = W_MLA_OUT + SZ_SQW;
constexpr size_t W_W2 = W_W1 + 4 * SZ_FFW;
constexpr size_t WS_X = W_W2 + 4 * SZ_FFW;
constexpr size_t WS_H = WS_X + (size_t)NTOK * DM * 4;
constexpr size_t WS_AO = WS_H + (size_t)NTOK * DM * 2;
constexpr size_t WS_LOGF = WS_AO + (size_t)NTOK * DM * 2;
constexpr size_t WS_CF = WS_LOGF + (size_t)NTOK * 16 * 4;
constexpr size_t WS_ROPE = WS_CF + (size_t)64 * 2048 * 4;
constexpr size_t WS_KR = WS_ROPE + (size_t)NTOK * 64 * 4;
constexpr size_t WS_SCR = WS_KR + (size_t)NTOK * 64 * 4;
constexpr size_t SC_Q = 0, SC_K = (size_t)NTOK * DM * 2, SC_V = 2 * (size_t)NTOK * DM * 2;
constexpr size_t SC_DOWN = 0;
constexpr size_t SC_CQ = SC_DOWN + (size_t)NTOK * MLA_DOWN_PAD * 2;
constexpr size_t SC_CKV = SC_CQ + (size_t)NTOK * MLA_QR * 2;
constexpr size_t SC_QUP = SC_CKV + (size_t)NTOK * MLA_KVR * 2;
constexpr size_t SC_KV = SC_QUP + (size_t)NTOK * 3072 * 2;
constexpr size_t SC_QN = SC_KV + (size_t)NTOK * 4096 * 2;
constexpr size_t SC_KN = SC_QN + (size_t)NTOK * 3072 * 2;
constexpr size_t SC_END = SC_KN + (size_t)NTOK * 3072 * 2;
constexpr size_t WS_BAR = WS_SCR + SC_END;
constexpr size_t WS_END = WS_BAR + 16384;

constexpr int LDS_BYTES = 131072 + 16;

struct Params {
    const float* x; const int* pos; const float* mix_norm; const float* mlp_norm;
    const float* sb_w_in; const float* sb_w_out; const float* fox_w_in; const float* fox_b_f; const float* fox_q_gain; const float* fox_k_gain; const float* fox_w_out;
    const float* mla_w_in; const float* mla_q_norm; const float* mla_kv_norm; const float* mla_w_uq; const float* mla_w_ukv; const float* mla_q_gain; const float* mla_k_gain; const float* mla_w_out;
    const float* mlp_w1; const float* mlp_w2;
    float* out; unsigned char* ws;
    long long ph_lo, ph_hi, alt;
};

__device__ __forceinline__ unsigned cvtpk(float lo, float hi) { unsigned r; asm volatile("v_cvt_pk_bf16_f32 %0, %1, %2" : "=v"(r) : "v"(lo), "v"(hi)); return r; }
__device__ __forceinline__ float bflo(unsigned w) { return __uint_as_float(w << 16); }
__device__ __forceinline__ float bfhi(unsigned w) { return __uint_as_float(w & 0xffff0000u); }
__device__ __forceinline__ int opq(int x) { asm volatile("" : "+v"(x)); return x; }
__device__ __forceinline__ float wave_sum(float v) {
#pragma unroll
    for (int o = 32; o > 0; o >>= 1) v += __shfl_xor(v, o);
    return v;
}
__device__ __forceinline__ float sum16(float v) {
#pragma unroll
    for (int o = 8; o > 0; o >>= 1) v += __shfl_xor(v, o);
    return v;
}

namespace pg8 {
constexpr int BM = 256, BK = 64, HALF = 128, HTB = HALF * BK * 2, STAGE_BYTES = 8 * HTB, NXCD = 8, WGM = 8;
__host__ __device__ __forceinline__ int lds_byte(int r, int c) { const int st = (r >> 4) * 2 + (c >> 5), rr = r & 15, cc = c & 31, ob = rr * 64 + cc * 2; return st * 1024 + (ob ^ (((ob >> 9) & 1) << 5)); }
__host__ __device__ __forceinline__ void stage_rc(int b, int& R, int& C) { const int st = b / 1024, sb = b % 1024, swz = sb ^ (((sb >> 9) & 1) << 5); R = (st >> 1) * 16 + swz / 64; C = (st & 1) * 32 + (swz % 64) / 2; }
__host__ __device__ __forceinline__ int perm32(int rho) { const int n = rho >> 4, i = rho & 15; return 8 * (i >> 2) + 4 * n + (i & 3); }
struct Unit { int pm, pn; };
struct Gemm { const bf16_t* A; const bf16_t* Bt; int M, N, K; };
struct StaticOrder {
    int nM, nN, nwg, G, c;
    __device__ void init(int M, int N, int G_, int c_) { nM = M / BM; nN = N / BM; nwg = nM * nN; G = G_; c = c_; }
    __device__ bool next(int i, Unit& u) const {
        const long L = (long)i * G + c; if (L >= nwg) return false;
        int wgid = (int)L; { const int q = nwg / NXCD, r = nwg % NXCD, xcd = wgid % NXCD, off = wgid / NXCD; wgid = (xcd < r ? xcd * (q + 1) : r * (q + 1) + (xcd - r) * q) + off; }
        const int nig = WGM * nN, gid = wgid / nig, fm = gid * WGM, gsz = (nM - fm) < WGM ? (nM - fm) : WGM;
        u.pm = fm + ((wgid % nig) % gsz); u.pn = (wgid % nig) / gsz; return true;
    }
};
struct EpiGen {
    int mode; bf16_t* O; int ldc; int split_cols; size_t split_stride; const void* R; void* C; int rf32, cf32;
    __device__ __forceinline__ void operator()(const f32x4 (&acc)[2][2][4][2], const Unit& u, int wr, int wc, int fr, int fq) const {
        const int row0 = u.pm * BM + wr * 64 + fr;
        if (mode == 2) {
            const int col0 = u.pn * BM + wc * 32 + 8 * fq;
            const float* R32 = (const float*)R; const bf16_t* R16 = (const bf16_t*)R; float* C32 = (float*)C; bf16_t* C16 = (bf16_t*)C;
#pragma unroll
            for (int ai = 0; ai < 2; ++ai) {
                if (rf32) {
#pragma unroll
                    for (int mp = 0; mp < 2; ++mp) {
                        f32x4 rv[2][2][2];
#pragma unroll
                        for (int mm = 0; mm < 2; ++mm) { const size_t ro = (size_t)(row0 + ai * HALF + (2 * mp + mm) * 16) * ldc + col0;
#pragma unroll
                            for (int bj = 0; bj < 2; ++bj) { rv[mm][bj][0] = *(const f32x4*)(R32 + ro + bj * HALF); rv[mm][bj][1] = *(const f32x4*)(R32 + ro + bj * HALF + 4); } }
#pragma unroll
                        for (int mm = 0; mm < 2; ++mm) { const int m = 2 * mp + mm; const size_t ro = (size_t)(row0 + ai * HALF + m * 16) * ldc + col0;
#pragma unroll
                            for (int bj = 0; bj < 2; ++bj) { const f32x4 x0 = acc[ai][bj][m][0] + rv[mm][bj][0], x1 = acc[ai][bj][m][1] + rv[mm][bj][1];
                                if (cf32) { *(f32x4*)(C32 + ro + bj * HALF) = x0; *(f32x4*)(C32 + ro + bj * HALF + 4) = x1; }
                                else { u32x4 w; w.x = cvtpk(x0[0], x0[1]); w.y = cvtpk(x0[2], x0[3]); w.z = cvtpk(x1[0], x1[1]); w.w = cvtpk(x1[2], x1[3]); *(u32x4*)(C16 + ro + bj * HALF) = w; } } }
                    }
                } else {
                    u32x4 rw[4][2];
#pragma unroll
                    for (int m = 0; m < 4; ++m) { const size_t ro = (size_t)(row0 + ai * HALF + m * 16) * ldc + col0;
#pragma unroll
                        for (int bj = 0; bj < 2; ++bj) rw[m][bj] = *(const u32x4*)(R16 + ro + bj * HALF); }
#pragma unroll
                    for (int m = 0; m < 4; ++m) { const size_t ro = (size_t)(row0 + ai * HALF + m * 16) * ldc + col0;
#pragma unroll
                        for (int bj = 0; bj < 2; ++bj) { const u32x4 r = rw[m][bj];
                            const f32x4 x0 = acc[ai][bj][m][0] + (f32x4){bflo(r.x), bfhi(r.x), bflo(r.y), bfhi(r.y)}, x1 = acc[ai][bj][m][1] + (f32x4){bflo(r.z), bfhi(r.z), bflo(r.w), bfhi(r.w)};
                            if (cf32) { *(f32x4*)(C32 + ro + bj * HALF) = x0; *(f32x4*)(C32 + ro + bj * HALF + 4) = x1; }
                            else { u32x4 w; w.x = cvtpk(x0[0], x0[1]); w.y = cvtpk(x0[2], x0[3]); w.z = cvtpk(x1[0], x1[1]); w.w = cvtpk(x1[2], x1[3]); *(u32x4*)(C16 + ro + bj * HALF) = w; } } }
                }
            }
        } else {
            int colt = u.pn * BM; bf16_t* base = O;
            if (split_cols) { const int t = colt / split_cols; base += (size_t)t * split_stride; colt -= t * split_cols; }
            const int col0 = colt + wc * 32 + 8 * fq; const bool act = mode == 1;
#pragma unroll
            for (int ai = 0; ai < 2; ++ai)
#pragma unroll
                for (int m = 0; m < 4; ++m) { bf16_t* rowp = base + (size_t)(row0 + ai * HALF + m * 16) * ldc + col0;
#pragma unroll
                    for (int bj = 0; bj < 2; ++bj) { f32x4 v0 = acc[ai][bj][m][0], v1 = acc[ai][bj][m][1];
                        if (act) {
#pragma unroll
                            for (int j = 0; j < 4; ++j) { float x = fmaxf(v0[j], 0.f), y = fmaxf(v1[j], 0.f); v0[j] = x * x; v1[j] = y * y; } }
                        u32x4 w; w.x = cvtpk(v0[0], v0[1]); w.y = cvtpk(v0[2], v0[3]); w.z = cvtpk(v1[0], v1[1]); w.w = cvtpk(v1[2], v1[3]);
                        *(u32x4*)(rowp + bj * HALF) = w; } }
        }
    }
};

template <class Epi, class Sched>
__device__ __forceinline__ void gemm_phase(LAS unsigned char* lds, const Gemm g, const Sched& S, const Epi& E) {
    const int tid = opq(threadIdx.x), wid = __builtin_amdgcn_readfirstlane(tid >> 6), lane = tid & 63, wr = wid >> 2, wc = wid & 3, fr = lane & 15, fq = lane >> 4;
    const int K = g.K, nt = K / BK;
    unsigned voffA[2], voffB[2];
#pragma unroll
    for (int i = 0; i < 2; ++i) { int R, C; stage_rc(tid * 16 + i * 8192, R, C); const int Rb = (R & ~31) + perm32(R & 31);
        voffA[i] = (unsigned)(R * K + C) * 2u; voffB[i] = (unsigned)(Rb * K + C) * 2u; }
    const size_t kstep = (size_t)(BK * 2);
    const size_t hstep = (size_t)HALF * K * 2;
    const size_t tstep = 2 * hstep;
    const unsigned ldsw = (unsigned)wid * 1024u;
    const int aoff = lds_byte(wr * 64 + fr, fq * 8), boff = lds_byte(wc * 32 + fr, fq * 8);
#define PG8_SA(b, h) (((b) * 2 + (h)) * HTB)
#define PG8_SB(b, h) ((4 + (b) * 2 + (h)) * HTB)
#define PG8_STAGE(bufoff, gbase, voff) do { _Pragma("unroll") for (int _i = 0; _i < 2; ++_i) \
        __builtin_amdgcn_global_load_lds((const unsigned*)((const char*)(gbase) + (voff)[_i]), (LAS unsigned*)(lds + (bufoff) + ldsw + _i * 8192), 16, 0, 0); } while (0)
#define PG8_LDA(dst, b, h) do { _Pragma("unroll") for (int m = 0; m < 4; ++m) _Pragma("unroll") for (int k = 0; k < 2; ++k) dst[m][k] = *(const LAS bf16x8*)(lds + PG8_SA(b, h) + aoff + m * 2048 + k * 1024); } while (0)
#define PG8_LDB(dst, b, h) do { _Pragma("unroll") for (int n = 0; n < 2; ++n) _Pragma("unroll") for (int k = 0; k < 2; ++k) dst[n][k] = *(const LAS bf16x8*)(lds + PG8_SB(b, h) + boff + n * 2048 + k * 1024); } while (0)
#define PG8_MMA(ai, bj, At, Bt) do { __builtin_amdgcn_s_setprio(1); _Pragma("unroll") for (int m = 0; m < 4; ++m) _Pragma("unroll") for (int n = 0; n < 2; ++n) _Pragma("unroll") for (int k = 0; k < 2; ++k) \
        acc[ai][bj][m][n] = __builtin_amdgcn_mfma_f32_16x16x32_bf16(Bt[n][k], At[m][k], acc[ai][bj][m][n], 0, 0, 0); __builtin_amdgcn_s_setprio(0); } while (0)
#define PG8_WAIT_V(n) asm volatile("s_waitcnt vmcnt(" #n ")" ::: "memory")
#define PG8_WAIT_L(n) asm volatile("s_waitcnt lgkmcnt(" #n ")" ::: "memory")
#define PG8_BAR __builtin_amdgcn_s_barrier()
#define PG8_SCHED __builtin_amdgcn_sched_barrier(0)
    Unit cur, nxt; int ui = 0;
    if (!S.next(0, cur)) return;
    f32x4 acc[2][2][4][2];
#pragma unroll
    for (int a = 0; a < 2; ++a)
#pragma unroll
        for (int b = 0; b < 2; ++b)
#pragma unroll
            for (int m = 0; m < 4; ++m)
#pragma unroll
                for (int n = 0; n < 2; ++n) acc[a][b][m][n] = (f32x4){0.f, 0.f, 0.f, 0.f};
    bf16x8 At[4][2], B0[2][2], B1[2][2];
    const char* cA = (const char*)g.A + (size_t)cur.pm * tstep; const char* cB = (const char*)g.Bt + (size_t)cur.pn * tstep;
    PG8_STAGE(PG8_SB(0, 0), cB, voffB); PG8_STAGE(PG8_SA(0, 0), cA, voffA); PG8_STAGE(PG8_SB(0, 1), cB + hstep, voffB); PG8_STAGE(PG8_SA(0, 1), cA + hstep, voffA);
    if (wr == 1) PG8_BAR;
    PG8_WAIT_V(4); PG8_BAR;
    PG8_STAGE(PG8_SB(1, 0), cB + kstep, voffB); PG8_STAGE(PG8_SA(1, 0), cA + kstep, voffA); PG8_STAGE(PG8_SB(1, 1), cB + hstep + kstep, voffB);
    PG8_WAIT_V(6); PG8_BAR;
    for (;;) {
        const bool has_next = S.next(ui + 1, nxt);
        const char* nA = has_next ? (const char*)g.A + (size_t)nxt.pm * tstep : cA; const char* nB = has_next ? (const char*)g.Bt + (size_t)nxt.pn * tstep : cB;
        for (int t = 0; t < nt; t += 2) {
            const bool last = (t == nt - 2);
            const char* a1 = cA + (size_t)(t + 1) * kstep;
            const char* a2 = last ? nA : cA + (size_t)(t + 2) * kstep; const char* b2 = last ? nB : cB + (size_t)(t + 2) * kstep;
            const char* a3 = a2 + kstep; const char* b3 = b2 + kstep;
            PG8_LDB(B0, 0, 0); PG8_SCHED; PG8_LDA(At, 0, 0); PG8_STAGE(PG8_SA(1, 1), a1 + hstep, voffA);
            PG8_WAIT_L(8); PG8_BAR; PG8_WAIT_L(0); PG8_MMA(0, 0, At, B0); PG8_BAR; PG8_SCHED;
            PG8_LDB(B1, 0, 1); PG8_STAGE(PG8_SB(0, 0), b2, voffB);
            PG8_BAR; PG8_WAIT_L(0); PG8_MMA(0, 1, At, B1); PG8_BAR;
            PG8_LDA(At, 0, 1); PG8_STAGE(PG8_SA(0, 0), a2, voffA);
            PG8_BAR; PG8_WAIT_L(0); PG8_MMA(1, 0, At, B0); PG8_BAR; PG8_SCHED;
            PG8_STAGE(PG8_SB(0, 1), b2 + hstep, voffB);
            PG8_WAIT_V(6); PG8_BAR; PG8_MMA(1, 1, At, B1); PG8_BAR;
            PG8_LDB(B0, 1, 0); PG8_SCHED; PG8_LDA(At, 1, 0); PG8_STAGE(PG8_SA(0, 1), a2 + hstep, voffA);
            PG8_WAIT_L(8); PG8_BAR; PG8_WAIT_L(0); PG8_MMA(0, 0, At, B0); PG8_BAR; PG8_SCHED;
            PG8_LDB(B1, 1, 1); PG8_STAGE(PG8_SB(1, 0), b3, voffB);
            PG8_BAR; PG8_WAIT_L(0); PG8_MMA(0, 1, At, B1); PG8_BAR;
            PG8_LDA(At, 1, 1); PG8_STAGE(PG8_SA(1, 0), a3, voffA);
            PG8_BAR; PG8_WAIT_L(0); PG8_MMA(1, 0, At, B0); PG8_BAR; PG8_SCHED;
            PG8_STAGE(PG8_SB(1, 1), b3 + hstep, voffB);
            PG8_WAIT_V(6); PG8_BAR; PG8_MMA(1, 1, At, B1); PG8_BAR;
        }
        E(acc, cur, wr, wc, fr, fq);
        if (!has_next) break;
#pragma unroll
        for (int a = 0; a < 2; ++a)
#pragma unroll
            for (int b = 0; b < 2; ++b)
#pragma unroll
                for (int m = 0; m < 4; ++m)
#pragma unroll
                    for (int n = 0; n < 2; ++n) acc[a][b][m][n] = (f32x4){0.f, 0.f, 0.f, 0.f};
        cur = nxt; cA = nA; cB = nB; ++ui;
    }
    PG8_WAIT_V(0);
    if (wr == 0) PG8_BAR;
    PG8_BAR;
#undef PG8_SA
#undef PG8_SB
#undef PG8_STAGE
#undef PG8_LDA
#undef PG8_LDB
#undef PG8_MMA
#undef PG8_WAIT_V
#undef PG8_WAIT_L
#undef PG8_BAR
#undef PG8_SCHED
}
}

struct GemmJob { const bf16_t* A; const bf16_t* Bt; int M, N, K; pg8::EpiGen E; };
__device__ __forceinline__ void run_gemm(LAS unsigned char* lds, const GemmJob& j) {
    pg8::Gemm g{j.A, j.Bt, j.M, j.N, j.K};
    pg8::StaticOrder S; S.init(j.M, j.N, (int)gridDim.x, (int)blockIdx.x);
    pg8::gemm_phase<pg8::EpiGen, pg8::StaticOrder>(lds, g, S, j.E);
    __syncthreads();
}

__device__ __forceinline__ void conv_job(LAS unsigned char* lds, const float* __restrict__ src, int ldn, int col0, int ncols, int npad, int K, bf16_t* __restrict__ dst) {
    constexpr int LR = 132;
    LAS float* T = (LAS float*)lds;
    const int tid = opq(threadIdx.x), n4 = tid & 31, kr = tid >> 5;
    const int rn = tid & 127, rk = tid >> 7;
    const int ntn = npad / 128, ntk = K / 128, ntiles = ntn * ntk;
    f32x4 r[8];
    int t = blockIdx.x;
#define CONV_LOAD(tt_) do { const int tn_ = (tt_) % ntn, tk_ = (tt_) / ntn; const int n_ = tn_ * 128 + n4 * 4; const bool ok_ = n_ < ncols; \
        const float* p_ = src + (size_t)(tk_ * 128 + kr) * ldn + col0 + (ok_ ? n_ : 0); \
        _Pragma("unroll") for (int j_ = 0; j_ < 8; ++j_) { r[j_] = __builtin_nontemporal_load((const f32x4*)(p_ + (size_t)(16 * j_) * ldn)); if (!ok_) r[j_] = (f32x4){0.f, 0.f, 0.f, 0.f}; } } while (0)
    if (t < ntiles) CONV_LOAD(t);
    for (; t < ntiles; t += gridDim.x) {
        const int tn = t % ntn, tk = t / ntn;
#pragma unroll
        for (int j = 0; j < 8; ++j) *(LAS f32x4*)(T + (kr + 16 * j) * LR + n4 * 4) = r[j];
        if (t + (int)gridDim.x < ntiles) CONV_LOAD(t + (int)gridDim.x);
        __syncthreads();
#pragma unroll
        for (int j = 0; j < 4; ++j) { const int kc = rk + 4 * j; float v[8];
#pragma unroll
            for (int i = 0; i < 8; ++i) v[i] = T[(kc * 8 + i) * LR + rn];
            u32x4 w; w.x = cvtpk(v[0], v[1]); w.y = cvtpk(v[2], v[3]); w.z = cvtpk(v[4], v[5]); w.w = cvtpk(v[6], v[7]);
            *(u32x4*)(dst + (size_t)(tn * 128 + rn) * K + tk * 128 + kc * 8) = w; }
        __syncthreads();
    }
}

__device__ __forceinline__ void rmsnorm_phase(const void* __restrict__ xv, bool xf32, const float* __restrict__ g, bf16_t* __restrict__ h) {
    const int tid = opq(threadIdx.x), lane = tid & 63, gw = blockIdx.x * 8 + (tid >> 6), nw = gridDim.x * 8;
    for (int row = gw; row < NTOK; row += nw) {
        f32x4 v[8]; float ss = 0.f;
        if (xf32) { const float* xr = (const float*)xv + (size_t)row * DM;
#pragma unroll
            for (int j = 0; j < 8; ++j) v[j] = *(const f32x4*)(xr + j * 256 + lane * 4); }
        else { const bf16_t* xr = (const bf16_t*)xv + (size_t)row * DM;
#pragma unroll
            for (int j = 0; j < 8; ++j) { const u32x2 w = *(const u32x2*)(xr + j * 256 + lane * 4); v[j] = (f32x4){bflo(w.x), bfhi(w.x), bflo(w.y), bfhi(w.y)}; } }
#pragma unroll
        for (int j = 0; j < 8; ++j) ss += v[j][0] * v[j][0] + v[j][1] * v[j][1] + v[j][2] * v[j][2] + v[j][3] * v[j][3];
        ss = wave_sum(ss); const float rs = rsqrtf(ss * (1.f / DM) + EPS);
#pragma unroll
        for (int j = 0; j < 8; ++j) { const f32x4 gv = *(const f32x4*)(g + j * 256 + lane * 4);
            u32x2 w; w.x = cvtpk(v[j][0] * rs * gv[0], v[j][1] * rs * gv[1]); w.y = cvtpk(v[j][2] * rs * gv[2], v[j][3] * rs * gv[3]);
            *(u32x2*)(h + (size_t)row * DM + j * 256 + lane * 4) = w; }
    }
}

__device__ __forceinline__ void fgate_phase(const bf16_t* __restrict__ h, const bf16_t* __restrict__ wft, const float* __restrict__ bfv, float* __restrict__ logf) {
    const int tid = opq(threadIdx.x), lane = tid & 63, gw = blockIdx.x * 8 + (tid >> 6), nw = gridDim.x * 8;
    const int fr = lane & 15, fq = lane >> 4;
    if ((gw & 3) != 0) return;
    for (int job = gw >> 2; job < NTOK / 16; job += (nw >> 2)) {
        const bf16_t* ap = h + (size_t)(job * 16 + fr) * DM + fq * 8; const bf16_t* bp = wft + (size_t)fr * DM + fq * 8;
        f32x4 acc = {0.f, 0.f, 0.f, 0.f};
#pragma unroll 8
        for (int k = 0; k < DM; k += 32) { const bf16x8 a = *(const bf16x8*)(ap + k), b = *(const bf16x8*)(bp + k); acc = __builtin_amdgcn_mfma_f32_16x16x32_bf16(a, b, acc, 0, 0, 0); }
        const float bb = bfv[fr];
#pragma unroll
        for (int j = 0; j < 4; ++j) { const float u = acc[j] + bb; logf[(size_t)(job * 16 + fq * 4 + j) * 16 + fr] = -(fmaxf(-u, 0.f) + log1pf(__expf(-fabsf(u)))); }
    }
}

__device__ __forceinline__ void fox_prep_phase(bf16_t* __restrict__ qk  , const float* __restrict__ qg, const float* __restrict__ kg, const float* __restrict__ logf, float* __restrict__ cf) {
    const int tid = opq(threadIdx.x), lane = tid & 63, gw = blockIdx.x * 8 + (tid >> 6), nw = gridDim.x * 8;
    const int sub = lane >> 4, l16 = lane & 15;
    const int nrows = 2 * NTOK * NH;
    for (int r0 = gw * 4; r0 < nrows; r0 += nw * 4) {
        const int row = r0 + sub; const bool isk = row >= NTOK * NH;
        bf16_t* p = qk + (size_t)row * HD + l16 * 8;
        const u32x4 w = *(const u32x4*)p; float v[8] = {bflo(w.x), bfhi(w.x), bflo(w.y), bfhi(w.y), bflo(w.z), bfhi(w.z), bflo(w.w), bfhi(w.w)};
        float ss = 0.f;
#pragma unroll
        for (int i = 0; i < 8; ++i) ss += v[i] * v[i];
        ss = sum16(ss); const float rs = rsqrtf(ss * (1.f / HD) + EPS);
        const float* gp = (isk ? kg : qg) + l16 * 8; const f32x4 g0 = *(const f32x4*)gp, g1 = *(const f32x4*)(gp + 4);
        u32x4 o; o.x = cvtpk(v[0] * rs * g0[0], v[1] * rs * g0[1]); o.y = cvtpk(v[2] * rs * g0[2], v[3] * rs * g0[3]);
        o.z = cvtpk(v[4] * rs * g1[0], v[5] * rs * g1[1]); o.w = cvtpk(v[6] * rs * g1[2], v[7] * rs * g1[3]);
        *(u32x4*)p = o;
    }
    for (int bh = blockIdx.x; bh < 64; bh += gridDim.x) {
        if ((threadIdx.x >> 6) != 0) continue;
        const int b = bh >> 4, hd = bh & 15; const float* lp = logf + (size_t)(b * SEQ + lane * 32) * 16 + hd;
        float v[32]; float tot = 0.f;
#pragma unroll
        for (int i = 0; i < 32; ++i) { tot += lp[(size_t)i * 16]; v[i] = tot; }
        float inc = tot;
#pragma unroll
        for (int o = 1; o < 64; o <<= 1) { const float up = __shfl_up(inc, o); if (lane >= o) inc += up; }
        const float base = inc - tot;
        float* cp = cf + (size_t)bh * SEQ + lane * 32;
#pragma unroll
        for (int i = 0; i < 32; ++i) cp[i] = base + v[i];
    }
}

__device__ __forceinline__ void mla_prep1_phase(const bf16_t* __restrict__ down, const int* __restrict__ pos, const float* __restrict__ qn, const float* __restrict__ kvn,
                                                bf16_t* __restrict__ cq, bf16_t* __restrict__ ckv, float* __restrict__ ropet, float* __restrict__ kr) {
    const int tid = opq(threadIdx.x), lane = tid & 63, gw = blockIdx.x * 8 + (tid >> 6), nw = gridDim.x * 8;
    for (int row = gw; row < NTOK; row += nw) {
        const bf16_t* dr = down + (size_t)row * MLA_DOWN_PAD;
        {   float v[12]; float ss = 0.f;
#pragma unroll
            for (int j = 0; j < 3; ++j) { const u32x2 w = *(const u32x2*)(dr + j * 256 + lane * 4); v[4 * j] = bflo(w.x); v[4 * j + 1] = bfhi(w.x); v[4 * j + 2] = bflo(w.y); v[4 * j + 3] = bfhi(w.y); }
#pragma unroll
            for (int i = 0; i < 12; ++i) ss += v[i] * v[i];
            ss = wave_sum(ss); const float rs = rsqrtf(ss * (1.f / MLA_QR) + EPS);
#pragma unroll
            for (int j = 0; j < 3; ++j) { const f32x4 g = *(const f32x4*)(qn + j * 256 + lane * 4);
                u32x2 w; w.x = cvtpk(v[4 * j] * rs * g[0], v[4 * j + 1] * rs * g[1]); w.y = cvtpk(v[4 * j + 2] * rs * g[2], v[4 * j + 3] * rs * g[3]);
                *(u32x2*)(cq + (size_t)row * MLA_QR + j * 256 + lane * 4) = w; } }
        {   float v[8]; float ss = 0.f;
#pragma unroll
            for (int j = 0; j < 2; ++j) { const u32x2 w = *(const u32x2*)(dr + MLA_QR + j * 256 + lane * 4); v[4 * j] = bflo(w.x); v[4 * j + 1] = bfhi(w.x); v[4 * j + 2] = bflo(w.y); v[4 * j + 3] = bfhi(w.y); }
#pragma unroll
            for (int i = 0; i < 8; ++i) ss += v[i] * v[i];
            ss = wave_sum(ss); const float rs = rsqrtf(ss * (1.f / MLA_KVR) + EPS);
#pragma unroll
            for (int j = 0; j < 2; ++j) { const f32x4 g = *(const f32x4*)(kvn + j * 256 + lane * 4);
                u32x2 w; w.x = cvtpk(v[4 * j] * rs * g[0], v[4 * j + 1] * rs * g[1]); w.y = cvtpk(v[4 * j + 2] * rs * g[2], v[4 * j + 3] * rs * g[3]);
                *(u32x2*)(ckv + (size_t)row * MLA_KVR + j * 256 + lane * 4) = w; } }
        if (lane < 32) {
            const float invf = powf(10000.0f, -(float)(2 * lane) / 64.0f);
            const float ang = (float)pos[row] * invf; const float cs = cosf(ang), sn = sinf(ang);
            ropet[(size_t)row * 64 + lane] = cs; ropet[(size_t)row * 64 + 32 + lane] = sn;
            const float x1 = __uint_as_float((unsigned)dr[MLA_QR + MLA_KVR + lane] << 16), x2 = __uint_as_float((unsigned)dr[MLA_QR + MLA_KVR + 32 + lane] << 16);
            kr[(size_t)row * 64 + lane] = x1 * cs - x2 * sn; kr[(size_t)row * 64 + 32 + lane] = x1 * sn + x2 * cs;
        }
    }
}

__device__ __forceinline__ void mla_prep2_phase(const bf16_t* __restrict__ qup, const bf16_t* __restrict__ kv, const float* __restrict__ ropet, const float* __restrict__ kr,
                                                const float* __restrict__ qg, const float* __restrict__ kg, bf16_t* __restrict__ Qn, bf16_t* __restrict__ Kn) {
    const int tid = opq(threadIdx.x), lane = tid & 63, gw = blockIdx.x * 8 + (tid >> 6), nw = gridDim.x * 8;
    const int sub = lane >> 4, j = lane & 15;
    const int nrows = 2 * NTOK * NH;
    for (int r0 = gw * 4; r0 < nrows; r0 += nw * 4) {
        int row = r0 + sub; const bool isk = row >= NTOK * NH; if (isk) row -= NTOK * NH;
        const int tok = row >> 4, hd = row & 15;
        float v[8], ra[2], rb[2];
        if (!isk) {
            const bf16_t* p = qup + (size_t)tok * 3072 + hd * 192;
            const u32x4 w = *(const u32x4*)(p + j * 8);
            v[0] = bflo(w.x); v[1] = bfhi(w.x); v[2] = bflo(w.y); v[3] = bfhi(w.y); v[4] = bflo(w.z); v[5] = bfhi(w.z); v[6] = bflo(w.w); v[7] = bfhi(w.w);
            const unsigned w1 = *(const unsigned*)(p + 128 + 2 * j), w2 = *(const unsigned*)(p + 160 + 2 * j);
            const float x1a = bflo(w1), x1b = bfhi(w1), x2a = bflo(w2), x2b = bfhi(w2);
            const float* rt = ropet + (size_t)tok * 64; const float c0 = rt[2 * j], c1 = rt[2 * j + 1], s0 = rt[32 + 2 * j], s1 = rt[32 + 2 * j + 1];
            ra[0] = x1a * c0 - x2a * s0; ra[1] = x1b * c1 - x2b * s1; rb[0] = x1a * s0 + x2a * c0; rb[1] = x1b * s1 + x2b * c1;
        } else {
            const bf16_t* p = kv + (size_t)tok * 4096 + hd * 256;
            const u32x4 w = *(const u32x4*)(p + j * 8);
            v[0] = bflo(w.x); v[1] = bfhi(w.x); v[2] = bflo(w.y); v[3] = bfhi(w.y); v[4] = bflo(w.z); v[5] = bfhi(w.z); v[6] = bflo(w.w); v[7] = bfhi(w.w);
            const float* kp = kr + (size_t)tok * 64; ra[0] = kp[2 * j]; ra[1] = kp[2 * j + 1]; rb[0] = kp[32 + 2 * j]; rb[1] = kp[32 + 2 * j + 1];
        }
        float ss = ra[0] * ra[0] + ra[1] * ra[1] + rb[0] * rb[0] + rb[1] * rb[1];
#pragma unroll
        for (int i = 0; i < 8; ++i) ss += v[i] * v[i];
        ss = sum16(ss); const float rs = rsqrtf(ss * (1.f / MLA_QK) + EPS);
        const float* g = isk ? kg : qg; const f32x4 g0 = *(const f32x4*)(g + j * 8), g1 = *(const f32x4*)(g + j * 8 + 4);
        bf16_t* o = (isk ? Kn : Qn) + (size_t)tok * 3072 + hd * 192;
        u32x4 ow; ow.x = cvtpk(v[0] * rs * g0[0], v[1] * rs * g0[1]); ow.y = cvtpk(v[2] * rs * g0[2], v[3] * rs * g0[3]);
        ow.z = cvtpk(v[4] * rs * g1[0], v[5] * rs * g1[1]); ow.w = cvtpk(v[6] * rs * g1[2], v[7] * rs * g1[3]);
        *(u32x4*)(o + j * 8) = ow;
        *(unsigned*)(o + 128 + 2 * j) = cvtpk(ra[0] * rs * g[128 + 2 * j], ra[1] * rs * g[128 + 2 * j + 1]);
        *(unsigned*)(o + 160 + 2 * j) = cvtpk(rb[0] * rs * g[160 + 2 * j], rb[1] * rs * g[160 + 2 * j + 1]);
    }
}

__device__ __forceinline__ int v_st(int k, int c) { const int kk = (k & ~0xC) | ((k & 4) << 1) | ((k & 8) >> 1); return ((kk >> 3) * 4 + (c >> 5)) * 512 + ((kk & 7) * 32 + (c & 31)) * 2; }
__device__ __forceinline__ int v_rd_base(int lane) { return ((lane & 3) << 3) | (((lane >> 2) & 3) << 6) | (((lane >> 4) & 1) << 5) | (((lane >> 5) & 1) << 8); }
constexpr int v_rd_off(int d0, int ks, int half) { return d0 * 512 + ks * 4096 + half * 2048; }
__device__ __forceinline__ int crow(int r, int hi) { return (r & 3) + 8 * (r >> 2) + 4 * hi; }

constexpr int AT_SHM_V = 16384, AT_KBUF = 24576;
constexpr int AT_OFF_K = 2 * AT_SHM_V, AT_OFF_WS = AT_OFF_K + 2 * AT_KBUF, AT_OFF_CF = AT_OFF_WS + 2048;

#ifdef TESTB
#define SB_LG(y) fmaxf(1.f - 0.5f * fabsf(y), 0.f)
#else
#define SB_LG(y) __builtin_amdgcn_logf(1.f + __builtin_amdgcn_exp2f(-fabsf(y)))
#endif
#ifndef SB_BLOCK_EXIT
#define SB_BLOCK_EXIT 0
#endif
template <int DQK, int MODE>
__device__ __forceinline__ void attn_block(const bf16_t* __restrict__ Qg, int ldq, const bf16_t* __restrict__ Kg, int ldk, const bf16_t* __restrict__ Vg, int ldv,
                                           bf16_t* __restrict__ Og, int ldo, int q0, float C2, LAS unsigned char* lds) {
    constexpr int NQ = DQK / 16, ROWB = DQK * 2, SHM_K = 64 * ROWB, NCH = DQK / 8, KCH = NCH / 8;
    const int tid = opq(threadIdx.x), wid = __builtin_amdgcn_readfirstlane(tid >> 6), lane = tid & 63, r32 = lane & 31, hi = lane >> 5;
    LAS unsigned char* V_lds = lds; LAS unsigned char* K_lds = lds + AT_OFF_K;
    LAS float* li_l = (LAS float*)(lds + AT_OFF_WS) + wid * 64; LAS float* al_l = li_l + 32;
    const LAS float* cfl = (const LAS float*)(lds + AT_OFF_CF);
    const int qlo = q0 + wid * 32, trow = qlo + r32;
    bf16x8 qr[NQ];
#pragma unroll
    for (int d0 = 0; d0 < NQ; ++d0) qr[d0] = *(const bf16x8*)(Qg + (size_t)trow * ldq + d0 * 16 + hi * 8);
    const int NT = q0 / 64 + 4;
    int kso[KCH], vso[2];
#pragma unroll
    for (int i = 0; i < KCH; ++i) { const int L = (i * 8 + wid) * 1024 + lane * 16, row = L / ROWB, wi = L % ROWB; kso[i] = row * ldk + ((wi ^ ((row & 7) << 4)) >> 1); }
#pragma unroll
    for (int i = 0; i < 2; ++i) { const int L = (i * 8 + wid) * 1024 + lane * 16, sub = L >> 9, we = (L & 511) >> 1, kk = (sub >> 2) * 8 + (we >> 5), c = (sub & 3) * 32 + (we & 31);
        const int k = (kk & ~0xC) | ((kk & 4) << 1) | ((kk & 8) >> 1); vso[i] = k * ldv + c; }
#define AT_DMA(kb_, buf_) do { const bf16_t* kp_ = Kg + (size_t)(kb_) * ldk; const bf16_t* vp_ = Vg + (size_t)(kb_) * ldv; \
        _Pragma("unroll") for (int i_ = 0; i_ < KCH; ++i_) __builtin_amdgcn_global_load_lds((const unsigned*)(kp_ + kso[i_]), (LAS unsigned*)(K_lds + (buf_) * SHM_K + (i_ * 8 + wid) * 1024), 16, 0, 0); \
        _Pragma("unroll") for (int i_ = 0; i_ < 2; ++i_) __builtin_amdgcn_global_load_lds((const unsigned*)(vp_ + vso[i_]), (LAS unsigned*)(V_lds + (buf_) * AT_SHM_V + (i_ * 8 + wid) * 1024), 16, 0, 0); } while (0)
#if ATT_DMA
    AT_DMA((NT - 1) * 64, 0);
    asm volatile("s_waitcnt vmcnt(0)" ::: "memory");
    __syncthreads();
#else
    bf16x8 stk[KCH], stv[2];
    const int vk = tid >> 4, vc = (tid & 15) * 8;
#define AT_LOAD(kb_) do { _Pragma("unroll") for (int i_ = 0; i_ < KCH; ++i_) { const int c_ = tid + 512 * i_, row_ = c_ / NCH, cc_ = c_ % NCH; stk[i_] = *(const bf16x8*)(Kg + (size_t)((kb_) + row_) * ldk + cc_ * 8); } \
        _Pragma("unroll") for (int i_ = 0; i_ < 2; ++i_) stv[i_] = *(const bf16x8*)(Vg + (size_t)((kb_) + vk + 32 * i_) * ldv + vc); } while (0)
#define AT_WRITE(buf_) do { _Pragma("unroll") for (int i_ = 0; i_ < KCH; ++i_) { const int c_ = tid + 512 * i_, row_ = c_ / NCH, cc_ = c_ % NCH; \
            *(LAS bf16x8*)(K_lds + (buf_) * SHM_K + row_ * ROWB + ((cc_ * 16) ^ ((row_ & 7) << 4))) = stk[i_]; } \
        _Pragma("unroll") for (int i_ = 0; i_ < 2; ++i_) *(LAS bf16x8*)(V_lds + (buf_) * AT_SHM_V + v_st(vk + 32 * i_, vc)) = stv[i_]; } while (0)
    AT_LOAD((NT - 1) * 64); AT_WRITE(0);
    if (NT > 1) AT_LOAD((NT - 2) * 64);
    __syncthreads();
#endif
    f32x16 o[4];
#pragma unroll
    for (int d = 0; d < 4; ++d)
#pragma unroll
        for (int r = 0; r < 16; ++r) o[d][r] = 0.f;
    float m_reg = -1e30f, l_reg = 0.f, carry = (MODE == 0) ? 1.f : 0.f;
    float cft = 0.f; if (MODE == 1) cft = cfl[trow];
    int koff[4];
#pragma unroll
    for (int dd = 0; dd < 4; ++dd) koff[dd] = r32 * ROWB + ((dd * 32 + hi * 16) ^ ((r32 & 7) << 4));
    const int vbase = (int)(uintptr_t)V_lds + v_rd_base(lane);
    bool wdone = false;
    LAS unsigned* dflag = (LAS unsigned*)(lds + AT_OFF_CF);
    for (int it = 0; it < NT; ++it) {
        const int kb = (NT - 1 - it) * 64, cur = it & 1;
        bool alld = false;
        if (MODE == 0 && it > 0) {
            const LAS unsigned* fp = dflag + ((it - 1) & 1) * 8; const u32x4 f0 = *(const LAS u32x4*)fp, f1 = *(const LAS u32x4*)(fp + 4);
            alld = __builtin_amdgcn_readfirstlane(f0.x & f0.y & f0.z & f0.w & f1.x & f1.y & f1.z & f1.w) != 0u;
        }
        const bool act = (kb <= qlo + 31) && !wdone;
#if ATT_DMA
        if (it + 1 < NT && !alld) AT_DMA(kb - 64, cur ^ 1);
#endif
        if (act) {
            f32x16 p0, p1;
#pragma unroll
            for (int r = 0; r < 16; ++r) { p0[r] = 0.f; p1[r] = 0.f; }
            const LAS unsigned char* kbase = K_lds + cur * SHM_K;
#pragma unroll
            for (int dg = 0; dg < NQ / 4; ++dg) {
                bf16x8 kf0[4], kf1[4];
#pragma unroll
                for (int dd = 0; dd < 4; ++dd) { const LAS unsigned char* a = kbase + koff[dd] + dg * 128; kf0[dd] = *(const LAS bf16x8*)a; kf1[dd] = *(const LAS bf16x8*)(a + 32 * ROWB); }
#pragma unroll
                for (int dd = 0; dd < 4; ++dd) { p0 = __builtin_amdgcn_mfma_f32_32x32x16_bf16(kf0[dd], qr[dg * 4 + dd], p0, 0, 0, 0); p1 = __builtin_amdgcn_mfma_f32_32x32x16_bf16(kf1[dd], qr[dg * 4 + dd], p1, 0, 0, 0); }
                __builtin_amdgcn_sched_barrier(0);
            }
            const int dq = trow - kb - 4 * hi;
            if (MODE == 0) {
                const bool needm = kb + 63 >= qlo;
                f32x16 kA, kB;
#pragma unroll
                for (int r = 0; r < 16; ++r) { p0[r] = fminf(p0[r] * C2, 80.f); p1[r] = fminf(p1[r] * C2, 80.f); }
#pragma unroll
                for (int r = 0; r < 16; ++r) { p0[r] = __builtin_amdgcn_exp2f(p0[r]); p1[r] = __builtin_amdgcn_exp2f(p1[r]); }
                __builtin_amdgcn_sched_barrier(0);
#pragma unroll
                for (int r = 0; r < 16; ++r) { kA[r] = 1.f + p0[r]; kB[r] = 1.f + p1[r]; }
                __builtin_amdgcn_sched_barrier(0);
#pragma unroll
                for (int r = 0; r < 16; ++r) { kA[r] = __builtin_amdgcn_rcpf(kA[r]); kB[r] = __builtin_amdgcn_rcpf(kB[r]); }
                __builtin_amdgcn_sched_barrier(0);
#pragma unroll
                for (int r = 0; r < 16; ++r) { p0[r] *= kA[r]; p1[r] *= kB[r]; }
                if (needm) {
#pragma unroll
                    for (int r = 0; r < 16; ++r) { const int c = (r & 3) + 8 * (r >> 2);
                        if (!(c < dq)) { kA[r] = 1.f; p0[r] = 0.f; } if (!(c + 32 < dq)) { kB[r] = 1.f; p1[r] = 0.f; } }
                }
                __builtin_amdgcn_sched_barrier(0);
                float run = carry;
#pragma unroll
                for (int g = 7; g >= 0; --g) {
                    const float gp = (g < 4) ? (kA[4 * g] * kA[4 * g + 1]) * (kA[4 * g + 2] * kA[4 * g + 3]) : (kB[4 * (g - 4)] * kB[4 * (g - 4) + 1]) * (kB[4 * (g - 4) + 2] * kB[4 * (g - 4) + 3]);
                    auto rr = __builtin_amdgcn_permlane32_swap(__float_as_uint(gp), __float_as_uint(gp), false, false);
                    const float e = __uint_as_float(rr[0]), od = __uint_as_float(rr[1]);
                    const float base = hi ? run : run * od;
                    if (g < 4) { const int b = 4 * g; const float l3 = base, l2 = l3 * kA[b + 3], l1 = l2 * kA[b + 2], l0 = l1 * kA[b + 1];
                        p0[b] *= l0; p0[b + 1] *= l1; p0[b + 2] *= l2; p0[b + 3] *= l3; }
                    else { const int b = 4 * (g - 4); const float l3 = base, l2 = l3 * kB[b + 3], l1 = l2 * kB[b + 2], l0 = l1 * kB[b + 1];
                        p1[b] *= l0; p1[b + 1] *= l1; p1[b + 2] *= l2; p1[b + 3] *= l3; }
                    run *= e * od;
                }
                carry = run;
                __builtin_amdgcn_sched_barrier(0);
            } else {
                if (MODE == 1) {
#pragma unroll
                    for (int g = 0; g < 4; ++g) { const f32x4 c0 = *(const LAS f32x4*)(cfl + kb + 8 * g + 4 * hi), c1 = *(const LAS f32x4*)(cfl + kb + 32 + 8 * g + 4 * hi);
#pragma unroll
                        for (int i = 0; i < 4; ++i) { p0[4 * g + i] = fmaf(p0[4 * g + i], C2, cft - c0[i]); p1[4 * g + i] = fmaf(p1[4 * g + i], C2, cft - c1[i]); } }
                } else {
#pragma unroll
                    for (int r = 0; r < 16; ++r) { p0[r] *= C2; p1[r] *= C2; }
                }
                if (kb + 63 > qlo) {
#pragma unroll
                    for (int r = 0; r < 16; ++r) { const int c = (r & 3) + 8 * (r >> 2); if (!(c <= dq)) p0[r] = -__builtin_inff(); if (!(c + 32 <= dq)) p1[r] = -__builtin_inff(); }
                }
                float pmax = p0[0];
#pragma unroll
                for (int r = 1; r < 16; ++r) pmax = fmaxf(pmax, p0[r]);
#pragma unroll
                for (int r = 0; r < 16; ++r) pmax = fmaxf(pmax, p1[r]);
                { auto rr = __builtin_amdgcn_permlane32_swap(__float_as_uint(pmax), __float_as_uint(pmax), false, false); pmax = fmaxf(__uint_as_float(rr[0]), __uint_as_float(rr[1])); }
                const float mn = fmaxf(m_reg, pmax); const float alpha = __builtin_amdgcn_exp2f(m_reg - mn); m_reg = mn;
                float ps = 0.f;
#pragma unroll
                for (int r = 0; r < 16; ++r) { p0[r] = __builtin_amdgcn_exp2f(p0[r] - mn); p1[r] = __builtin_amdgcn_exp2f(p1[r] - mn); ps += p0[r] + p1[r]; }
                { auto rr = __builtin_amdgcn_permlane32_swap(__float_as_uint(ps), __float_as_uint(ps), false, false); ps = __uint_as_float(rr[0]) + __uint_as_float(rr[1]); }
                l_reg = l_reg * alpha + ps;
                if (__any(alpha < 1.f)) {
                    if (hi == 0) al_l[r32] = alpha;
                    asm volatile("s_waitcnt lgkmcnt(0)" ::: "memory");
#pragma unroll
                    for (int g = 0; g < 4; ++g) { const f32x4 av = *(const LAS f32x4*)(al_l + 8 * g + 4 * hi);
#pragma unroll
                        for (int d = 0; d < 4; ++d)
#pragma unroll
                            for (int i = 0; i < 4; ++i) o[d][4 * g + i] *= av[i]; }
                }
            }
            bf16x8 pa0, pa1, pa2, pa3;
#define PK4(P, B_, OUT) do { unsigned a0 = cvtpk(P[B_+0], P[B_+1]), a1 = cvtpk(P[B_+2], P[B_+3]); unsigned b0 = cvtpk(P[B_+4], P[B_+5]), b1 = cvtpk(P[B_+6], P[B_+7]); \
        auto r0 = __builtin_amdgcn_permlane32_swap(a0, b0, false, false); auto r1 = __builtin_amdgcn_permlane32_swap(a1, b1, false, false); \
        u32x4 w = {r0[0], r1[0], r0[1], r1[1]}; OUT = *reinterpret_cast<bf16x8*>(&w); } while (0)
            PK4(p0, 0, pa0); PK4(p0, 8, pa1); PK4(p1, 0, pa2); PK4(p1, 8, pa3);
#undef PK4
            const int vb0 = vbase + cur * AT_SHM_V;
#define TRRD(dst, off) asm volatile("ds_read_b64_tr_b16 %0, %1 offset:%2" : "=&v"(dst) : "v"(vb0), "i"(off) : "memory")
#define PV_D0(d0) do { s16x4 l0, l1, l2, l3, h0, h1, h2, h3; constexpr int b_ = v_rd_off(d0, 0, 0); \
        TRRD(l0, b_); TRRD(h0, b_ + 2048); TRRD(l1, b_ + 4096); TRRD(h1, b_ + 6144); TRRD(l2, b_ + 8192); TRRD(h2, b_ + 10240); TRRD(l3, b_ + 12288); TRRD(h3, b_ + 14336); \
        asm volatile("s_waitcnt lgkmcnt(0)" ::: "memory"); __builtin_amdgcn_sched_barrier(0); \
        o[d0] = __builtin_amdgcn_mfma_f32_32x32x16_bf16(pa0, (bf16x8){l0[0], l0[1], l0[2], l0[3], h0[0], h0[1], h0[2], h0[3]}, o[d0], 0, 0, 0); \
        o[d0] = __builtin_amdgcn_mfma_f32_32x32x16_bf16(pa1, (bf16x8){l1[0], l1[1], l1[2], l1[3], h1[0], h1[1], h1[2], h1[3]}, o[d0], 0, 0, 0); \
        o[d0] = __builtin_amdgcn_mfma_f32_32x32x16_bf16(pa2, (bf16x8){l2[0], l2[1], l2[2], l2[3], h2[0], h2[1], h2[2], h2[3]}, o[d0], 0, 0, 0); \
        o[d0] = __builtin_amdgcn_mfma_f32_32x32x16_bf16(pa3, (bf16x8){l3[0], l3[1], l3[2], l3[3], h3[0], h3[1], h3[2], h3[3]}, o[d0], 0, 0, 0); } while (0)
            PV_D0(0); PV_D0(1); PV_D0(2); PV_D0(3);
#undef PV_D0
#undef TRRD
        }
        if (MODE == 0) { if (kb <= qlo + 31) wdone = __all(carry < 1e-37f) != 0; if (lane == 0) dflag[(it & 1) * 8 + wid] = wdone ? 1u : 0u; }
#if ATT_DMA
        asm volatile("s_waitcnt vmcnt(0)" ::: "memory");
#else
        if (it + 1 < NT) { AT_WRITE(cur ^ 1); if (it + 2 < NT) AT_LOAD((NT - 3 - it) * 64); }
#endif
        __syncthreads();
    }
#undef AT_DMA
    float rli[16];
    if (MODE != 0) {
        if (hi == 0) li_l[r32] = l_reg;
        asm volatile("s_waitcnt lgkmcnt(0)" ::: "memory");
#pragma unroll
        for (int g = 0; g < 4; ++g) { const f32x4 lv = *(const LAS f32x4*)(li_l + 8 * g + 4 * hi);
#pragma unroll
            for (int i = 0; i < 4; ++i) rli[4 * g + i] = 1.0f / lv[i]; }
    } else {
#pragma unroll
        for (int r = 0; r < 16; ++r) rli[r] = 1.f;
    }
    bf16_t* Ow = Og + (size_t)qlo * ldo;
#pragma unroll
    for (int r = 0; r < 16; ++r) { const int orow = crow(r, hi);
#pragma unroll
        for (int d0 = 0; d0 < 4; ++d0) { const float v = o[d0][r] * rli[r]; const float vn = __shfl_xor(v, 1);
            if ((r32 & 1) == 0) *(unsigned*)(Ow + (size_t)orow * ldo + d0 * 32 + r32) = cvtpk(v, vn); } }
}

template <int DQK, int MODE>
__device__ __forceinline__ void attn_phase(const bf16_t* Qb, int ldq, int hq, const bf16_t* Kb, int ldk, int hk, const bf16_t* Vb, int ldv, int hv, bf16_t* Ob, const float* cf, float C2, LAS unsigned char* lds) {
#ifdef TESTCOPY
    if (MODE == 0) {
        for (size_t i = (size_t)blockIdx.x * 512 + threadIdx.x; i < (size_t)NTOK * DM; i += (size_t)gridDim.x * 512) {
            const float a = __uint_as_float((unsigned)Qb[i] << 16) + __uint_as_float((unsigned)Kb[i] << 16) + __uint_as_float((unsigned)Vb[i] << 16);
            Ob[i] = (bf16_t)(__float_as_uint(sinf(300.f * a)) >> 16); }
        return;
    }
#endif
#ifdef TESTNAN
    for (int i = threadIdx.x; i < LDS_BYTES / 4; i += 512) ((LAS unsigned*)lds)[i] = 0xFFFFFFFFu;
    __syncthreads();
#endif
    for (int w = blockIdx.x; w < 256; w += gridDim.x) {
        const int xcd = w & 7, slot = w >> 3, bh = xcd * 8 + (slot >> 2), y = slot & 3, b = bh >> 4, hd = bh & 15;
        if (MODE == 1) { LAS float* cfl = (LAS float*)(lds + AT_OFF_CF);
            for (int s = threadIdx.x; s < SEQ; s += 512) cfl[s] = cf[(size_t)bh * SEQ + s] * LOG2E;
            __syncthreads(); }
        const bf16_t* Q = Qb + (size_t)b * SEQ * ldq + hd * hq; const bf16_t* K = Kb + (size_t)b * SEQ * ldk + hd * hk; const bf16_t* V = Vb + (size_t)b * SEQ * ldv + hd * hv;
        bf16_t* O = Ob + (size_t)b * SEQ * DM + hd * HD;
        attn_block<DQK, MODE>(Q, ldq, K, ldk, V, ldv, O, DM, (7 - y) * 256, C2, lds);
        attn_block<DQK, MODE>(Q, ldq, K, ldk, V, ldv, O, DM, y * 256, C2, lds);
        __syncthreads();
    }
}

#define XB_TMO      128
#define XB_XCNT(j)  (256  + 64 * (j))
#define XB_XSUB(j)  (1280 + 64 * (j))
#define XB_XGEN(j)  (2304 + 64 * (j))
#define XB_TOP      3328
#define XB_TOPGEN   3392
#define XCD_BAR_WORDS 3456
#define XB_SPIN_CAP (1u << 18)
__device__ __forceinline__ unsigned xb_ld(unsigned* p)              { return __hip_atomic_load(p, __ATOMIC_RELAXED, __HIP_MEMORY_SCOPE_AGENT); }
__device__ __forceinline__ unsigned xb_add(unsigned* p, unsigned v) { return __hip_atomic_fetch_add(p, v, __ATOMIC_RELAXED, __HIP_MEMORY_SCOPE_AGENT); }
__device__ __forceinline__ unsigned xb_xcc_id() { return (unsigned)__builtin_amdgcn_s_getreg((3 << 11) | 20) & 0xFu; }
#define XB_SPIN(cond, bar) do { unsigned _sp = 0; while (cond) { __builtin_amdgcn_s_sleep(1); \
    if ((++_sp & 255u) == 0u) { if (xb_ld(&(bar)[XB_TMO])) break; if (_sp > XB_SPIN_CAP) { atomicAdd(&(bar)[XB_TMO], 1u); break; } } } } while (0)
struct XcdBarrier { unsigned* bar; unsigned x; volatile LAS unsigned* st; };
__device__ __forceinline__ XcdBarrier xcd_barrier_post(unsigned* bar, volatile LAS unsigned* st) {
    XcdBarrier b; b.bar = bar; b.x = xb_xcc_id(); b.st = st;
    if (threadIdx.x == 0) (void)xb_add(&bar[XB_XCNT(b.x)], 1u);
    return b;
}
__device__ __forceinline__ void xcd_barrier_complete(unsigned* bar, unsigned x, unsigned& nloc, unsigned& nx) {
    const unsigned G = gridDim.x * gridDim.y * gridDim.z;
    unsigned sum, cnt, mine, sp = 0u;
    for (;;) {
        sum = 0u; cnt = 0u; mine = 0u;
#pragma unroll
        for (unsigned j = 0; j < 16; ++j) { const unsigned c = xb_ld(&bar[XB_XCNT(j)]); sum += c; cnt += (c > 0u) ? 1u : 0u; mine = (j == x) ? c : mine; }
        if (sum == G) break;
        __builtin_amdgcn_s_sleep(1);
        if ((++sp & 255u) == 0u) { if (xb_ld(&bar[XB_TMO])) break; if (sp > XB_SPIN_CAP) { atomicAdd(&bar[XB_TMO], 1u); break; } }
    }
    nloc = mine > 0u ? mine : 1u; nx = cnt > 0u ? cnt : 1u;
}
__device__ __forceinline__ void xcd_barrier(const XcdBarrier& b) {
    asm volatile("s_waitcnt vmcnt(0)" ::: "memory");
    __syncthreads();
    if (threadIdx.x == 0) {
        unsigned* bar = b.bar;
        __builtin_amdgcn_s_waitcnt(0);
        unsigned nloc = b.st[0], nx = b.st[1];
        if (nloc == 0u) { xcd_barrier_complete(bar, b.x, nloc, nx); b.st[0] = nloc; b.st[1] = nx; }
        const unsigned old = xb_add(&bar[XB_XSUB(b.x)], 1u);
        const unsigned gen = old / nloc;
        if (old + 1u == (gen + 1u) * nloc) {
            __builtin_amdgcn_fence(__ATOMIC_RELEASE, "agent");
            asm volatile("s_waitcnt vmcnt(0)" ::: "memory");
            const unsigned og = xb_add(&bar[XB_TOP], 1u);
            const unsigned tg = og / nx;
            if (og + 1u == (tg + 1u) * nx) xb_add(&bar[XB_TOPGEN], 1u);
            else XB_SPIN(xb_ld(&bar[XB_TOPGEN]) == tg, bar);
            __builtin_amdgcn_fence(__ATOMIC_ACQUIRE, "agent");
            xb_add(&bar[XB_XGEN(b.x)], 1u);
            asm volatile("s_waitcnt vmcnt(0)" ::: "memory");
        } else {
            XB_SPIN(xb_ld(&bar[XB_XGEN(b.x)]) == gen, bar);
            __builtin_amdgcn_fence(__ATOMIC_ACQUIRE, "agent");
            asm volatile("s_waitcnt vmcnt(0)" ::: "memory");
        }
    }
    __syncthreads();
}

#ifndef NLAYERS
#define NLAYERS 4
#endif
constexpr int N_PHASES = 1 + 10 * NLAYERS;
__host__ __device__ inline bool phase_active(int ph) {
    if (ph == 0) return false;
    const int layer = (ph - 1) / 10, s = (ph - 1) % 10, kind = layer % 3;
    if (s == 2) return kind != 0;
    if (s == 3 || s == 4) return kind == 2;
    return true;
}

__global__ void __launch_bounds__(512, 2) fwd_megakernel(Params p) {
    extern __shared__ __attribute__((aligned(16))) unsigned char shm_raw[];
    LAS unsigned char* lds = (LAS unsigned char*)shm_raw;
    unsigned char* ws = p.ws;
    bf16_t* X = (bf16_t*)(ws + WS_X);
    bf16_t* H = (bf16_t*)(ws + WS_H); bf16_t* AO = p.alt ? (bf16_t*)(ws + WS_SCR + (size_t)NTOK * DFF * 2) : (bf16_t*)(ws + WS_AO);
    float* LOGF = (float*)(ws + WS_LOGF); float* CF = (float*)(ws + WS_CF); float* ROPE = (float*)(ws + WS_ROPE); float* KR = (float*)(ws + WS_KR);
    unsigned char* scr = ws + WS_SCR;
    bool first = true;
#if COOP
    volatile LAS unsigned* st = (volatile LAS unsigned*)(lds + 131072);
    if (threadIdx.x == 0) { st[0] = 0u; st[1] = 0u; }
    __syncthreads();
    const XcdBarrier xb = xcd_barrier_post((unsigned*)(ws + WS_BAR), st);
    int nsync = 0;
#endif
    for (int ph = (int)p.ph_lo; ph < (int)p.ph_hi; ++ph) {
        if (!phase_active(ph)) continue;
#if COOP
        if (!first) { if (nsync == 0) cg::this_grid().sync(); else xcd_barrier(xb); ++nsync; }
#endif
        first = false;
        const int layer = (ph - 1) / 10, s = (ph - 1) % 10, kind = layer % 3, j = layer / 3;
        const void* xin = (layer == 0) ? (const void*)p.x : (const void*)X;
        const int xin_f32 = layer == 0;
        int ng = 0; GemmJob g0{}, g1{}; bool do_fgate = false;
        g0.M = NTOK; g1.M = NTOK;
        if (s == 0 || s == 7) {
            if (s == 0 && EN(100)) {
                if (kind == 0) conv_job(lds, p.sb_w_in + (size_t)j * 2048 * 6144, 6144, 0, 6144, 6144, 2048, (bf16_t*)(ws + W_SB_IN + j * SZ_QKVW));
                else if (kind == 1) { conv_job(lds, p.fox_w_in, 6160, 0, 6144, 6144, 2048, (bf16_t*)(ws + W_FOX_IN)); conv_job(lds, p.fox_w_in, 6160, 6144, 16, 128, 2048, (bf16_t*)(ws + W_FOX_F)); }
                else conv_job(lds, p.mla_w_in, MLA_DOWN, 0, MLA_DOWN, MLA_DOWN_PAD, 2048, (bf16_t*)(ws + W_MLA_IN));
            }
            if (s == 7 && EN(100)) conv_job(lds, p.mlp_w1 + (size_t)layer * 2048 * 8192, 8192, 0, 8192, 8192, 2048, (bf16_t*)(ws + W_W1 + layer * SZ_FFW));
            if (EN(0)) rmsnorm_phase(s == 0 ? xin : (const void*)X, s == 0 && xin_f32, (s == 0 ? p.mix_norm : p.mlp_norm) + layer * DM, H);
        }
        else if (s == 1) {
            ng = 1; g0.A = H; g0.K = DM;
            if (kind == 2) { g0.Bt = (const bf16_t*)(ws + W_MLA_IN); g0.N = MLA_DOWN_PAD; g0.E = pg8::EpiGen{0, (bf16_t*)(scr + SC_DOWN), MLA_DOWN_PAD, 0, 0, nullptr, nullptr, 0, 0}; }
            else { g0.Bt = (const bf16_t*)(ws + (kind == 0 ? W_SB_IN + j * SZ_QKVW : W_FOX_IN)); g0.N = 3 * DM; g0.E = pg8::EpiGen{0, (bf16_t*)(scr + SC_Q), DM, DM, (size_t)NTOK * DM, nullptr, nullptr, 0, 0}; do_fgate = kind == 1; }
        } else if (s == 2) {
            if (kind == 1) { if (EN(2)) fox_prep_phase((bf16_t*)(scr + SC_Q), p.fox_q_gain, p.fox_k_gain, LOGF, CF); }
            else { if (EN(100)) { conv_job(lds, p.mla_w_uq, 3072, 0, 3072, 3072, 768, (bf16_t*)(ws + W_MLA_UQ)); conv_job(lds, p.mla_w_ukv, 4096, 0, 4096, 4096, 512, (bf16_t*)(ws + W_MLA_UKV)); }
                   if (EN(2)) mla_prep1_phase((const bf16_t*)(scr + SC_DOWN), p.pos, p.mla_q_norm, p.mla_kv_norm, (bf16_t*)(scr + SC_CQ), (bf16_t*)(scr + SC_CKV), ROPE, KR); }
        } else if (s == 3) {
            ng = 2;
            g0.A = (const bf16_t*)(scr + SC_CQ); g0.Bt = (const bf16_t*)(ws + W_MLA_UQ); g0.N = 3072; g0.K = MLA_QR; g0.E = pg8::EpiGen{0, (bf16_t*)(scr + SC_QUP), 3072, 0, 0, nullptr, nullptr, 0, 0};
            g1.A = (const bf16_t*)(scr + SC_CKV); g1.Bt = (const bf16_t*)(ws + W_MLA_UKV); g1.N = 4096; g1.K = MLA_KVR; g1.E = pg8::EpiGen{0, (bf16_t*)(scr + SC_KV), 4096, 0, 0, nullptr, nullptr, 0, 0};
        } else if (s == 4) { if (EN(4)) mla_prep2_phase((const bf16_t*)(scr + SC_QUP), (const bf16_t*)(scr + SC_KV), ROPE, KR, p.mla_q_gain, p.mla_k_gain, (bf16_t*)(scr + SC_QN), (bf16_t*)(scr + SC_KN)); }
        else if (s == 5) {
            if (kind == 0) { if (EN(50)) attn_phase<128, TESTMODE2 ? 2 : 0>((const bf16_t*)(scr + SC_Q), DM, HD, (const bf16_t*)(scr + SC_K), DM, HD, (const bf16_t*)(scr + SC_V), DM, HD, AO, nullptr, 0.08838834764831845f * LOG2E, lds); }
            else if (kind == 1) { if (EN(51)) attn_phase<128, 1>((const bf16_t*)(scr + SC_Q), DM, HD, (const bf16_t*)(scr + SC_K), DM, HD, (const bf16_t*)(scr + SC_V), DM, HD, AO, CF, 0.08838834764831845f * LOG2E, lds); }
            else { if (EN(52)) attn_phase<192, 2>((const bf16_t*)(scr + SC_QN), 3072, 192, (const bf16_t*)(scr + SC_KN), 3072, 192, (const bf16_t*)(scr + SC_KV) + 128, 4096, 256, AO, nullptr, 0.07216878364870323f * LOG2E, lds); }
            if (EN(100)) {
                if (kind == 0) conv_job(lds, p.sb_w_out + (size_t)j * 2048 * 2048, 2048, 0, 2048, 2048, 2048, (bf16_t*)(ws + W_SB_OUT + j * SZ_SQW));
                else if (kind == 1) conv_job(lds, p.fox_w_out, 2048, 0, 2048, 2048, 2048, (bf16_t*)(ws + W_FOX_OUT));
                else conv_job(lds, p.mla_w_out, 2048, 0, 2048, 2048, 2048, (bf16_t*)(ws + W_MLA_OUT));
            }
        } else if (s == 6) {
            ng = 1; g0.A = AO; g0.K = DM; g0.N = DM; g0.Bt = (const bf16_t*)(ws + (kind == 0 ? W_SB_OUT + j * SZ_SQW : (kind == 1 ? W_FOX_OUT : W_MLA_OUT)));
            g0.E = pg8::EpiGen{2, nullptr, DM, 0, 0, xin, X, xin_f32, 0};
        } else if (s == 8) {
            ng = 1; g0.A = H; g0.K = DM; g0.N = DFF; g0.Bt = (const bf16_t*)(ws + W_W1 + layer * SZ_FFW); g0.E = pg8::EpiGen{1, (bf16_t*)scr, DFF, 0, 0, nullptr, nullptr, 0, 0};
        } else {
            ng = 1; g0.A = (const bf16_t*)scr; g0.K = DFF; g0.N = DM; g0.Bt = (const bf16_t*)(ws + W_W2 + layer * SZ_FFW); const bool lastl = layer == NLAYERS - 1;
            g0.E = pg8::EpiGen{2, nullptr, DM, 0, 0, X, lastl ? (void*)p.out : (void*)X, 0, lastl ? 1 : 0};
        }
        if (EN(1)) {
#pragma nounroll
            for (int gi = 0; gi < ng; ++gi) run_gemm(lds, gi ? g1 : g0);
        }
        if (s == 8 && EN(100)) conv_job(lds, p.mlp_w2 + (size_t)layer * 8192 * 2048, 2048, 0, 2048, 2048, 8192, (bf16_t*)(ws + W_W2 + layer * SZ_FFW));
        if (do_fgate && EN(2)) fgate_phase(H, (const bf16_t*)(ws + W_FOX_F), p.fox_b_f, LOGF);
    }
}

__global__ void k_cmp(const unsigned* a, const unsigned* b, size_t n, unsigned* cnt) {
    unsigned c = 0;
    for (size_t i = (size_t)blockIdx.x * blockDim.x + threadIdx.x; i < n; i += (size_t)gridDim.x * blockDim.x) c += (a[i] != b[i]) ? 1u : 0u;
    if (c) atomicAdd(cnt, c);
}
__global__ void k_out(float* out, size_t n, const unsigned* cnt) {
    for (size_t i = (size_t)blockIdx.x * blockDim.x + threadIdx.x; i < n; i += (size_t)gridDim.x * blockDim.x) out[i] = 0.f;
    if (blockIdx.x == 0 && threadIdx.x == 0) out[0] = cnt[0] ? 3.0e5f : 1.0e5f;
}
extern "C" void kernel_launch(void* const* d_in, const int* in_sizes, int n_in, void* d_out, int out_size, void* d_ws, size_t ws_size, hipStream_t stream) {
    static int grid = 0;
    if (grid == 0) {
        if (n_in != 21 || out_size != NTOK * DM || ws_size < WS_END) { fprintf(stderr, "kernel_launch: unexpected shapes (n_in %d out %d ws %zu need %zu)\n", n_in, out_size, ws_size, (size_t)WS_END); grid = -1; return; }
        int dev = 0, cus = 0, per_cu = 0;
        hipGetDevice(&dev); hipDeviceGetAttribute(&cus, hipDeviceAttributeMultiprocessorCount, dev);
        if (hipFuncSetAttribute((const void*)fwd_megakernel, hipFuncAttributeMaxDynamicSharedMemorySize, LDS_BYTES) != hipSuccess) { fprintf(stderr, "kernel_launch: hipFuncSetAttribute failed\n"); grid = -1; return; }
        if (hipOccupancyMaxActiveBlocksPerMultiprocessor(&per_cu, (const void*)fwd_megakernel, 512, LDS_BYTES) != hipSuccess || per_cu < 1) { fprintf(stderr, "kernel_launch: occupancy query says %d\n", per_cu); per_cu = 1; }
        (void)hipGetLastError();
        grid = cus * 1;
        if (grid > 256) grid = 256;
    }
    if (grid < 0) return;
    Params p{};
    p.x = (const float*)d_in[0]; p.pos = (const int*)d_in[1]; p.mix_norm = (const float*)d_in[2]; p.mlp_norm = (const float*)d_in[3];
    p.sb_w_in = (const float*)d_in[4]; p.sb_w_out = (const float*)d_in[5]; p.fox_w_in = (const float*)d_in[6]; p.fox_b_f = (const float*)d_in[7];
    p.fox_q_gain = (const float*)d_in[8]; p.fox_k_gain = (const float*)d_in[9]; p.fox_w_out = (const float*)d_in[10];
    p.mla_w_in = (const float*)d_in[11]; p.mla_q_norm = (const float*)d_in[12]; p.mla_kv_norm = (const float*)d_in[13]; p.mla_w_uq = (const float*)d_in[14]; p.mla_w_ukv = (const float*)d_in[15];
    p.mla_q_gain = (const float*)d_in[16]; p.mla_k_gain = (const float*)d_in[17]; p.mla_w_out = (const float*)d_in[18]; p.mlp_w1 = (const float*)d_in[19]; p.mlp_w2 = (const float*)d_in[20];
    p.out = (float*)d_out; p.ws = (unsigned char*)d_ws;
#if COOP
    hipMemsetAsync((char*)d_ws + WS_BAR, 0, 16384, stream);
    p.ph_lo = 0; p.ph_hi = N_PHASES;
    void* args[] = {&p};
    hipError_t e = hipLaunchCooperativeKernel((const void*)fwd_megakernel, dim3(grid), dim3(512), args, LDS_BYTES, stream);
    if (e != hipSuccess) fprintf(stderr, "cooperative launch failed: %s (grid %d)\n", hipGetErrorString(e), grid);
#else
    for (int ph = 0; ph < N_PHASES; ++ph) {
        if (!phase_active(ph)) continue;
        p.ph_lo = ph; p.ph_hi = ph + 1;
        hipLaunchKernelGGL(fwd_megakernel, dim3(grid), dim3(512), LDS_BYTES, stream, p);
#ifdef TESTDUP
        if (ph == 6) { p.alt = 1; hipLaunchKernelGGL(fwd_megakernel, dim3(grid), dim3(512), LDS_BYTES, stream, p); p.alt = 0; }
#endif
    }
#ifdef TESTDUP
    unsigned* cnt = (unsigned*)((char*)d_ws + WS_LOGF);
    hipMemsetAsync(cnt, 0, 4, stream);
    hipLaunchKernelGGL(k_cmp, dim3(1024), dim3(256), 0, stream, (const unsigned*)((char*)d_ws + WS_AO), (const unsigned*)((char*)d_ws + WS_SCR + (size_t)NTOK * DFF * 2), (size_t)NTOK * DM / 2, cnt);
    hipLaunchKernelGGL(k_out, dim3(1024), dim3(256), 0, stream, (float*)d_out, (size_t)NTOK * DM, (const unsigned*)cnt);
#endif
#endif
}
```

```cpp
#include <hip/hip_runtime.h>
#include <hip/hip_cooperative_groups.h>
#include <cstdio>
#include <cstdint>
namespace cg = cooperative_groups;

#ifndef COOP
#define COOP 1
#endif
#ifndef ONLY
#define ONLY -1
#endif
#ifndef ATT_DMA
#define ATT_DMA 1
#endif
#define TESTMODE2 0

#ifndef SKIP
#define SKIP -5
#endif
#define EN(x) ((ONLY < 0 || ONLY == (x)) && (x) != SKIP)

#define LAS __attribute__((address_space(3)))
typedef unsigned short bf16_t;
typedef short bf16x8 __attribute__((ext_vector_type(8)));
typedef short s16x4 __attribute__((ext_vector_type(4)));
typedef float f32x4 __attribute__((ext_vector_type(4)));
typedef float f32x16 __attribute__((ext_vector_type(16)));
typedef unsigned u32x4 __attribute__((ext_vector_type(4)));
typedef unsigned u32x2 __attribute__((ext_vector_type(2)));

constexpr int DM = 2048, NTOK = 8192, SEQ = 2048, NH = 16, HD = 128, DFF = 8192, DEPTH = 4;
constexpr int MLA_QR = 768, MLA_KVR = 512, MLA_ROPE = 64, MLA_QK = 192, MLA_DOWN = 1344, MLA_DOWN_PAD = 1536;
constexpr float EPS = 1e-6f;
constexpr float LOG2E = 1.4426950408889634f;

constexpr size_t SZ_QKVW = (size_t)6144 * 2048 * 2, SZ_SQW = (size_t)2048 * 2048 * 2, SZ_FFW = (size_t)8192 * 2048 * 2;
constexpr size_t W_SB_IN = 0;
constexpr size_t W_SB_OUT = W_SB_IN + 2 * SZ_QKVW;
constexpr size_t W_FOX_IN = W_SB_OUT + 2 * SZ_SQW;
constexpr size_t W_FOX_F = W_FOX_IN + SZ_QKVW;
constexpr size_t W_FOX_OUT = W_FOX_F + (size_t)128 * 2048 * 2;
constexpr size_t W_MLA_IN = W_FOX_OUT + SZ_SQW;
constexpr size_t W_MLA_UQ = W_MLA_IN + (size_t)1536 * 2048 * 2;
constexpr size_t W_MLA_UKV = W_MLA_UQ + (size_t)3072 * 768 * 2;
constexpr size_t W_MLA_OUT = W_MLA_UKV + (size_t)4096 * 512 * 2;
constexpr size_t W_W1 = W_MLA_OUT + SZ_SQW;
constexpr size_t W_W2 = W_W1 + 4 * SZ_FFW;
constexpr size_t WS_X = W_W2 + 4 * SZ_FFW;
constexpr size_t WS_H = WS_X + (size_t)NTOK * DM * 4;
constexpr size_t WS_AO = WS_H + (size_t)NTOK * DM * 2;
constexpr size_t WS_LOGF = WS_AO + (size_t)NTOK * DM * 2;
constexpr size_t WS_CF = WS_LOGF + (size_t)NTOK * 16 * 4;
constexpr size_t WS_ROPE = WS_CF + (size_t)64 * 2048 * 4;
constexpr size_t WS_KR = WS_ROPE + (size_t)NTOK * 64 * 4;
constexpr size_t WS_SCR = WS_KR + (size_t)NTOK * 64 * 4;
constexpr size_t SC_Q = 0, SC_K = (size_t)NTOK * DM * 2, SC_V = 2 * (size_t)NTOK * DM * 2;
constexpr size_t SC_DOWN = 0;
constexpr size_t SC_CQ = SC_DOWN + (size_t)NTOK * MLA_DOWN_PAD * 2;
constexpr size_t SC_CKV = SC_CQ + (size_t)NTOK * MLA_QR * 2;
constexpr size_t SC_QUP = SC_CKV + (size_t)NTOK * MLA_KVR * 2;
constexpr size_t SC_KV = SC_QUP + (size_t)NTOK * 3072 * 2;
constexpr size_t SC_QN = SC_KV + (size_t)NTOK * 4096 * 2;
constexpr size_t SC_KN = SC_QN + (size_t)NTOK * 3072 * 2;
constexpr size_t SC_END = SC_KN + (size_t)NTOK * 3072 * 2;
constexpr size_t WS_BAR = WS_SCR + SC_END;
constexpr size_t WS_SS = WS_BAR + 16384;
constexpr size_t WS_END = WS_SS + (size_t)8 * NTOK * 8 * 4;

constexpr int LDS_BYTES = 131072 + 16 + 2048;

struct Params {
    const float* x; const int* pos; const float* mix_norm; const float* mlp_norm;
    const float* sb_w_in; const float* sb_w_out; const float* fox_w_in; const float* fox_b_f; const float* fox_q_gain; const float* fox_k_gain; const float* fox_w_out;
    const float* mla_w_in; const float* mla_q_norm; const float* mla_kv_norm; const float* mla_w_uq; const float* mla_w_ukv; const float* mla_q_gain; const float* mla_k_gain; const float* mla_w_out;
    const float* mlp_w1; const float* mlp_w2;
    float* out; unsigned char* ws;
    long long ph_lo, ph_hi, alt;
};

__device__ __forceinline__ unsigned cvtpk(float lo, float hi) { unsigned r; asm volatile("v_cvt_pk_bf16_f32 %0, %1, %2" : "=v"(r) : "v"(lo), "v"(hi)); return r; }
__device__ __forceinline__ float bflo(unsigned w) { return __uint_as_float(w << 16); }
__device__ __forceinline__ float bfhi(unsigned w) { return __uint_as_float(w & 0xffff0000u); }
__device__ __forceinline__ int opq(int x) { asm volatile("" : "+v"(x)); return x; }
__device__ __forceinline__ float wave_sum(float v) {
#pragma unroll
    for (int o = 32; o > 0; o >>= 1) v += __shfl_xor(v, o);
    return v;
}
__device__ __forceinline__ float sum16(float v) {
#pragma unroll
    for (int o = 8; o > 0; o >>= 1) v += __shfl_xor(v, o);
    return v;
}

namespace pg8 {
constexpr int BM = 256, BK = 64, HALF = 128, HTB = HALF * BK * 2, STAGE_BYTES = 8 * HTB, NXCD = 8, WGM = 8;
__host__ __device__ __forceinline__ int lds_byte(int r, int c) { const int st = (r >> 4) * 2 + (c >> 5), rr = r & 15, cc = c & 31, ob = rr * 64 + cc * 2; return st * 1024 + (ob ^ (((ob >> 9) & 1) << 5)); }
__host__ __device__ __forceinline__ void stage_rc(int b, int& R, int& C) { const int st = b / 1024, sb = b % 1024, swz = sb ^ (((sb >> 9) & 1) << 5); R = (st >> 1) * 16 + swz / 64; C = (st & 1) * 32 + (swz % 64) / 2; }
__host__ __device__ __forceinline__ int perm32(int rho) { const int n = rho >> 4, i = rho & 15; return 8 * (i >> 2) + 4 * n + (i & 3); }
struct Unit { int pm, pn; };
struct Gemm { const bf16_t* A; const bf16_t* Bt; int M, N, K; };
struct StaticOrder {
    int nM, nN, nwg, G, c;
    __device__ void init(int M, int N, int G_, int c_) { nM = M / BM; nN = N / BM; nwg = nM * nN; G = G_; c = c_; }
    __device__ bool next(int i, Unit& u) const {
        const long L = (long)i * G + c; if (L >= nwg) return false;
        int wgid = (int)L; { const int q = nwg / NXCD, r = nwg % NXCD, xcd = wgid % NXCD, off = wgid / NXCD; wgid = (xcd < r ? xcd * (q + 1) : r * (q + 1) + (xcd - r) * q) + off; }
        const int nig = WGM * nN, gid = wgid / nig, fm = gid * WGM, gsz = (nM - fm) < WGM ? (nM - fm) : WGM;
        u.pm = fm + ((wgid % nig) % gsz); u.pn = (wgid % nig) / gsz; return true;
    }
};
__device__ __forceinline__ float rstd_of(const float* ss, int row) {
    const f32x4 a = *(const f32x4*)(ss + (size_t)row * 8), b = *(const f32x4*)(ss + (size_t)row * 8 + 4);
    return rsqrtf((((a[0] + a[1]) + (a[2] + a[3])) + ((b[0] + b[1]) + (b[2] + b[3]))) * (1.f / DM) + EPS);
}
struct EpiGen {
    int mode; bf16_t* O; int ldc; int split_cols; size_t split_stride; const void* R; void* C; int rf32, cf32;
    const float* SSc;
    float* SSn;
    __device__ __forceinline__ void operator()(const f32x4 (&acc)[2][2][4][2], const Unit& u, int wr, int wc, int fr, int fq, LAS unsigned char* lds) const {
        const int row0 = u.pm * BM + wr * 64 + fr;
        if (mode == 2) {
            const int col0 = u.pn * BM + wc * 32 + 8 * fq;
            const float* R32 = (const float*)R; const bf16_t* R16 = (const bf16_t*)R; float* C32 = (float*)C; bf16_t* C16 = (bf16_t*)C;
            LAS float* ex = (LAS float*)(lds + 131072 + 16) + wr * 256;
#pragma unroll
            for (int ai = 0; ai < 2; ++ai) {
                float ssq[4] = {0.f, 0.f, 0.f, 0.f};
                if (rf32) {
#pragma unroll
                    for (int mp = 0; mp < 2; ++mp) {
                        f32x4 rv[2][2][2];
#pragma unroll
                        for (int mm = 0; mm < 2; ++mm) { const size_t ro = (size_t)(row0 + ai * HALF + (2 * mp + mm) * 16) * ldc + col0;
#pragma unroll
                            for (int bj = 0; bj < 2; ++bj) { rv[mm][bj][0] = *(const f32x4*)(R32 + ro + bj * HALF); rv[mm][bj][1] = *(const f32x4*)(R32 + ro + bj * HALF + 4); } }
#pragma unroll
                        for (int mm = 0; mm < 2; ++mm) { const int m = 2 * mp + mm; const size_t ro = (size_t)(row0 + ai * HALF + m * 16) * ldc + col0;
#pragma unroll
                            for (int bj = 0; bj < 2; ++bj) { const f32x4 x0 = acc[ai][bj][m][0] + rv[mm][bj][0], x1 = acc[ai][bj][m][1] + rv[mm][bj][1];
                                ssq[m] += (x0[0] * x0[0] + x0[1] * x0[1]) + (x0[2] * x0[2] + x0[3] * x0[3]) + (x1[0] * x1[0] + x1[1] * x1[1]) + (x1[2] * x1[2] + x1[3] * x1[3]);
                                if (cf32) { *(f32x4*)(C32 + ro + bj * HALF) = x0; *(f32x4*)(C32 + ro + bj * HALF + 4) = x1; }
                                else { u32x4 w; w.x = cvtpk(x0[0], x0[1]); w.y = cvtpk(x0[2], x0[3]); w.z = cvtpk(x1[0], x1[1]); w.w = cvtpk(x1[2], x1[3]); *(u32x4*)(C16 + ro + bj * HALF) = w; } } }
                    }
                } else {
                    u32x4 rw[4][2];
#pragma unroll
                    for (int m = 0; m < 4; ++m) { const size_t ro = (size_t)(row0 + ai * HALF + m * 16) * ldc + col0;
#pragma unroll
                        for (int bj = 0; bj < 2; ++bj) rw[m][bj] = *(const u32x4*)(R16 + ro + bj * HALF); }
#pragma unroll
                    for (int m = 0; m < 4; ++m) { const size_t ro = (size_t)(row0 + ai * HALF + m * 16) * ldc + col0;
#pragma unroll
                        for (int bj = 0; bj < 2; ++bj) { const u32x4 r = rw[m][bj];
                            const f32x4 x0 = acc[ai][bj][m][0] + (f32x4){bflo(r.x), bfhi(r.x), bflo(r.y), bfhi(r.y)}, x1 = acc[ai][bj][m][1] + (f32x4){bflo(r.z), bfhi(r.z), bflo(r.w), bfhi(r.w)};
                            ssq[m] += (x0[0] * x0[0] + x0[1] * x0[1]) + (x0[2] * x0[2] + x0[3] * x0[3]) + (x1[0] * x1[0] + x1[1] * x1[1]) + (x1[2] * x1[2] + x1[3] * x1[3]);
                            if (cf32) { *(f32x4*)(C32 + ro + bj * HALF) = x0; *(f32x4*)(C32 + ro + bj * HALF + 4) = x1; }
                            else { u32x4 w; w.x = cvtpk(x0[0], x0[1]); w.y = cvtpk(x0[2], x0[3]); w.z = cvtpk(x1[0], x1[1]); w.w = cvtpk(x1[2], x1[3]); *(u32x4*)(C16 + ro + bj * HALF) = w; } } }
                }
                if (SSn) {
#pragma unroll
                    for (int m = 0; m < 4; ++m) { float t = ssq[m]; t += __shfl_xor(t, 16); t += __shfl_xor(t, 32); if (fq == 0) ex[(m * 16 + fr) * 4 + wc] = t; }
                    asm volatile("s_waitcnt lgkmcnt(0)\n\ts_barrier" ::: "memory");
                    if (wc == 0 && fq == 0) {
#pragma unroll
                        for (int m = 0; m < 4; ++m) { const f32x4 q = *(const LAS f32x4*)(ex + (m * 16 + fr) * 4); SSn[(size_t)(row0 + ai * HALF + m * 16) * 8 + u.pn] = (q[0] + q[1]) + (q[2] + q[3]); } }
                    asm volatile("s_waitcnt lgkmcnt(0)\n\ts_barrier" ::: "memory");
                }
            }
        } else {
            int colt = u.pn * BM; bf16_t* base = O;
            if (split_cols) { const int t = colt / split_cols; base += (size_t)t * split_stride; colt -= t * split_cols; }
            const int col0 = colt + wc * 32 + 8 * fq; const bool act = mode == 1;
#pragma unroll
            for (int ai = 0; ai < 2; ++ai)
#pragma unroll
                for (int m = 0; m < 4; ++m) { bf16_t* rowp = base + (size_t)(row0 + ai * HALF + m * 16) * ldc + col0;
                    const float rs = SSc ? rstd_of(SSc, row0 + ai * HALF + m * 16) : 1.f;
#pragma unroll
                    for (int bj = 0; bj < 2; ++bj) { f32x4 v0 = acc[ai][bj][m][0] * rs, v1 = acc[ai][bj][m][1] * rs;
                        if (act) {
#pragma unroll
                            for (int j = 0; j < 4; ++j) { float x = fmaxf(v0[j], 0.f), y = fmaxf(v1[j], 0.f); v0[j] = x * x; v1[j] = y * y; } }
                        u32x4 w; w.x = cvtpk(v0[0], v0[1]); w.y = cvtpk(v0[2], v0[3]); w.z = cvtpk(v1[0], v1[1]); w.w = cvtpk(v1[2], v1[3]);
                        *(u32x4*)(rowp + bj * HALF) = w; } }
        }
    }
};

template <class Epi, class Sched>
__device__ __forceinline__ void gemm_phase(LAS unsigned char* lds, const Gemm g, const Sched& S, const Epi& E) {
    const int tid = opq(threadIdx.x), wid = __builtin_amdgcn_readfirstlane(tid >> 6), lane = tid & 63, wr = wid >> 2, wc = wid & 3, fr = lane & 15, fq = lane >> 4;
    const int K = g.K, nt = K / BK;
    unsigned voffA[2], voffB[2];
#pragma unroll
    for (int i = 0; i < 2; ++i) { int R, C; stage_rc(tid * 16 + i * 8192, R, C); const int Rb = (R & ~31) + perm32(R & 31);
        voffA[i] = (unsigned)(R * K + C) * 2u; voffB[i] = (unsigned)(Rb * K + C) * 2u; }
    const size_t kstep = (size_t)(BK * 2);
    const size_t hstep = (size_t)HALF * K * 2;
    const size_t tstep = 2 * hstep;
    const unsigned ldsw = (unsigned)wid * 1024u;
    const int aoff = lds_byte(wr * 64 + fr, fq * 8), boff = lds_byte(wc * 32 + fr, fq * 8);
#define PG8_SA(b, h) (((b) * 2 + (h)) * HTB)
#define PG8_SB(b, h) ((4 + (b) * 2 + (h)) * HTB)
#define PG8_STAGE(bufoff, gbase, voff) do { _Pragma("unroll") for (int _i = 0; _i < 2; ++_i) \
        __builtin_amdgcn_global_load_lds((const unsigned*)((const char*)(gbase) + (voff)[_i]), (LAS unsigned*)(lds + (bufoff) + ldsw + _i * 8192), 16, 0, 0); } while (0)
#define PG8_LDA(dst, b, h) do { _Pragma("unroll") for (int m = 0; m < 4; ++m) _Pragma("unroll") for (int k = 0; k < 2; ++k) dst[m][k] = *(const LAS bf16x8*)(lds + PG8_SA(b, h) + aoff + m * 2048 + k * 1024); } while (0)
#define PG8_LDB(dst, b, h) do { _Pragma("unroll") for (int n = 0; n < 2; ++n) _Pragma("unroll") for (int k = 0; k < 2; ++k) dst[n][k] = *(const LAS bf16x8*)(lds + PG8_SB(b, h) + boff + n * 2048 + k * 1024); } while (0)
#define PG8_MMA(ai, bj, At, Bt) do { __builtin_amdgcn_s_setprio(1); _Pragma("unroll") for (int m = 0; m < 4; ++m) _Pragma("unroll") for (int n = 0; n < 2; ++n) _Pragma("unroll") for (int k = 0; k < 2; ++k) \
        acc[ai][bj][m][n] = __builtin_amdgcn_mfma_f32_16x16x32_bf16(Bt[n][k], At[m][k], acc[ai][bj][m][n], 0, 0, 0); __builtin_amdgcn_s_setprio(0); } while (0)
#define PG8_WAIT_V(n) asm volatile("s_waitcnt vmcnt(" #n ")" ::: "memory")
#define PG8_WAIT_L(n) asm volatile("s_waitcnt lgkmcnt(" #n ")" ::: "memory")
#define PG8_BAR __builtin_amdgcn_s_barrier()
#define PG8_SCHED __builtin_amdgcn_sched_barrier(0)
    Unit cur, nxt; int ui = 0;
    if (!S.next(0, cur)) return;
    f32x4 acc[2][2][4][2];
#pragma unroll
    for (int a = 0; a < 2; ++a)
#pragma unroll
        for (int b = 0; b < 2; ++b)
#pragma unroll
            for (int m = 0; m < 4; ++m)
#pragma unroll
                for (int n = 0; n < 2; ++n) acc[a][b][m][n] = (f32x4){0.f, 0.f, 0.f, 0.f};
    bf16x8 At[4][2], B0[2][2], B1[2][2];
    const char* cA = (const char*)g.A + (size_t)cur.pm * tstep; const char* cB = (const char*)g.Bt + (size_t)cur.pn * tstep;
    PG8_STAGE(PG8_SB(0, 0), cB, voffB); PG8_STAGE(PG8_SA(0, 0), cA, voffA); PG8_STAGE(PG8_SB(0, 1), cB + hstep, voffB); PG8_STAGE(PG8_SA(0, 1), cA + hstep, voffA);
    if (wr == 1) PG8_BAR;
    PG8_WAIT_V(4); PG8_BAR;
    PG8_STAGE(PG8_SB(1, 0), cB + kstep, voffB); PG8_STAGE(PG8_SA(1, 0), cA + kstep, voffA); PG8_STAGE(PG8_SB(1, 1), cB + hstep + kstep, voffB);
    PG8_WAIT_V(6); PG8_BAR;
    for (;;) {
        const bool has_next = S.next(ui + 1, nxt);
        const char* nA = has_next ? (const char*)g.A + (size_t)nxt.pm * tstep : cA; const char* nB = has_next ? (const char*)g.Bt + (size_t)nxt.pn * tstep : cB;
        for (int t = 0; t < nt; t += 2) {
            const bool last = (t == nt - 2);
            const char* a1 = cA + (size_t)(t + 1) * kstep;
            const char* a2 = last ? nA : cA + (size_t)(t + 2) * kstep; const char* b2 = last ? nB : cB + (size_t)(t + 2) * kstep;
            const char* a3 = a2 + kstep; const char* b3 = b2 + kstep;
            PG8_LDB(B0, 0, 0); PG8_SCHED; PG8_LDA(At, 0, 0); PG8_STAGE(PG8_SA(1, 1), a1 + hstep, voffA);
            PG8_WAIT_L(8); PG8_BAR; PG8_WAIT_L(0); PG8_MMA(0, 0, At, B0); PG8_BAR; PG8_SCHED;
            PG8_LDB(B1, 0, 1); PG8_STAGE(PG8_SB(0, 0), b2, voffB);
            PG8_BAR; PG8_WAIT_L(0); PG8_MMA(0, 1, At, B1); PG8_BAR;
            PG8_LDA(At, 0, 1); PG8_STAGE(PG8_SA(0, 0), a2, voffA);
            PG8_BAR; PG8_WAIT_L(0); PG8_MMA(1, 0, At, B0); PG8_BAR; PG8_SCHED;
            PG8_STAGE(PG8_SB(0, 1), b2 + hstep, voffB);
            PG8_WAIT_V(6); PG8_BAR; PG8_MMA(1, 1, At, B1); PG8_BAR;
            PG8_LDB(B0, 1, 0); PG8_SCHED; PG8_LDA(At, 1, 0); PG8_STAGE(PG8_SA(0, 1), a2 + hstep, voffA);
            PG8_WAIT_L(8); PG8_BAR; PG8_WAIT_L(0); PG8_MMA(0, 0, At, B0); PG8_BAR; PG8_SCHED;
            PG8_LDB(B1, 1, 1); PG8_STAGE(PG8_SB(1, 0), b3, voffB);
            PG8_BAR; PG8_WAIT_L(0); PG8_MMA(0, 1, At, B1); PG8_BAR;
            PG8_LDA(At, 1, 1); PG8_STAGE(PG8_SA(1, 0), a3, voffA);
            PG8_BAR; PG8_WAIT_L(0); PG8_MMA(1, 0, At, B0); PG8_BAR; PG8_SCHED;
            PG8_STAGE(PG8_SB(1, 1), b3 + hstep, voffB);
            PG8_WAIT_V(6); PG8_BAR; PG8_MMA(1, 1, At, B1); PG8_BAR;
        }
        E(acc, cur, wr, wc, fr, fq, lds);
        if (!has_next) break;
#pragma unroll
        for (int a = 0; a < 2; ++a)
#pragma unroll
            for (int b = 0; b < 2; ++b)
#pragma unroll
                for (int m = 0; m < 4; ++m)
#pragma unroll
                    for (int n = 0; n < 2; ++n) acc[a][b][m][n] = (f32x4){0.f, 0.f, 0.f, 0.f};
        cur = nxt; cA = nA; cB = nB; ++ui;
    }
    PG8_WAIT_V(0);
    if (wr == 0) PG8_BAR;
    PG8_BAR;
#undef PG8_SA
#undef PG8_SB
#undef PG8_STAGE
#undef PG8_LDA
#undef PG8_LDB
#undef PG8_MMA
#undef PG8_WAIT_V
#undef PG8_WAIT_L
#undef PG8_BAR
#undef PG8_SCHED
}
}

struct GemmJob { const bf16_t* A; const bf16_t* Bt; int M, N, K; pg8::EpiGen E; };
__device__ __forceinline__ void run_gemm(LAS unsigned char* lds, const GemmJob& j) {
    pg8::Gemm g{j.A, j.Bt, j.M, j.N, j.K};
    pg8::StaticOrder S; S.init(j.M, j.N, (int)gridDim.x, (int)blockIdx.x);
    pg8::gemm_phase<pg8::EpiGen, pg8::StaticOrder>(lds, g, S, j.E);
    __syncthreads();
}

__device__ __forceinline__ void conv_job(LAS unsigned char* lds, const float* __restrict__ src, int ldn, int col0, int ncols, int npad, int K, bf16_t* __restrict__ dst, const float* __restrict__ gk = nullptr) {
    constexpr int LR = 132;
    LAS float* T = (LAS float*)lds;
    const int tid = opq(threadIdx.x), n4 = tid & 31, kr = tid >> 5;
    const int rn = tid & 127, rk = tid >> 7;
    const int ntn = npad / 128, ntk = K / 128, ntiles = ntn * ntk;
    f32x4 r[8]; float gq[8];
    int t = blockIdx.x;
#define CONV_LOAD(tt_) do { const int tn_ = (tt_) % ntn, tk_ = (tt_) / ntn; const int n_ = tn_ * 128 + n4 * 4; const bool ok_ = n_ < ncols; \
        const float* p_ = src + (size_t)(tk_ * 128 + kr) * ldn + col0 + (ok_ ? n_ : 0); \
        _Pragma("unroll") for (int j_ = 0; j_ < 8; ++j_) { r[j_] = __builtin_nontemporal_load((const f32x4*)(p_ + (size_t)(16 * j_) * ldn)); if (!ok_) r[j_] = (f32x4){0.f, 0.f, 0.f, 0.f}; gq[j_] = gk ? gk[tk_ * 128 + kr + 16 * j_] : 1.f; } } while (0)
    if (t < ntiles) CONV_LOAD(t);
    for (; t < ntiles; t += gridDim.x) {
        const int tn = t % ntn, tk = t / ntn;
#pragma unroll
        for (int j = 0; j < 8; ++j) *(LAS f32x4*)(T + (kr + 16 * j) * LR + n4 * 4) = r[j] * gq[j];
        if (t + (int)gridDim.x < ntiles) CONV_LOAD(t + (int)gridDim.x);
        __syncthreads();
#pragma unroll
        for (int j = 0; j < 4; ++j) { const int kc = rk + 4 * j; float v[8];
#pragma unroll
            for (int i = 0; i < 8; ++i) v[i] = T[(kc * 8 + i) * LR + rn];
            u32x4 w; w.x = cvtpk(v[0], v[1]); w.y = cvtpk(v[2], v[3]); w.z = cvtpk(v[4], v[5]); w.w = cvtpk(v[6], v[7]);
            *(u32x4*)(dst + (size_t)(tn * 128 + rn) * K + tk * 128 + kc * 8) = w; }
        __syncthreads();
    }
}

__device__ __forceinline__ void xprep_phase(const float* __restrict__ x, bf16_t* __restrict__ xb, float* __restrict__ ss0) {
    const int tid = opq(threadIdx.x), lane = tid & 63, gw = blockIdx.x * 8 + (tid >> 6), nw = gridDim.x * 8;
    for (int row = gw; row < NTOK; row += nw) {
        const float* xr = x + (size_t)row * DM; f32x4 v[8]; float ss = 0.f;
#pragma unroll
        for (int j = 0; j < 8; ++j) { v[j] = *(const f32x4*)(xr + j * 256 + lane * 4); ss += v[j][0] * v[j][0] + v[j][1] * v[j][1] + v[j][2] * v[j][2] + v[j][3] * v[j][3]; }
        ss = wave_sum(ss); if (lane < 8) ss0[(size_t)row * 8 + lane] = lane == 0 ? ss : 0.f;
#pragma unroll
        for (int j = 0; j < 8; ++j) { u32x2 w; w.x = cvtpk(v[j][0], v[j][1]); w.y = cvtpk(v[j][2], v[j][3]); *(u32x2*)(xb + (size_t)row * DM + j * 256 + lane * 4) = w; }
    }
}

__device__ __forceinline__ void fgate_phase(const bf16_t* __restrict__ h, const bf16_t* __restrict__ wft, const float* __restrict__ bfv, const float* __restrict__ ssc, float* __restrict__ logf) {
    const int tid = opq(threadIdx.x), lane = tid & 63, gw = blockIdx.x * 8 + (tid >> 6), nw = gridDim.x * 8;
    const int fr = lane & 15, fq = lane >> 4;
    if ((gw & 3) != 0) return;
    for (int job = gw >> 2; job < NTOK / 16; job += (nw >> 2)) {
        const bf16_t* ap = h + (size_t)(job * 16 + fr) * DM + fq * 8; const bf16_t* bp = wft + (size_t)fr * DM + fq * 8;
        f32x4 acc = {0.f, 0.f, 0.f, 0.f};
#pragma unroll 8
        for (int k = 0; k < DM; k += 32) { const bf16x8 a = *(const bf16x8*)(ap + k), b = *(const bf16x8*)(bp + k); acc = __builtin_amdgcn_mfma_f32_16x16x32_bf16(a, b, acc, 0, 0, 0); }
        const float bb = bfv[fr];
#pragma unroll
        for (int j = 0; j < 4; ++j) { const float u = acc[j] * pg8::rstd_of(ssc, job * 16 + fq * 4 + j) + bb; logf[(size_t)(job * 16 + fq * 4 + j) * 16 + fr] = -(fmaxf(-u, 0.f) + log1pf(__expf(-fabsf(u)))); }
    }
}

__device__ __forceinline__ void fox_prep_phase(bf16_t* __restrict__ qk  , const float* __restrict__ qg, const float* __restrict__ kg, const float* __restrict__ logf, float* __restrict__ cf) {
    const int tid = opq(threadIdx.x), lane = tid & 63, gw = blockIdx.x * 8 + (tid >> 6), nw = gridDim.x * 8;
    const int sub = lane >> 4, l16 = lane & 15;
    const int nrows = 2 * NTOK * NH;
    for (int r0 = gw * 4; r0 < nrows; r0 += nw * 4) {
        const int row = r0 + sub; const bool isk = row >= NTOK * NH;
        bf16_t* p = qk + (size_t)row * HD + l16 * 8;
        const u32x4 w = *(const u32x4*)p; float v[8] = {bflo(w.x), bfhi(w.x), bflo(w.y), bfhi(w.y), bflo(w.z), bfhi(w.z), bflo(w.w), bfhi(w.w)};
        float ss = 0.f;
#pragma unroll
        for (int i = 0; i < 8; ++i) ss += v[i] * v[i];
        ss = sum16(ss); const float rs = rsqrtf(ss * (1.f / HD) + EPS);
        const float* gp = (isk ? kg : qg) + l16 * 8; const f32x4 g0 = *(const f32x4*)gp, g1 = *(const f32x4*)(gp + 4);
        u32x4 o; o.x = cvtpk(v[0] * rs * g0[0], v[1] * rs * g0[1]); o.y = cvtpk(v[2] * rs * g0[2], v[3] * rs * g0[3]);
        o.z = cvtpk(v[4] * rs * g1[0], v[5] * rs * g1[1]); o.w = cvtpk(v[6] * rs * g1[2], v[7] * rs * g1[3]);
        *(u32x4*)p = o;
    }
    for (int bh = blockIdx.x; bh < 64; bh += gridDim.x) {
        if ((threadIdx.x >> 6) != 0) continue;
        const int b = bh >> 4, hd = bh & 15; const float* lp = logf + (size_t)(b * SEQ + lane * 32) * 16 + hd;
        float v[32]; float tot = 0.f;
#pragma unroll
        for (int i = 0; i < 32; ++i) { tot += lp[(size_t)i * 16]; v[i] = tot; }
        float inc = tot;
#pragma unroll
        for (int o = 1; o < 64; o <<= 1) { const float up = __shfl_up(inc, o); if (lane >= o) inc += up; }
        const float base = inc - tot;
        float* cp = cf + (size_t)bh * SEQ + lane * 32;
#pragma unroll
        for (int i = 0; i < 32; ++i) cp[i] = base + v[i];
    }
}

__device__ __forceinline__ void mla_prep1_phase(const bf16_t* __restrict__ down, const int* __restrict__ pos, const float* __restrict__ qn, const float* __restrict__ kvn,
                                                bf16_t* __restrict__ cq, bf16_t* __restrict__ ckv, float* __restrict__ ropet, float* __restrict__ kr) {
    const int tid = opq(threadIdx.x), lane = tid & 63, gw = blockIdx.x * 8 + (tid >> 6), nw = gridDim.x * 8;
    for (int row = gw; row < NTOK; row += nw) {
        const bf16_t* dr = down + (size_t)row * MLA_DOWN_PAD;
        {   float v[12]; float ss = 0.f;
#pragma unroll
            for (int j = 0; j < 3; ++j) { const u32x2 w = *(const u32x2*)(dr + j * 256 + lane * 4); v[4 * j] = bflo(w.x); v[4 * j + 1] = bfhi(w.x); v[4 * j + 2] = bflo(w.y); v[4 * j + 3] = bfhi(w.y); }
#pragma unroll
            for (int i = 0; i < 12; ++i) ss += v[i] * v[i];
            ss = wave_sum(ss); const float rs = rsqrtf(ss * (1.f / MLA_QR) + EPS);
#pragma unroll
            for (int j = 0; j < 3; ++j) { const f32x4 g = *(const f32x4*)(qn + j * 256 + lane * 4);
                u32x2 w; w.x = cvtpk(v[4 * j] * rs * g[0], v[4 * j + 1] * rs * g[1]); w.y = cvtpk(v[4 * j + 2] * rs * g[2], v[4 * j + 3] * rs * g[3]);
                *(u32x2*)(cq + (size_t)row * MLA_QR + j * 256 + lane * 4) = w; } }
        {   float v[8]; float ss = 0.f;
#pragma unroll
            for (int j = 0; j < 2; ++j) { const u32x2 w = *(const u32x2*)(dr + MLA_QR + j * 256 + lane * 4); v[4 * j] = bflo(w.x); v[4 * j + 1] = bfhi(w.x); v[4 * j + 2] = bflo(w.y); v[4 * j + 3] = bfhi(w.y); }
#pragma unroll
            for (int i = 0; i < 8; ++i) ss += v[i] * v[i];
            ss = wave_sum(ss); const float rs = rsqrtf(ss * (1.f / MLA_KVR) + EPS);
#pragma unroll
            for (int j = 0; j < 2; ++j) { const f32x4 g = *(const f32x4*)(kvn + j * 256 + lane * 4);
                u32x2 w; w.x = cvtpk(v[4 * j] * rs * g[0], v[4 * j + 1] * rs * g[1]); w.y = cvtpk(v[4 * j + 2] * rs * g[2], v[4 * j + 3] * rs * g[3]);
                *(u32x2*)(ckv + (size_t)row * MLA_KVR + j * 256 + lane * 4) = w; } }
        if (lane < 32) {
            const float invf = powf(10000.0f, -(float)(2 * lane) / 64.0f);
            const float ang = (float)pos[row] * invf; const float cs = cosf(ang), sn = sinf(ang);
            ropet[(size_t)row * 64 + lane] = cs; ropet[(size_t)row * 64 + 32 + lane] = sn;
            const float x1 = __uint_as_float((unsigned)dr[MLA_QR + MLA_KVR + lane] << 16), x2 = __uint_as_float((unsigned)dr[MLA_QR + MLA_KVR + 32 + lane] << 16);
            kr[(size_t)row * 64 + lane] = x1 * cs - x2 * sn; kr[(size_t)row * 64 + 32 + lane] = x1 * sn + x2 * cs;
        }
    }
}

__device__ __forceinline__ void mla_prep2_phase(const bf16_t* __restrict__ qup, const bf16_t* __restrict__ kv, const float* __restrict__ ropet, const float* __restrict__ kr,
                                                const float* __restrict__ qg, const float* __restrict__ kg, bf16_t* __restrict__ Qn, bf16_t* __restrict__ Kn) {
    const int tid = opq(threadIdx.x), lane = tid & 63, gw = blockIdx.x * 8 + (tid >> 6), nw = gridDim.x * 8;
    const int sub = lane >> 4, j = lane & 15;
    const int nrows = 2 * NTOK * NH;
    for (int r0 = gw * 4; r0 < nrows; r0 += nw * 4) {
        int row = r0 + sub; const bool isk = row >= NTOK * NH; if (isk) row -= NTOK * NH;
        const int tok = row >> 4, hd = row & 15;
        float v[8], ra[2], rb[2];
        if (!isk) {
            const bf16_t* p = qup + (size_t)tok * 3072 + hd * 192;
            const u32x4 w = *(const u32x4*)(p + j * 8);
            v[0] = bflo(w.x); v[1] = bfhi(w.x); v[2] = bflo(w.y); v[3] = bfhi(w.y); v[4] = bflo(w.z); v[5] = bfhi(w.z); v[6] = bflo(w.w); v[7] = bfhi(w.w);
            const unsigned w1 = *(const unsigned*)(p + 128 + 2 * j), w2 = *(const unsigned*)(p + 160 + 2 * j);
            const float x1a = bflo(w1), x1b = bfhi(w1), x2a = bflo(w2), x2b = bfhi(w2);
            const float* rt = ropet + (size_t)tok * 64; const float c0 = rt[2 * j], c1 = rt[2 * j + 1], s0 = rt[32 + 2 * j], s1 = rt[32 + 2 * j + 1];
            ra[0] = x1a * c0 - x2a * s0; ra[1] = x1b * c1 - x2b * s1; rb[0] = x1a * s0 + x2a * c0; rb[1] = x1b * s1 + x2b * c1;
        } else {
            const bf16_t* p = kv + (size_t)tok * 4096 + hd * 256;
            const u32x4 w = *(const u32x4*)(p + j * 8);
            v[0] = bflo(w.x); v[1] = bfhi(w.x); v[2] = bflo(w.y); v[3] = bfhi(w.y); v[4] = bflo(w.z); v[5] = bfhi(w.z); v[6] = bflo(w.w); v[7] = bfhi(w.w);
            const float* kp = kr + (size_t)tok * 64; ra[0] = kp[2 * j]; ra[1] = kp[2 * j + 1]; rb[0] = kp[32 + 2 * j]; rb[1] = kp[32 + 2 * j + 1];
        }
        float ss = ra[0] * ra[0] + ra[1] * ra[1] + rb[0] * rb[0] + rb[1] * rb[1];
#pragma unroll
        for (int i = 0; i < 8; ++i) ss += v[i] * v[i];
        ss = sum16(ss); const float rs = rsqrtf(ss * (1.f / MLA_QK) + EPS);
        const float* g = isk ? kg : qg; const f32x4 g0 = *(const f32x4*)(g + j * 8), g1 = *(const f32x4*)(g + j * 8 + 4);
        bf16_t* o = (isk ? Kn : Qn) + (size_t)tok * 3072 + hd * 192;
        u32x4 ow; ow.x = cvtpk(v[0] * rs * g0[0], v[1] * rs * g0[1]); ow.y = cvtpk(v[2] * rs * g0[2], v[3] * rs * g0[3]);
        ow.z = cvtpk(v[4] * rs * g1[0], v[5] * rs * g1[1]); ow.w = cvtpk(v[6] * rs * g1[2], v[7] * rs * g1[3]);
        *(u32x4*)(o + j * 8) = ow;
        *(unsigned*)(o + 128 + 2 * j) = cvtpk(ra[0] * rs * g[128 + 2 * j], ra[1] * rs * g[128 + 2 * j + 1]);
        *(unsigned*)(o + 160 + 2 * j) = cvtpk(rb[0] * rs * g[160 + 2 * j], rb[1] * rs * g[160 + 2 * j + 1]);
    }
}

__device__ __forceinline__ int v_st(int k, int c) { const int kk = (k & ~0xC) | ((k & 4) << 1) | ((k & 8) >> 1); return ((kk >> 3) * 4 + (c >> 5)) * 512 + ((kk & 7) * 32 + (c & 31)) * 2; }
__device__ __forceinline__ int v_rd_base(int lane) { return ((lane & 3) << 3) | (((lane >> 2) & 3) << 6) | (((lane >> 4) & 1) << 5) | (((lane >> 5) & 1) << 8); }
constexpr int v_rd_off(int d0, int ks, int half) { return d0 * 512 + ks * 4096 + half * 2048; }
__device__ __forceinline__ int crow(int r, int hi) { return (r & 3) + 8 * (r >> 2) + 4 * hi; }

constexpr int AT_SHM_V = 16384, AT_KBUF = 24576;
constexpr int AT_OFF_K = 2 * AT_SHM_V, AT_OFF_WS = AT_OFF_K + 2 * AT_KBUF, AT_OFF_CF = AT_OFF_WS + 2048;

#ifdef TESTB
#define SB_LG(y) fmaxf(1.f - 0.5f * fabsf(y), 0.f)
#else
#define SB_LG(y) __builtin_amdgcn_logf(1.f + __builtin_amdgcn_exp2f(-fabsf(y)))
#endif
#ifndef SB_BLOCK_EXIT
#define SB_BLOCK_EXIT 0
#endif
template <int DQK, int MODE>
__device__ __forceinline__ void attn_block(const bf16_t* __restrict__ Qg, int ldq, const bf16_t* __restrict__ Kg, int ldk, const bf16_t* __restrict__ Vg, int ldv,
                                           bf16_t* __restrict__ Og, int ldo, int q0, float C2, LAS unsigned char* lds) {
    constexpr int NQ = DQK / 16, ROWB = DQK * 2, SHM_K = 64 * ROWB, NCH = DQK / 8, KCH = NCH / 8;
    const int tid = opq(threadIdx.x), wid = __builtin_amdgcn_readfirstlane(tid >> 6), lane = tid & 63, r32 = lane & 31, hi = lane >> 5;
    LAS unsigned char* V_lds = lds; LAS unsigned char* K_lds = lds + AT_OFF_K;
    LAS float* li_l = (LAS float*)(lds + AT_OFF_WS) + wid * 64; LAS float* al_l = li_l + 32;
    const LAS float* cfl = (const LAS float*)(lds + AT_OFF_CF);
    const int qlo = q0 + wid * 32, trow = qlo + r32;
    bf16x8 qr[NQ];
#pragma unroll
    for (int d0 = 0; d0 < NQ; ++d0) qr[d0] = *(const bf16x8*)(Qg + (size_t)trow * ldq + d0 * 16 + hi * 8);
    const int NT = q0 / 64 + 4;
    int kso[KCH], vso[2];
#pragma unroll
    for (int i = 0; i < KCH; ++i) { const int L = (i * 8 + wid) * 1024 + lane * 16, row = L / ROWB, wi = L % ROWB; kso[i] = row * ldk + ((wi ^ ((row & 7) << 4)) >> 1); }
#pragma unroll
    for (int i = 0; i < 2; ++i) { const int L = (i * 8 + wid) * 1024 + lane * 16, sub = L >> 9, we = (L & 511) >> 1, kk = (sub >> 2) * 8 + (we >> 5), c = (sub & 3) * 32 + (we & 31);
        const int k = (kk & ~0xC) | ((kk & 4) << 1) | ((kk & 8) >> 1); vso[i] = k * ldv + c; }
#define AT_DMA(kb_, buf_) do { const bf16_t* kp_ = Kg + (size_t)(kb_) * ldk; const bf16_t* vp_ = Vg + (size_t)(kb_) * ldv; \
        _Pragma("unroll") for (int i_ = 0; i_ < KCH; ++i_) __builtin_amdgcn_global_load_lds((const unsigned*)(kp_ + kso[i_]), (LAS unsigned*)(K_lds + (buf_) * SHM_K + (i_ * 8 + wid) * 1024), 16, 0, 0); \
        _Pragma("unroll") for (int i_ = 0; i_ < 2; ++i_) __builtin_amdgcn_global_load_lds((const unsigned*)(vp_ + vso[i_]), (LAS unsigned*)(V_lds + (buf_) * AT_SHM_V + (i_ * 8 + wid) * 1024), 16, 0, 0); } while (0)
#if ATT_DMA
    AT_DMA((NT - 1) * 64, 0);
    asm volatile("s_waitcnt vmcnt(0)" ::: "memory");
    __syncthreads();
#else
    bf16x8 stk[KCH], stv[2];
    const int vk = tid >> 4, vc = (tid & 15) * 8;
#define AT_LOAD(kb_) do { _Pragma("unroll") for (int i_ = 0; i_ < KCH; ++i_) { const int c_ = tid + 512 * i_, row_ = c_ / NCH, cc_ = c_ % NCH; stk[i_] = *(const bf16x8*)(Kg + (size_t)((kb_) + row_) * ldk + cc_ * 8); } \
        _Pragma("unroll") for (int i_ = 0; i_ < 2; ++i_) stv[i_] = *(const bf16x8*)(Vg + (size_t)((kb_) + vk + 32 * i_) * ldv + vc); } while (0)
#define AT_WRITE(buf_) do { _Pragma("unroll") for (int i_ = 0; i_ < KCH; ++i_) { const int c_ = tid + 512 * i_, row_ = c_ / NCH, cc_ = c_ % NCH; \
            *(LAS bf16x8*)(K_lds + (buf_) * SHM_K + row_ * ROWB + ((cc_ * 16) ^ ((row_ & 7) << 4))) = stk[i_]; } \
        _Pragma("unroll") for (int i_ = 0; i_ < 2; ++i_) *(LAS bf16x8*)(V_lds + (buf_) * AT_SHM_V + v_st(vk + 32 * i_, vc)) = stv[i_]; } while (0)
    AT_LOAD((NT - 1) * 64); AT_WRITE(0);
    if (NT > 1) AT_LOAD((NT - 2) * 64);
    __syncthreads();
#endif
    f32x16 o[4];
#pragma unroll
    for (int d = 0; d < 4; ++d)
#pragma unroll
        for (int r = 0; r < 16; ++r) o[d][r] = 0.f;
    float m_reg = -1e30f, l_reg = 0.f, carry = (MODE == 0) ? 1.f : 0.f;
    float cft = 0.f; if (MODE == 1) cft = cfl[trow];
    int koff[4];
#pragma unroll
    for (int dd = 0; dd < 4; ++dd) koff[dd] = r32 * ROWB + ((dd * 32 + hi * 16) ^ ((r32 & 7) << 4));
    const int vbase = (int)(uintptr_t)V_lds + v_rd_base(lane);
    bool wdone = false;
    LAS unsigned* dflag = (LAS unsigned*)(lds + AT_OFF_CF);
    for (int it = 0; it < NT; ++it) {
        const int kb = (NT - 1 - it) * 64, cur = it & 1;
        bool alld = false;
        if (MODE == 0 && it > 0) {
            const LAS unsigned* fp = dflag + ((it - 1) & 1) * 8; const u32x4 f0 = *(const LAS u32x4*)fp, f1 = *(const LAS u32x4*)(fp + 4);
            alld = __builtin_amdgcn_readfirstlane(f0.x & f0.y & f0.z & f0.w & f1.x & f1.y & f1.z & f1.w) != 0u;
        }
        const bool act = (kb <= qlo + 31) && !wdone;
#if ATT_DMA
        if (it + 1 < NT && !alld) AT_DMA(kb - 64, cur ^ 1);
#endif
        if (act) {
            f32x16 p0, p1;
#pragma unroll
            for (int r = 0; r < 16; ++r) { p0[r] = 0.f; p1[r] = 0.f; }
            const LAS unsigned char* kbase = K_lds + cur * SHM_K;
#pragma unroll
            for (int dg = 0; dg < NQ / 4; ++dg) {
                bf16x8 kf0[4], kf1[4];
#pragma unroll
                for (int dd = 0; dd < 4; ++dd) { const LAS unsigned char* a = kbase + koff[dd] + dg * 128; kf0[dd] = *(const LAS bf16x8*)a; kf1[dd] = *(const LAS bf16x8*)(a + 32 * ROWB); }
#pragma unroll
                for (int dd = 0; dd < 4; ++dd) { p0 = __builtin_amdgcn_mfma_f32_32x32x16_bf16(kf0[dd], qr[dg * 4 + dd], p0, 0, 0, 0); p1 = __builtin_amdgcn_mfma_f32_32x32x16_bf16(kf1[dd], qr[dg * 4 + dd], p1, 0, 0, 0); }
                __builtin_amdgcn_sched_barrier(0);
            }
            const int dq = trow - kb - 4 * hi;
            if (MODE == 0) {
                const bool needm = kb + 63 >= qlo;
                f32x16 kA, kB;
#pragma unroll
                for (int r = 0; r < 16; ++r) { p0[r] = fminf(p0[r] * C2, 80.f); p1[r] = fminf(p1[r] * C2, 80.f); }
#pragma unroll
                for (int r = 0; r < 16; ++r) { p0[r] = __builtin_amdgcn_exp2f(p0[r]); p1[r] = __builtin_amdgcn_exp2f(p1[r]); }
                __builtin_amdgcn_sched_barrier(0);
#pragma unroll
                for (int r = 0; r < 16; ++r) { kA[r] = 1.f + p0[r]; kB[r] = 1.f + p1[r]; }
                __builtin_amdgcn_sched_barrier(0);
#pragma unroll
                for (int r = 0; r < 16; ++r) { kA[r] = __builtin_amdgcn_rcpf(kA[r]); kB[r] = __builtin_amdgcn_rcpf(kB[r]); }
                __builtin_amdgcn_sched_barrier(0);
#pragma unroll
                for (int r = 0; r < 16; ++r) { p0[r] *= kA[r]; p1[r] *= kB[r]; }
                if (needm) {
#pragma unroll
                    for (int r = 0; r < 16; ++r) { const int c = (r & 3) + 8 * (r >> 2);
                        if (!(c < dq)) { kA[r] = 1.f; p0[r] = 0.f; } if (!(c + 32 < dq)) { kB[r] = 1.f; p1[r] = 0.f; } }
                }
                __builtin_amdgcn_sched_barrier(0);
                float run = carry;
#pragma unroll
                for (int g = 7; g >= 0; --g) {
                    const float gp = (g < 4) ? (kA[4 * g] * kA[4 * g + 1]) * (kA[4 * g + 2] * kA[4 * g + 3]) : (kB[4 * (g - 4)] * kB[4 * (g - 4) + 1]) * (kB[4 * (g - 4) + 2] * kB[4 * (g - 4) + 3]);
                    auto rr = __builtin_amdgcn_permlane32_swap(__float_as_uint(gp), __float_as_uint(gp), false, false);
                    const float e = __uint_as_float(rr[0]), od = __uint_as_float(rr[1]);
                    const float base = hi ? run : run * od;
                    if (g < 4) { const int b = 4 * g; const float l3 = base, l2 = l3 * kA[b + 3], l1 = l2 * kA[b + 2], l0 = l1 * kA[b + 1];
                        p0[b] *= l0; p0[b + 1] *= l1; p0[b + 2] *= l2; p0[b + 3] *= l3; }
                    else { const int b = 4 * (g - 4); const float l3 = base, l2 = l3 * kB[b + 3], l1 = l2 * kB[b + 2], l0 = l1 * kB[b + 1];
                        p1[b] *= l0; p1[b + 1] *= l1; p1[b + 2] *= l2; p1[b + 3] *= l3; }
                    run *= e * od;
                }
                carry = run;
                __builtin_amdgcn_sched_barrier(0);
            } else {
                if (MODE == 1) {
#pragma unroll
                    for (int g = 0; g < 4; ++g) { const f32x4 c0 = *(const LAS f32x4*)(cfl + kb + 8 * g + 4 * hi), c1 = *(const LAS f32x4*)(cfl + kb + 32 + 8 * g + 4 * hi);
#pragma unroll
                        for (int i = 0; i < 4; ++i) { p0[4 * g + i] = fmaf(p0[4 * g + i], C2, cft - c0[i]); p1[4 * g + i] = fmaf(p1[4 * g + i], C2, cft - c1[i]); } }
                } else {
#pragma unroll
                    for (int r = 0; r < 16; ++r) { p0[r] *= C2; p1[r] *= C2; }
                }
                if (kb + 63 > qlo) {
#pragma unroll
                    for (int r = 0; r < 16; ++r) { const int c = (r & 3) + 8 * (r >> 2); if (!(c <= dq)) p0[r] = -__builtin_inff(); if (!(c + 32 <= dq)) p1[r] = -__builtin_inff(); }
                }
                float pmax = p0[0];
#pragma unroll
                for (int r = 1; r < 16; ++r) pmax = fmaxf(pmax, p0[r]);
#pragma unroll
                for (int r = 0; r < 16; ++r) pmax = fmaxf(pmax, p1[r]);
                { auto rr = __builtin_amdgcn_permlane32_swap(__float_as_uint(pmax), __float_as_uint(pmax), false, false); pmax = fmaxf(__uint_as_float(rr[0]), __uint_as_float(rr[1])); }
                const float mn = fmaxf(m_reg, pmax); const float alpha = __builtin_amdgcn_exp2f(m_reg - mn); m_reg = mn;
                float ps = 0.f;
#pragma unroll
                for (int r = 0; r < 16; ++r) { p0[r] = __builtin_amdgcn_exp2f(p0[r] - mn); p1[r] = __builtin_amdgcn_exp2f(p1[r] - mn); ps += p0[r] + p1[r]; }
                { auto rr = __builtin_amdgcn_permlane32_swap(__float_as_uint(ps), __float_as_uint(ps), false, false); ps = __uint_as_float(rr[0]) + __uint_as_float(rr[1]); }
                l_reg = l_reg * alpha + ps;
                if (__any(alpha < 1.f)) {
                    if (hi == 0) al_l[r32] = alpha;
                    asm volatile("s_waitcnt lgkmcnt(0)" ::: "memory");
#pragma unroll
                    for (int g = 0; g < 4; ++g) { const f32x4 av = *(const LAS f32x4*)(al_l + 8 * g + 4 * hi);
#pragma unroll
                        for (int d = 0; d < 4; ++d)
#pragma unroll
                            for (int i = 0; i < 4; ++i) o[d][4 * g + i] *= av[i]; }
                }
            }
            bf16x8 pa0, pa1, pa2, pa3;
#define PK4(P, B_, OUT) do { unsigned a0 = cvtpk(P[B_+0], P[B_+1]), a1 = cvtpk(P[B_+2], P[B_+3]); unsigned b0 = cvtpk(P[B_+4], P[B_+5]), b1 = cvtpk(P[B_+6], P[B_+7]); \
        auto r0 = __builtin_amdgcn_permlane32_swap(a0, b0, false, false); auto r1 = __builtin_amdgcn_permlane32_swap(a1, b1, false, false); \
        u32x4 w = {r0[0], r1[0], r0[1], r1[1]}; OUT = *reinterpret_cast<bf16x8*>(&w); } while (0)
            PK4(p0, 0, pa0); PK4(p0, 8, pa1); PK4(p1, 0, pa2); PK4(p1, 8, pa3);
#undef PK4
            const int vb0 = vbase + cur * AT_SHM_V;
#define TRRD(dst, off) asm volatile("ds_read_b64_tr_b16 %0, %1 offset:%2" : "=&v"(dst) : "v"(vb0), "i"(off) : "memory")
#define PV_D0(d0) do { s16x4 l0, l1, l2, l3, h0, h1, h2, h3; constexpr int b_ = v_rd_off(d0, 0, 0); \
        TRRD(l0, b_); TRRD(h0, b_ + 2048); TRRD(l1, b_ + 4096); TRRD(h1, b_ + 6144); TRRD(l2, b_ + 8192); TRRD(h2, b_ + 10240); TRRD(l3, b_ + 12288); TRRD(h3, b_ + 14336); \
        asm volatile("s_waitcnt lgkmcnt(0)" ::: "memory"); __builtin_amdgcn_sched_barrier(0); \
        o[d0] = __builtin_amdgcn_mfma_f32_32x32x16_bf16(pa0, (bf16x8){l0[0], l0[1], l0[2], l0[3], h0[0], h0[1], h0[2], h0[3]}, o[d0], 0, 0, 0); \
        o[d0] = __builtin_amdgcn_mfma_f32_32x32x16_bf16(pa1, (bf16x8){l1[0], l1[1], l1[2], l1[3], h1[0], h1[1], h1[2], h1[3]}, o[d0], 0, 0, 0); \
        o[d0] = __builtin_amdgcn_mfma_f32_32x32x16_bf16(pa2, (bf16x8){l2[0], l2[1], l2[2], l2[3], h2[0], h2[1], h2[2], h2[3]}, o[d0], 0, 0, 0); \
        o[d0] = __builtin_amdgcn_mfma_f32_32x32x16_bf16(pa3, (bf16x8){l3[0], l3[1], l3[2], l3[3], h3[0], h3[1], h3[2], h3[3]}, o[d0], 0, 0, 0); } while (0)
            PV_D0(0); PV_D0(1); PV_D0(2); PV_D0(3);
#undef PV_D0
#undef TRRD
        }
        if (MODE == 0) { if (kb <= qlo + 31) wdone = __all(carry < 1e-37f) != 0; if (lane == 0) dflag[(it & 1) * 8 + wid] = wdone ? 1u : 0u; }
#if ATT_DMA
        asm volatile("s_waitcnt vmcnt(0)" ::: "memory");
#else
        if (it + 1 < NT) { AT_WRITE(cur ^ 1); if (it + 2 < NT) AT_LOAD((NT - 3 - it) * 64); }
#endif
        __syncthreads();
    }
#undef AT_DMA
    float rli[16];
    if (MODE != 0) {
        if (hi == 0) li_l[r32] = l_reg;
        asm volatile("s_waitcnt lgkmcnt(0)" ::: "memory");
#pragma unroll
        for (int g = 0; g < 4; ++g) { const f32x4 lv = *(const LAS f32x4*)(li_l + 8 * g + 4 * hi);
#pragma unroll
            for (int i = 0; i < 4; ++i) rli[4 * g + i] = 1.0f / lv[i]; }
    } else {
#pragma unroll
        for (int r = 0; r < 16; ++r) rli[r] = 1.f;
    }
    bf16_t* Ow = Og + (size_t)qlo * ldo;
#pragma unroll
    for (int r = 0; r < 16; ++r) { const int orow = crow(r, hi);
#pragma unroll
        for (int d0 = 0; d0 < 4; ++d0) { const float v = o[d0][r] * rli[r]; const float vn = __shfl_xor(v, 1);
            if ((r32 & 1) == 0) *(unsigned*)(Ow + (size_t)orow * ldo + d0 * 32 + r32) = cvtpk(v, vn); } }
}

template <int DQK, int MODE>
__device__ __forceinline__ void attn_phase(const bf16_t* Qb, int ldq, int hq, const bf16_t* Kb, int ldk, int hk, const bf16_t* Vb, int ldv, int hv, bf16_t* Ob, const float* cf, float C2, LAS unsigned char* lds) {
#ifdef TESTCOPY
    if (MODE == 0) {
        for (size_t i = (size_t)blockIdx.x * 512 + threadIdx.x; i < (size_t)NTOK * DM; i += (size_t)gridDim.x * 512) {
            const float a = __uint_as_float((unsigned)Qb[i] << 16) + __uint_as_float((unsigned)Kb[i] << 16) + __uint_as_float((unsigned)Vb[i] << 16);
            Ob[i] = (bf16_t)(__float_as_uint(sinf(300.f * a)) >> 16); }
        return;
    }
#endif
#ifdef TESTNAN
    for (int i = threadIdx.x; i < LDS_BYTES / 4; i += 512) ((LAS unsigned*)lds)[i] = 0xFFFFFFFFu;
    __syncthreads();
#endif
    for (int w = blockIdx.x; w < 256; w += gridDim.x) {
        const int xcd = w & 7, slot = w >> 3, bh = xcd * 8 + (slot >> 2), y = slot & 3, b = bh >> 4, hd = bh & 15;
        if (MODE == 1) { LAS float* cfl = (LAS float*)(lds + AT_OFF_CF);
            for (int s = threadIdx.x; s < SEQ; s += 512) cfl[s] = cf[(size_t)bh * SEQ + s] * LOG2E;
            __syncthreads(); }
        const bf16_t* Q = Qb + (size_t)b * SEQ * ldq + hd * hq; const bf16_t* K = Kb + (size_t)b * SEQ * ldk + hd * hk; const bf16_t* V = Vb + (size_t)b * SEQ * ldv + hd * hv;
        bf16_t* O = Ob + (size_t)b * SEQ * DM + hd * HD;
        attn_block<DQK, MODE>(Q, ldq, K, ldk, V, ldv, O, DM, (7 - y) * 256, C2, lds);
        attn_block<DQK, MODE>(Q, ldq, K, ldk, V, ldv, O, DM, y * 256, C2, lds);
        __syncthreads();
    }
}

#define XB_TMO      128
#define XB_XCNT(j)  (256  + 64 * (j))
#define XB_XSUB(j)  (1280 + 64 * (j))
#define XB_XGEN(j)  (2304 + 64 * (j))
#define XB_TOP      3328
#define XB_TOPGEN   3392
#define XCD_BAR_WORDS 3456
#define XB_SPIN_CAP (1u << 18)
__device__ __forceinline__ unsigned xb_ld(unsigned* p)              { return __hip_atomic_load(p, __ATOMIC_RELAXED, __HIP_MEMORY_SCOPE_AGENT); }
__device__ __forceinline__ unsigned xb_add(unsigned* p, unsigned v) { return __hip_atomic_fetch_add(p, v, __ATOMIC_RELAXED, __HIP_MEMORY_SCOPE_AGENT); }
__device__ __forceinline__ unsigned xb_xcc_id() { return (unsigned)__builtin_amdgcn_s_getreg((3 << 11) | 20) & 0xFu; }
#define XB_SPIN(cond, bar) do { unsigned _sp = 0; while (cond) { __builtin_amdgcn_s_sleep(1); \
    if ((++_sp & 255u) == 0u) { if (xb_ld(&(bar)[XB_TMO])) break; if (_sp > XB_SPIN_CAP) { atomicAdd(&(bar)[XB_TMO], 1u); break; } } } } while (0)
struct XcdBarrier { unsigned* bar; unsigned x; volatile LAS unsigned* st; };
__device__ __forceinline__ XcdBarrier xcd_barrier_post(unsigned* bar, volatile LAS unsigned* st) {
    XcdBarrier b; b.bar = bar; b.x = xb_xcc_id(); b.st = st;
    if (threadIdx.x == 0) (void)xb_add(&bar[XB_XCNT(b.x)], 1u);
    return b;
}
__device__ __forceinline__ void xcd_barrier_complete(unsigned* bar, unsigned x, unsigned& nloc, unsigned& nx) {
    const unsigned G = gridDim.x * gridDim.y * gridDim.z;
    unsigned sum, cnt, mine, sp = 0u;
    for (;;) {
        sum = 0u; cnt = 0u; mine = 0u;
#pragma unroll
        for (unsigned j = 0; j < 16; ++j) { const unsigned c = xb_ld(&bar[XB_XCNT(j)]); sum += c; cnt += (c > 0u) ? 1u : 0u; mine = (j == x) ? c : mine; }
        if (sum == G) break;
        __builtin_amdgcn_s_sleep(1);
        if ((++sp & 255u) == 0u) { if (xb_ld(&bar[XB_TMO])) break; if (sp > XB_SPIN_CAP) { atomicAdd(&bar[XB_TMO], 1u); break; } }
    }
    nloc = mine > 0u ? mine : 1u; nx = cnt > 0u ? cnt : 1u;
}
__device__ __forceinline__ void xcd_barrier(const XcdBarrier& b) {
    asm volatile("s_waitcnt vmcnt(0)" ::: "memory");
    __syncthreads();
    if (threadIdx.x == 0) {
        unsigned* bar = b.bar;
        __builtin_amdgcn_s_waitcnt(0);
        unsigned nloc = b.st[0], nx = b.st[1];
        if (nloc == 0u) { xcd_barrier_complete(bar, b.x, nloc, nx); b.st[0] = nloc; b.st[1] = nx; }
        const unsigned old = xb_add(&bar[XB_XSUB(b.x)], 1u);
        const unsigned gen = old / nloc;
        if (old + 1u == (gen + 1u) * nloc) {
            __builtin_amdgcn_fence(__ATOMIC_RELEASE, "agent");
            asm volatile("s_waitcnt vmcnt(0)" ::: "memory");
            const unsigned og = xb_add(&bar[XB_TOP], 1u);
            const unsigned tg = og / nx;
            if (og + 1u == (tg + 1u) * nx) xb_add(&bar[XB_TOPGEN], 1u);
            else XB_SPIN(xb_ld(&bar[XB_TOPGEN]) == tg, bar);
            __builtin_amdgcn_fence(__ATOMIC_ACQUIRE, "agent");
            xb_add(&bar[XB_XGEN(b.x)], 1u);
            asm volatile("s_waitcnt vmcnt(0)" ::: "memory");
        } else {
            XB_SPIN(xb_ld(&bar[XB_XGEN(b.x)]) == gen, bar);
            __builtin_amdgcn_fence(__ATOMIC_ACQUIRE, "agent");
            asm volatile("s_waitcnt vmcnt(0)" ::: "memory");
        }
    }
    __syncthreads();
}

#ifndef NLAYERS
#define NLAYERS 4
#endif
constexpr int N_PHASES = 1 + 10 * NLAYERS;
__host__ __device__ inline bool phase_active(int ph) {
    if (ph == 0) return true;
    const int layer = (ph - 1) / 10, s = (ph - 1) % 10, kind = layer % 3;
    if (s == 0 || s == 7) return false;
    if (s == 2) return kind != 0;
    if (s == 3 || s == 4) return kind == 2;
    return true;
}

__global__ void __launch_bounds__(512, 2) fwd_megakernel(Params p) {
    extern __shared__ __attribute__((aligned(16))) unsigned char shm_raw[];
    LAS unsigned char* lds = (LAS unsigned char*)shm_raw;
    unsigned char* ws = p.ws;
    bf16_t* X = (bf16_t*)(ws + WS_X);
    bf16_t* H = (bf16_t*)(ws + WS_H); bf16_t* AO = p.alt ? (bf16_t*)(ws + WS_SCR + (size_t)NTOK * DFF * 2) : (bf16_t*)(ws + WS_AO);
    float* SS = (float*)(ws + WS_SS); float* LOGF = (float*)(ws + WS_LOGF); float* CF = (float*)(ws + WS_CF); float* ROPE = (float*)(ws + WS_ROPE); float* KR = (float*)(ws + WS_KR);
    unsigned char* scr = ws + WS_SCR;
    bool first = true;
#if COOP
    volatile LAS unsigned* st = (volatile LAS unsigned*)(lds + 131072);
    if (threadIdx.x == 0) { st[0] = 0u; st[1] = 0u; }
    __syncthreads();
    const XcdBarrier xb = xcd_barrier_post((unsigned*)(ws + WS_BAR), st);
    int nsync = 0;
#endif
    for (int ph = (int)p.ph_lo; ph < (int)p.ph_hi; ++ph) {
        if (!phase_active(ph)) continue;
#if COOP
        if (!first) { if (nsync == 0) cg::this_grid().sync(); else xcd_barrier(xb); ++nsync; }
#endif
        first = false;
#define CONV_IN(L) do { const int k_ = (L) % 3, j_ = (L) / 3; const float* gm_ = p.mix_norm + (L) * DM; \
            if (k_ == 0) conv_job(lds, p.sb_w_in + (size_t)j_ * 2048 * 6144, 6144, 0, 6144, 6144, 2048, (bf16_t*)(ws + W_SB_IN + j_ * SZ_QKVW), gm_); \
            else if (k_ == 1) { conv_job(lds, p.fox_w_in, 6160, 0, 6144, 6144, 2048, (bf16_t*)(ws + W_FOX_IN), gm_); conv_job(lds, p.fox_w_in, 6160, 6144, 16, 128, 2048, (bf16_t*)(ws + W_FOX_F), gm_); } \
            else conv_job(lds, p.mla_w_in, MLA_DOWN, 0, MLA_DOWN, MLA_DOWN_PAD, 2048, (bf16_t*)(ws + W_MLA_IN), gm_); } while (0)
        if (ph == 0) { if (EN(100)) { CONV_IN(0); xprep_phase(p.x, X, SS); } continue; }
        const int layer = (ph - 1) / 10, s = (ph - 1) % 10, kind = layer % 3, j = layer / 3;
        const void* xin = (layer == 0) ? (const void*)p.x : (const void*)X;
        const int xin_f32 = layer == 0;
        const float* ss1 = SS + (size_t)(2 * layer) * NTOK * 8; const float* ss2 = SS + (size_t)(2 * layer + 1) * NTOK * 8;
        int ng = 0; GemmJob g0{}, g1{}; bool do_fgate = false;
        g0.M = NTOK; g1.M = NTOK;
        if (s == 1) {
            ng = 1; g0.A = X; g0.K = DM;
            if (kind == 2) { g0.Bt = (const bf16_t*)(ws + W_MLA_IN); g0.N = MLA_DOWN_PAD; g0.E = pg8::EpiGen{0, (bf16_t*)(scr + SC_DOWN), MLA_DOWN_PAD, 0, 0, nullptr, nullptr, 0, 0, ss1, nullptr}; }
            else { g0.Bt = (const bf16_t*)(ws + (kind == 0 ? W_SB_IN + j * SZ_QKVW : W_FOX_IN)); g0.N = 3 * DM; g0.E = pg8::EpiGen{0, (bf16_t*)(scr + SC_Q), DM, DM, (size_t)NTOK * DM, nullptr, nullptr, 0, 0, ss1, nullptr}; do_fgate = kind == 1; }
        } else if (s == 2) {
            if (kind == 1) { if (EN(2)) fox_prep_phase((bf16_t*)(scr + SC_Q), p.fox_q_gain, p.fox_k_gain, LOGF, CF); }
            else { if (EN(100)) { conv_job(lds, p.mla_w_uq, 3072, 0, 3072, 3072, 768, (bf16_t*)(ws + W_MLA_UQ)); conv_job(lds, p.mla_w_ukv, 4096, 0, 4096, 4096, 512, (bf16_t*)(ws + W_MLA_UKV)); }
                   if (EN(2)) mla_prep1_phase((const bf16_t*)(scr + SC_DOWN), p.pos, p.mla_q_norm, p.mla_kv_norm, (bf16_t*)(scr + SC_CQ), (bf16_t*)(scr + SC_CKV), ROPE, KR); }
        } else if (s == 3) {
            ng = 2;
            g0.A = (const bf16_t*)(scr + SC_CQ); g0.Bt = (const bf16_t*)(ws + W_MLA_UQ); g0.N = 3072; g0.K = MLA_QR; g0.E = pg8::EpiGen{0, (bf16_t*)(scr + SC_QUP), 3072, 0, 0, nullptr, nullptr, 0, 0, nullptr, nullptr};
            g1.A = (const bf16_t*)(scr + SC_CKV); g1.Bt = (const bf16_t*)(ws + W_MLA_UKV); g1.N = 4096; g1.K = MLA_KVR; g1.E = pg8::EpiGen{0, (bf16_t*)(scr + SC_KV), 4096, 0, 0, nullptr, nullptr, 0, 0, nullptr, nullptr};
        } else if (s == 4) { if (EN(4)) mla_prep2_phase((const bf16_t*)(scr + SC_QUP), (const bf16_t*)(scr + SC_KV), ROPE, KR, p.mla_q_gain, p.mla_k_gain, (bf16_t*)(scr + SC_QN), (bf16_t*)(scr + SC_KN)); }
        else if (s == 5) {
            if (kind == 0) { if (EN(50)) attn_phase<128, TESTMODE2 ? 2 : 0>((const bf16_t*)(scr + SC_Q), DM, HD, (const bf16_t*)(scr + SC_K), DM, HD, (const bf16_t*)(scr + SC_V), DM, HD, AO, nullptr, 0.08838834764831845f * LOG2E, lds); }
            else if (kind == 1) { if (EN(51)) attn_phase<128, 1>((const bf16_t*)(scr + SC_Q), DM, HD, (const bf16_t*)(scr + SC_K), DM, HD, (const bf16_t*)(scr + SC_V), DM, HD, AO, CF, 0.08838834764831845f * LOG2E, lds); }
            else { if (EN(52)) attn_phase<192, 2>((const bf16_t*)(scr + SC_QN), 3072, 192, (const bf16_t*)(scr + SC_KN), 3072, 192, (const bf16_t*)(scr + SC_KV) + 128, 4096, 256, AO, nullptr, 0.07216878364870323f * LOG2E, lds); }
            if (EN(100)) {
                if (kind == 0) conv_job(lds, p.sb_w_out + (size_t)j * 2048 * 2048, 2048, 0, 2048, 2048, 2048, (bf16_t*)(ws + W_SB_OUT + j * SZ_SQW));
                else if (kind == 1) conv_job(lds, p.fox_w_out, 2048, 0, 2048, 2048, 2048, (bf16_t*)(ws + W_FOX_OUT));
                else conv_job(lds, p.mla_w_out, 2048, 0, 2048, 2048, 2048, (bf16_t*)(ws + W_MLA_OUT));
            }
        } else if (s == 6) {
            ng = 1; g0.A = AO; g0.K = DM; g0.N = DM; g0.Bt = (const bf16_t*)(ws + (kind == 0 ? W_SB_OUT + j * SZ_SQW : (kind == 1 ? W_FOX_OUT : W_MLA_OUT)));
            g0.E = pg8::EpiGen{2, nullptr, DM, 0, 0, xin, X, xin_f32, 0, nullptr, SS + (size_t)(2 * layer + 1) * NTOK * 8};
        } else if (s == 8) {
            ng = 1; g0.A = X; g0.K = DM; g0.N = DFF; g0.Bt = (const bf16_t*)(ws + W_W1 + layer * SZ_FFW); g0.E = pg8::EpiGen{1, (bf16_t*)scr, DFF, 0, 0, nullptr, nullptr, 0, 0, ss2, nullptr};
        } else {
            const bool lastl = layer == NLAYERS - 1;
            ng = 1; g0.A = (const bf16_t*)scr; g0.K = DFF; g0.N = DM; g0.Bt = (const bf16_t*)(ws + W_W2 + layer * SZ_FFW);
            g0.E = pg8::EpiGen{2, nullptr, DM, 0, 0, X, lastl ? (void*)p.out : (void*)X, 0, lastl ? 1 : 0, nullptr, lastl ? nullptr : SS + (size_t)(2 * layer + 2) * NTOK * 8};
        }
        if (EN(1)) {
#pragma nounroll
            for (int gi = 0; gi < ng; ++gi) run_gemm(lds, gi ? g1 : g0);
        }
        if (s == 8 && EN(100)) conv_job(lds, p.mlp_w2 + (size_t)layer * 8192 * 2048, 2048, 0, 2048, 2048, 8192, (bf16_t*)(ws + W_W2 + layer * SZ_FFW));
        if (s == 6 && EN(100)) conv_job(lds, p.mlp_w1 + (size_t)layer * 2048 * 8192, 8192, 0, 8192, 8192, 2048, (bf16_t*)(ws + W_W1 + layer * SZ_FFW), p.mlp_norm + layer * DM);
        if (s == 9 && layer + 1 < NLAYERS && EN(100)) CONV_IN(layer + 1);
        if (do_fgate && EN(2)) fgate_phase(X, (const bf16_t*)(ws + W_FOX_F), p.fox_b_f, ss1, LOGF);
    }
}

__global__ void k_cmp(const unsigned* a, const unsigned* b, size_t n, unsigned* cnt) {
    unsigned c = 0;
    for (size_t i = (size_t)blockIdx.x * blockDim.x + threadIdx.x; i < n; i += (size_t)gridDim.x * blockDim.x) c += (a[i] != b[i]) ? 1u : 0u;
    if (c) atomicAdd(cnt, c);
}
__global__ void k_out(float* out, size_t n, const unsigned* cnt) {
    for (size_t i = (size_t)blockIdx.x * blockDim.x + threadIdx.x; i < n; i += (size_t)gridDim.x * blockDim.x) out[i] = 0.f;
    if (blockIdx.x == 0 && threadIdx.x == 0) out[0] = cnt[0] ? 3.0e5f : 1.0e5f;
}
extern "C" void kernel_launch(void* const* d_in, const int* in_sizes, int n_in, void* d_out, int out_size, void* d_ws, size_t ws_size, hipStream_t stream) {
    static int grid = 0;
    if (grid == 0) {
        if (n_in != 21 || out_size != NTOK * DM || ws_size < WS_END) { fprintf(stderr, "kernel_launch: unexpected shapes (n_in %d out %d ws %zu need %zu)\n", n_in, out_size, ws_size, (size_t)WS_END); grid = -1; return; }
        int dev = 0, cus = 0, per_cu = 0;
        hipGetDevice(&dev); hipDeviceGetAttribute(&cus, hipDeviceAttributeMultiprocessorCount, dev);
        if (hipFuncSetAttribute((const void*)fwd_megakernel, hipFuncAttributeMaxDynamicSharedMemorySize, LDS_BYTES) != hipSuccess) { fprintf(stderr, "kernel_launch: hipFuncSetAttribute failed\n"); grid = -1; return; }
        if (hipOccupancyMaxActiveBlocksPerMultiprocessor(&per_cu, (const void*)fwd_megakernel, 512, LDS_BYTES) != hipSuccess || per_cu < 1) { fprintf(stderr, "kernel_launch: occupancy query says %d\n", per_cu); per_cu = 1; }
        (void)hipGetLastError();
        grid = cus * 1;
        if (grid > 256) grid = 256;
    }
    if (grid < 0) return;
    Params p{};
    p.x = (const float*)d_in[0]; p.pos = (const int*)d_in[1]; p.mix_norm = (const float*)d_in[2]; p.mlp_norm = (const float*)d_in[3];
    p.sb_w_in = (const float*)d_in[4]; p.sb_w_out = (const float*)d_in[5]; p.fox_w_in = (const float*)d_in[6]; p.fox_b_f = (const float*)d_in[7];
    p.fox_q_gain = (const float*)d_in[8]; p.fox_k_gain = (const float*)d_in[9]; p.fox_w_out = (const float*)d_in[10];
    p.mla_w_in = (const float*)d_in[11]; p.mla_q_norm = (const float*)d_in[12]; p.mla_kv_norm = (const float*)d_in[13]; p.mla_w_uq = (const float*)d_in[14]; p.mla_w_ukv = (const float*)d_in[15];
    p.mla_q_gain = (const float*)d_in[16]; p.mla_k_gain = (const float*)d_in[17]; p.mla_w_out = (const float*)d_in[18]; p.mlp_w1 = (const float*)d_in[19]; p.mlp_w2 = (const float*)d_in[20];
    p.out = (float*)d_out; p.ws = (unsigned char*)d_ws;
#if COOP
    hipMemsetAsync((char*)d_ws + WS_BAR, 0, 16384, stream);
    p.ph_lo = 0; p.ph_hi = N_PHASES;
    void* args[] = {&p};
    hipError_t e = hipLaunchCooperativeKernel((const void*)fwd_megakernel, dim3(grid), dim3(512), args, LDS_BYTES, stream);
    if (e != hipSuccess) fprintf(stderr, "cooperative launch failed: %s (grid %d)\n", hipGetErrorString(e), grid);
#else
    for (int ph = 0; ph < N_PHASES; ++ph) {
        if (!phase_active(ph)) continue;
        p.ph_lo = ph; p.ph_hi = ph + 1;
        hipLaunchKernelGGL(fwd_megakernel, dim3(grid), dim3(512), LDS_BYTES, stream, p);
#ifdef TESTDUP
        if (ph == 6) { p.alt = 1; hipLaunchKernelGGL(fwd_megakernel, dim3(grid), dim3(512), LDS_BYTES, stream, p); p.alt = 0; }
#endif
    }
#ifdef TESTDUP
    unsigned* cnt = (unsigned*)((char*)d_ws + WS_LOGF);
    hipMemsetAsync(cnt, 0, 4, stream);
    hipLaunchKernelGGL(k_cmp, dim3(1024), dim3(256), 0, stream, (const unsigned*)((char*)d_ws + WS_AO), (const unsigned*)((char*)d_ws + WS_SCR + (size_t)NTOK * DFF * 2), (size_t)NTOK * DM / 2, cnt);
    hipLaunchKernelGGL(k_out, dim3(1024), dim3(256), 0, stream, (float*)d_out, (size_t)NTOK * DM, (const unsigned*)cnt);
#endif
#endif
}
```

```cpp
#include <hip/hip_runtime.h>
#include <hip/hip_cooperative_groups.h>
#include <cstdio>
#include <cstdint>
namespace cg = cooperative_groups;

#ifndef COOP
#define COOP 1
#endif
#ifndef ONLY
#define ONLY -1
#endif
#ifndef ATT_DMA
#define ATT_DMA 1
#endif
#define TESTMODE2 0

#ifndef SKIP
#define SKIP -5
#endif
#define EN(x) ((ONLY < 0 || ONLY == (x)) && (x) != SKIP)

#define LAS __attribute__((address_space(3)))
typedef unsigned short bf16_t;
typedef short bf16x8 __attribute__((ext_vector_type(8)));
typedef short s16x4 __attribute__((ext_vector_type(4)));
typedef float f32x4 __attribute__((ext_vector_type(4)));
typedef float f32x16 __attribute__((ext_vector_type(16)));
typedef unsigned u32x4 __attribute__((ext_vector_type(4)));
typedef unsigned u32x2 __attribute__((ext_vector_type(2)));

constexpr int DM = 2048, NTOK = 8192, SEQ = 2048, NH = 16, HD = 128, DFF = 8192, DEPTH = 4;
constexpr int MLA_QR = 768, MLA_KVR = 512, MLA_ROPE = 64, MLA_QK = 192, MLA_DOWN = 1344, MLA_DOWN_PAD = 1536;
constexpr float EPS = 1e-6f;
constexpr float LOG2E = 1.4426950408889634f;

constexpr size_t SZ_QKVW = (size_t)6144 * 2048 * 2, SZ_SQW = (size_t)2048 * 2048 * 2, SZ_FFW = (size_t)8192 * 2048 * 2;
constexpr size_t W_SB_IN = 0;
constexpr size_t W_SB_OUT = W_SB_IN + 2 * SZ_QKVW;
constexpr size_t W_FOX_IN = W_SB_OUT + 2 * SZ_SQW;
constexpr size_t W_FOX_F = W_FOX_IN + SZ_QKVW;
constexpr size_t W_FOX_OUT = W_FOX_F + (size_t)128 * 2048 * 2;
constexpr size_t W_MLA_IN = W_FOX_OUT + SZ_SQW;
constexpr size_t W_MLA_UQ = W_MLA_IN + (size_t)1536 * 2048 * 2;
constexpr size_t W_MLA_UKV = W_MLA_UQ + (size_t)3072 * 768 * 2;
constexpr size_t W_MLA_OUT = W_MLA_UKV + (size_t)4096 * 512 * 2;
constexpr size_t W_W1 = W_MLA_OUT + SZ_SQW;
constexpr size_t W_W2 = W_W1 + 4 * SZ_FFW;
constexpr size_t WS_X = W_W2 + 4 * SZ_FFW;
constexpr size_t WS_H = WS_X + (size_t)NTOK * DM * 4;
constexpr size_t WS_AO = WS_H + (size_t)NTOK * DM * 2;
constexpr size_t WS_LOGF = WS_AO + (size_t)NTOK * DM * 2;
constexpr size_t WS_CF = WS_LOGF + (size_t)NTOK * 16 * 4;
constexpr size_t WS_ROPE = WS_CF + (size_t)64 * 2048 * 4;
constexpr size_t WS_KR = WS_ROPE + (size_t)NTOK * 64 * 4;
constexpr size_t WS_SCR = WS_KR + (size_t)NTOK * 64 * 4;
constexpr size_t SC_Q = 0, SC_K = (size_t)NTOK * DM * 2, SC_V = 2 * (size_t)NTOK * DM * 2;
constexpr size_t SC_DOWN = 0;
constexpr size_t SC_CQ = SC_DOWN + (size_t)NTOK * MLA_DOWN_PAD * 2;
constexpr size_t SC_CKV = SC_CQ + (size_t)NTOK * MLA_QR * 2;
constexpr size_t SC_QUP = SC_CKV + (size_t)NTOK * MLA_KVR * 2;
constexpr size_t SC_KV = SC_QUP + (size_t)NTOK * 3072 * 2;
constexpr size_t SC_QN = SC_KV + (size_t)NTOK * 4096 * 2;
constexpr size_t SC_KN = SC_QN + (size_t)NTOK * 3072 * 2;
constexpr size_t SC_END = SC_KN + (size_t)NTOK * 3072 * 2;
constexpr size_t WS_BAR = WS_SCR + SC_END;
constexpr size_t WS_SS = WS_BAR + 16384;
constexpr size_t WS_END = WS_SS + (size_t)8 * NTOK * 32 * 4;

constexpr int LDS_BYTES = 131072 + 16 + 4096;

struct Params {
    const float* x; const int* pos; const float* mix_norm; const float* mlp_norm;
    const float* sb_w_in; const float* sb_w_out; const float* fox_w_in; const float* fox_b_f; const float* fox_q_gain; const float* fox_k_gain; const float* fox_w_out;
    const float* mla_w_in; const float* mla_q_norm; const float* mla_kv_norm; const float* mla_w_uq; const float* mla_w_ukv; const float* mla_q_gain; const float* mla_k_gain; const float* mla_w_out;
    const float* mlp_w1; const float* mlp_w2;
    float* out; unsigned char* ws;
    long long ph_lo, ph_hi, alt;
};

__device__ __forceinline__ unsigned cvtpk(float lo, float hi) { unsigned r; asm volatile("v_cvt_pk_bf16_f32 %0, %1, %2" : "=v"(r) : "v"(lo), "v"(hi)); return r; }
__device__ __forceinline__ float bflo(unsigned w) { return __uint_as_float(w << 16); }
__device__ __forceinline__ float bfhi(unsigned w) { return __uint_as_float(w & 0xffff0000u); }
__device__ __forceinline__ int opq(int x) { asm volatile("" : "+v"(x)); return x; }
__device__ __forceinline__ float wave_sum(float v) {
#pragma unroll
    for (int o = 32; o > 0; o >>= 1) v += __shfl_xor(v, o);
    return v;
}
__device__ __forceinline__ float sum16(float v) {
#pragma unroll
    for (int o = 8; o > 0; o >>= 1) v += __shfl_xor(v, o);
    return v;
}

namespace pg8 {
constexpr int BM = 256, BK = 64, HALF = 128, HTB = HALF * BK * 2, STAGE_BYTES = 8 * HTB, NXCD = 8, WGM = 8;
__host__ __device__ __forceinline__ int lds_byte(int r, int c) { const int st = (r >> 4) * 2 + (c >> 5), rr = r & 15, cc = c & 31, ob = rr * 64 + cc * 2; return st * 1024 + (ob ^ (((ob >> 9) & 1) << 5)); }
__host__ __device__ __forceinline__ void stage_rc(int b, int& R, int& C) { const int st = b / 1024, sb = b % 1024, swz = sb ^ (((sb >> 9) & 1) << 5); R = (st >> 1) * 16 + swz / 64; C = (st & 1) * 32 + (swz % 64) / 2; }
__host__ __device__ __forceinline__ int perm32(int rho) { const int n = rho >> 4, i = rho & 15; return 8 * (i >> 2) + 4 * n + (i & 3); }
struct Unit { int pm, pn; };
struct Gemm { const bf16_t* A; const bf16_t* Bt; int M, N, K; };
struct StaticOrder {
    int nM, nN, nwg, G, c;
    __device__ void init(int M, int N, int G_, int c_) { nM = M / BM; nN = N / BM; nwg = nM * nN; G = G_; c = c_; }
    __device__ bool next(int i, Unit& u) const {
        const long L = (long)i * G + c; if (L >= nwg) return false;
        int wgid = (int)L; { const int q = nwg / NXCD, r = nwg % NXCD, xcd = wgid % NXCD, off = wgid / NXCD; wgid = (xcd < r ? xcd * (q + 1) : r * (q + 1) + (xcd - r) * q) + off; }
        const int nig = WGM * nN, gid = wgid / nig, fm = gid * WGM, gsz = (nM - fm) < WGM ? (nM - fm) : WGM;
        u.pm = fm + ((wgid % nig) % gsz); u.pn = (wgid % nig) / gsz; return true;
    }
};
__device__ __forceinline__ float rstd_of(const float* ss, int row) {
    const f32x4* p = (const f32x4*)(ss + (size_t)row * 32); float t = 0.f;
#pragma unroll
    for (int k = 0; k < 8; ++k) { const f32x4 q = p[k]; t += (q[0] + q[1]) + (q[2] + q[3]); }
    return rsqrtf(t * (1.f / DM) + EPS);
}
struct EpiGen {
    int mode; bf16_t* O; int ldc; int split_cols; size_t split_stride; const void* R; void* C; int rf32, cf32;
    const float* SSc;
    float* SSn;
    __device__ __forceinline__ void operator()(const f32x4 (&acc)[2][2][4][2], const Unit& u, int wr, int wc, int fr, int fq, LAS unsigned char* lds, int ui) const {
        const int row0 = u.pm * BM + wr * 64 + fr;
        if (mode == 2) {
            const int col0 = u.pn * BM + wc * 32 + 8 * fq;
            const float* R32 = (const float*)R; const bf16_t* R16 = (const bf16_t*)R; float* C32 = (float*)C; bf16_t* C16 = (bf16_t*)C;
#pragma unroll
            for (int ai = 0; ai < 2; ++ai) {
                float ssq[4] = {0.f, 0.f, 0.f, 0.f};
                if (rf32) {
#pragma unroll
                    for (int mp = 0; mp < 2; ++mp) {
                        f32x4 rv[2][2][2];
#pragma unroll
                        for (int mm = 0; mm < 2; ++mm) { const size_t ro = (size_t)(row0 + ai * HALF + (2 * mp + mm) * 16) * ldc + col0;
#pragma unroll
                            for (int bj = 0; bj < 2; ++bj) { rv[mm][bj][0] = *(const f32x4*)(R32 + ro + bj * HALF); rv[mm][bj][1] = *(const f32x4*)(R32 + ro + bj * HALF + 4); } }
#pragma unroll
                        for (int mm = 0; mm < 2; ++mm) { const int m = 2 * mp + mm; const size_t ro = (size_t)(row0 + ai * HALF + m * 16) * ldc + col0;
#pragma unroll
                            for (int bj = 0; bj < 2; ++bj) { const f32x4 x0 = acc[ai][bj][m][0] + rv[mm][bj][0], x1 = acc[ai][bj][m][1] + rv[mm][bj][1];
                                ssq[m] += (x0[0] * x0[0] + x0[1] * x0[1]) + (x0[2] * x0[2] + x0[3] * x0[3]) + (x1[0] * x1[0] + x1[1] * x1[1]) + (x1[2] * x1[2] + x1[3] * x1[3]);
                                if (cf32) { *(f32x4*)(C32 + ro + bj * HALF) = x0; *(f32x4*)(C32 + ro + bj * HALF + 4) = x1; }
                                else { u32x4 w; w.x = cvtpk(x0[0], x0[1]); w.y = cvtpk(x0[2], x0[3]); w.z = cvtpk(x1[0], x1[1]); w.w = cvtpk(x1[2], x1[3]); *(u32x4*)(C16 + ro + bj * HALF) = w; } } }
                    }
                } else {
                    u32x4 rw[4][2];
#pragma unroll
                    for (int m = 0; m < 4; ++m) { const size_t ro = (size_t)(row0 + ai * HALF + m * 16) * ldc + col0;
#pragma unroll
                        for (int bj = 0; bj < 2; ++bj) rw[m][bj] = *(const u32x4*)(R16 + ro + bj * HALF); }
#pragma unroll
                    for (int m = 0; m < 4; ++m) { const size_t ro = (size_t)(row0 + ai * HALF + m * 16) * ldc + col0;
#pragma unroll
                        for (int bj = 0; bj < 2; ++bj) { const u32x4 r = rw[m][bj];
                            const f32x4 x0 = acc[ai][bj][m][0] + (f32x4){bflo(r.x), bfhi(r.x), bflo(r.y), bfhi(r.y)}, x1 = acc[ai][bj][m][1] + (f32x4){bflo(r.z), bfhi(r.z), bflo(r.w), bfhi(r.w)};
                            ssq[m] += (x0[0] * x0[0] + x0[1] * x0[1]) + (x0[2] * x0[2] + x0[3] * x0[3]) + (x1[0] * x1[0] + x1[1] * x1[1]) + (x1[2] * x1[2] + x1[3] * x1[3]);
                            if (cf32) { *(f32x4*)(C32 + ro + bj * HALF) = x0; *(f32x4*)(C32 + ro + bj * HALF + 4) = x1; }
                            else { u32x4 w; w.x = cvtpk(x0[0], x0[1]); w.y = cvtpk(x0[2], x0[3]); w.z = cvtpk(x1[0], x1[1]); w.w = cvtpk(x1[2], x1[3]); *(u32x4*)(C16 + ro + bj * HALF) = w; } } }
                }
                if (SSn) {
#pragma unroll
                    for (int m = 0; m < 4; ++m) { float t = ssq[m]; t += __shfl_xor(t, 16); t += __shfl_xor(t, 32); if (fq == 0) SSn[(size_t)(row0 + ai * HALF + m * 16) * 32 + u.pn * 4 + wc] = t; }
                }
            }
        } else {
            int colt = u.pn * BM; bf16_t* base = O;
            if (split_cols) { const int t = colt / split_cols; base += (size_t)t * split_stride; colt -= t * split_cols; }
            const int col0 = colt + wc * 32 + 8 * fq; const bool act = mode == 1;
#pragma unroll
            for (int ai = 0; ai < 2; ++ai)
#pragma unroll
                for (int m = 0; m < 4; ++m) { bf16_t* rowp = base + (size_t)(row0 + ai * HALF + m * 16) * ldc + col0;
                    const float rs = SSc ? ((const LAS float*)(lds + 131072 + 16))[ui * 256 + wr * 64 + fr + ai * HALF + m * 16] : 1.f;
#pragma unroll
                    for (int bj = 0; bj < 2; ++bj) { f32x4 v0 = acc[ai][bj][m][0] * rs, v1 = acc[ai][bj][m][1] * rs;
                        if (act) {
#pragma unroll
                            for (int j = 0; j < 4; ++j) { float x = fmaxf(v0[j], 0.f), y = fmaxf(v1[j], 0.f); v0[j] = x * x; v1[j] = y * y; } }
                        u32x4 w; w.x = cvtpk(v0[0], v0[1]); w.y = cvtpk(v0[2], v0[3]); w.z = cvtpk(v1[0], v1[1]); w.w = cvtpk(v1[2], v1[3]);
                        *(u32x4*)(rowp + bj * HALF) = w; } }
        }
    }
};

template <class Epi, class Sched>
__device__ __forceinline__ void gemm_phase(LAS unsigned char* lds, const Gemm g, const Sched& S, const Epi& E) {
    const int tid = opq(threadIdx.x), wid = __builtin_amdgcn_readfirstlane(tid >> 6), lane = tid & 63, wr = wid >> 2, wc = wid & 3, fr = lane & 15, fq = lane >> 4;
    const int K = g.K, nt = K / BK;
    unsigned voffA[2], voffB[2];
#pragma unroll
    for (int i = 0; i < 2; ++i) { int R, C; stage_rc(tid * 16 + i * 8192, R, C); const int Rb = (R & ~31) + perm32(R & 31);
        voffA[i] = (unsigned)(R * K + C) * 2u; voffB[i] = (unsigned)(Rb * K + C) * 2u; }
    const size_t kstep = (size_t)(BK * 2);
    const size_t hstep = (size_t)HALF * K * 2;
    const size_t tstep = 2 * hstep;
    const unsigned ldsw = (unsigned)wid * 1024u;
    const int aoff = lds_byte(wr * 64 + fr, fq * 8), boff = lds_byte(wc * 32 + fr, fq * 8);
#define PG8_SA(b, h) (((b) * 2 + (h)) * HTB)
#define PG8_SB(b, h) ((4 + (b) * 2 + (h)) * HTB)
#define PG8_STAGE(bufoff, gbase, voff) do { _Pragma("unroll") for (int _i = 0; _i < 2; ++_i) \
        __builtin_amdgcn_global_load_lds((const unsigned*)((const char*)(gbase) + (voff)[_i]), (LAS unsigned*)(lds + (bufoff) + ldsw + _i * 8192), 16, 0, 0); } while (0)
#define PG8_LDA(dst, b, h) do { _Pragma("unroll") for (int m = 0; m < 4; ++m) _Pragma("unroll") for (int k = 0; k < 2; ++k) dst[m][k] = *(const LAS bf16x8*)(lds + PG8_SA(b, h) + aoff + m * 2048 + k * 1024); } while (0)
#define PG8_LDB(dst, b, h) do { _Pragma("unroll") for (int n = 0; n < 2; ++n) _Pragma("unroll") for (int k = 0; k < 2; ++k) dst[n][k] = *(const LAS bf16x8*)(lds + PG8_SB(b, h) + boff + n * 2048 + k * 1024); } while (0)
#define PG8_MMA(ai, bj, At, Bt) do { __builtin_amdgcn_s_setprio(1); _Pragma("unroll") for (int m = 0; m < 4; ++m) _Pragma("unroll") for (int n = 0; n < 2; ++n) _Pragma("unroll") for (int k = 0; k < 2; ++k) \
        acc[ai][bj][m][n] = __builtin_amdgcn_mfma_f32_16x16x32_bf16(Bt[n][k], At[m][k], acc[ai][bj][m][n], 0, 0, 0); __builtin_amdgcn_s_setprio(0); } while (0)
#define PG8_WAIT_V(n) asm volatile("s_waitcnt vmcnt(" #n ")" ::: "memory")
#define PG8_WAIT_L(n) asm volatile("s_waitcnt lgkmcnt(" #n ")" ::: "memory")
#define PG8_BAR __builtin_amdgcn_s_barrier()
#define PG8_SCHED __builtin_amdgcn_sched_barrier(0)
    Unit cur, nxt; int ui = 0;
    if (!S.next(0, cur)) return;
    f32x4 acc[2][2][4][2];
#pragma unroll
    for (int a = 0; a < 2; ++a)
#pragma unroll
        for (int b = 0; b < 2; ++b)
#pragma unroll
            for (int m = 0; m < 4; ++m)
#pragma unroll
                for (int n = 0; n < 2; ++n) acc[a][b][m][n] = (f32x4){0.f, 0.f, 0.f, 0.f};
    bf16x8 At[4][2], B0[2][2], B1[2][2];
    const char* cA = (const char*)g.A + (size_t)cur.pm * tstep; const char* cB = (const char*)g.Bt + (size_t)cur.pn * tstep;
    PG8_STAGE(PG8_SB(0, 0), cB, voffB); PG8_STAGE(PG8_SA(0, 0), cA, voffA); PG8_STAGE(PG8_SB(0, 1), cB + hstep, voffB); PG8_STAGE(PG8_SA(0, 1), cA + hstep, voffA);
    if (wr == 1) PG8_BAR;
    PG8_WAIT_V(4); PG8_BAR;
    PG8_STAGE(PG8_SB(1, 0), cB + kstep, voffB); PG8_STAGE(PG8_SA(1, 0), cA + kstep, voffA); PG8_STAGE(PG8_SB(1, 1), cB + hstep + kstep, voffB);
    PG8_WAIT_V(6); PG8_BAR;
    for (;;) {
        const bool has_next = S.next(ui + 1, nxt);
        const char* nA = has_next ? (const char*)g.A + (size_t)nxt.pm * tstep : cA; const char* nB = has_next ? (const char*)g.Bt + (size_t)nxt.pn * tstep : cB;
        for (int t = 0; t < nt; t += 2) {
            const bool last = (t == nt - 2);
            const char* a1 = cA + (size_t)(t + 1) * kstep;
            const char* a2 = last ? nA : cA + (size_t)(t + 2) * kstep; const char* b2 = last ? nB : cB + (size_t)(t + 2) * kstep;
            const char* a3 = a2 + kstep; const char* b3 = b2 + kstep;
            PG8_LDB(B0, 0, 0); PG8_SCHED; PG8_LDA(At, 0, 0); PG8_STAGE(PG8_SA(1, 1), a1 + hstep, voffA);
            PG8_WAIT_L(8); PG8_BAR; PG8_WAIT_L(0); PG8_MMA(0, 0, At, B0); PG8_BAR; PG8_SCHED;
            PG8_LDB(B1, 0, 1); PG8_STAGE(PG8_SB(0, 0), b2, voffB);
            PG8_BAR; PG8_WAIT_L(0); PG8_MMA(0, 1, At, B1); PG8_BAR;
            PG8_LDA(At, 0, 1); PG8_STAGE(PG8_SA(0, 0), a2, voffA);
            PG8_BAR; PG8_WAIT_L(0); PG8_MMA(1, 0, At, B0); PG8_BAR; PG8_SCHED;
            PG8_STAGE(PG8_SB(0, 1), b2 + hstep, voffB);
            PG8_WAIT_V(6); PG8_BAR; PG8_MMA(1, 1, At, B1); PG8_BAR;
            PG8_LDB(B0, 1, 0); PG8_SCHED; PG8_LDA(At, 1, 0); PG8_STAGE(PG8_SA(0, 1), a2 + hstep, voffA);
            PG8_WAIT_L(8); PG8_BAR; PG8_WAIT_L(0); PG8_MMA(0, 0, At, B0); PG8_BAR; PG8_SCHED;
            PG8_LDB(B1, 1, 1); PG8_STAGE(PG8_SB(1, 0), b3, voffB);
            PG8_BAR; PG8_WAIT_L(0); PG8_MMA(0, 1, At, B1); PG8_BAR;
            PG8_LDA(At, 1, 1); PG8_STAGE(PG8_SA(1, 0), a3, voffA);
            PG8_BAR; PG8_WAIT_L(0); PG8_MMA(1, 0, At, B0); PG8_BAR; PG8_SCHED;
            PG8_STAGE(PG8_SB(1, 1), b3 + hstep, voffB);
            PG8_WAIT_V(6); PG8_BAR; PG8_MMA(1, 1, At, B1); PG8_BAR;
        }
        E(acc, cur, wr, wc, fr, fq, lds, ui);
        if (!has_next) break;
#pragma unroll
        for (int a = 0; a < 2; ++a)
#pragma unroll
            for (int b = 0; b < 2; ++b)
#pragma unroll
                for (int m = 0; m < 4; ++m)
#pragma unroll
                    for (int n = 0; n < 2; ++n) acc[a][b][m][n] = (f32x4){0.f, 0.f, 0.f, 0.f};
        cur = nxt; cA = nA; cB = nB; ++ui;
    }
    PG8_WAIT_V(0);
    if (wr == 0) PG8_BAR;
    PG8_BAR;
#undef PG8_SA
#undef PG8_SB
#undef PG8_STAGE
#undef PG8_LDA
#undef PG8_LDB
#undef PG8_MMA
#undef PG8_WAIT_V
#undef PG8_WAIT_L
#undef PG8_BAR
#undef PG8_SCHED
}
}

struct GemmJob { const bf16_t* A; const bf16_t* Bt; int M, N, K; pg8::EpiGen E; };
__device__ __forceinline__ void run_gemm(LAS unsigned char* lds, const GemmJob& j) {
    pg8::Gemm g{j.A, j.Bt, j.M, j.N, j.K};
    pg8::StaticOrder S; S.init(j.M, j.N, (int)gridDim.x, (int)blockIdx.x);
    if (j.E.SSc) {
        LAS float* tbl = (LAS float*)(lds + 131072 + 16); const int tid = opq(threadIdx.x);
        pg8::Unit u;
        for (int i = 0; i < 4 && S.next(i, u); ++i) {
            const int row = u.pm * 256 + (tid >> 1); const f32x4* pp = (const f32x4*)(j.E.SSc + (size_t)row * 32 + (tid & 1) * 16);
            float t = 0.f;
#pragma unroll
            for (int k = 0; k < 4; ++k) { const f32x4 q = pp[k]; t += (q[0] + q[1]) + (q[2] + q[3]); }
            const float o = __shfl_xor(t, 1); const float tot = (tid & 1) ? (o + t) : (t + o);
            if ((tid & 1) == 0) tbl[i * 256 + (tid >> 1)] = rsqrtf(tot * (1.f / DM) + EPS);
        }
        __syncthreads();
    }
    pg8::gemm_phase<pg8::EpiGen, pg8::StaticOrder>(lds, g, S, j.E);
    __syncthreads();
}

__device__ __forceinline__ void conv_job(LAS unsigned char* lds, const float* __restrict__ src, int ldn, int col0, int ncols, int npad, int K, bf16_t* __restrict__ dst, const float* __restrict__ gk = nullptr) {
    constexpr int LR = 132;
    LAS float* T = (LAS float*)lds;
    const int tid = opq(threadIdx.x), n4 = tid & 31, kr = tid >> 5;
    const int rn = tid & 127, rk = tid >> 7;
    const int ntn = npad / 128, ntk = K / 128, ntiles = ntn * ntk;
    f32x4 r[8]; float gq[8];
    int t = blockIdx.x;
#define CONV_LOAD(tt_) do { const int tn_ = (tt_) % ntn, tk_ = (tt_) / ntn; const int n_ = tn_ * 128 + n4 * 4; const bool ok_ = n_ < ncols; \
        const float* p_ = src + (size_t)(tk_ * 128 + kr) * ldn + col0 + (ok_ ? n_ : 0); \
        _Pragma("unroll") for (int j_ = 0; j_ < 8; ++j_) { r[j_] = __builtin_nontemporal_load((const f32x4*)(p_ + (size_t)(16 * j_) * ldn)); if (!ok_) r[j_] = (f32x4){0.f, 0.f, 0.f, 0.f}; gq[j_] = gk ? gk[tk_ * 128 + kr + 16 * j_] : 1.f; } } while (0)
    if (t < ntiles) CONV_LOAD(t);
    for (; t < ntiles; t += gridDim.x) {
        const int tn = t % ntn, tk = t / ntn;
#pragma unroll
        for (int j = 0; j < 8; ++j) *(LAS f32x4*)(T + (kr + 16 * j) * LR + n4 * 4) = r[j] * gq[j];
        if (t + (int)gridDim.x < ntiles) CONV_LOAD(t + (int)gridDim.x);
        __syncthreads();
#pragma unroll
        for (int j = 0; j < 4; ++j) { const int kc = rk + 4 * j; float v[8];
#pragma unroll
            for (int i = 0; i < 8; ++i) v[i] = T[(kc * 8 + i) * LR + rn];
            u32x4 w; w.x = cvtpk(v[0], v[1]); w.y = cvtpk(v[2], v[3]); w.z = cvtpk(v[4], v[5]); w.w = cvtpk(v[6], v[7]);
            *(u32x4*)(dst + (size_t)(tn * 128 + rn) * K + tk * 128 + kc * 8) = w; }
        __syncthreads();
    }
}

__device__ __forceinline__ void xprep_phase(const float* __restrict__ x, bf16_t* __restrict__ xb, float* __restrict__ ss0) {
    const int tid = opq(threadIdx.x), lane = tid & 63, gw = blockIdx.x * 8 + (tid >> 6), nw = gridDim.x * 8;
    for (int row = gw; row < NTOK; row += nw) {
        const float* xr = x + (size_t)row * DM; f32x4 v[8]; float ss = 0.f;
#pragma unroll
        for (int j = 0; j < 8; ++j) { v[j] = *(const f32x4*)(xr + j * 256 + lane * 4); ss += v[j][0] * v[j][0] + v[j][1] * v[j][1] + v[j][2] * v[j][2] + v[j][3] * v[j][3]; }
        ss = wave_sum(ss); if (lane < 32) ss0[(size_t)row * 32 + lane] = lane == 0 ? ss : 0.f;
#pragma unroll
        for (int j = 0; j < 8; ++j) { u32x2 w; w.x = cvtpk(v[j][0], v[j][1]); w.y = cvtpk(v[j][2], v[j][3]); *(u32x2*)(xb + (size_t)row * DM + j * 256 + lane * 4) = w; }
    }
}

__device__ __forceinline__ void fgate_phase(const bf16_t* __restrict__ h, const bf16_t* __restrict__ wft, const float* __restrict__ bfv, const float* __restrict__ ssc, float* __restrict__ logf) {
    const int tid = opq(threadIdx.x), lane = tid & 63, gw = blockIdx.x * 8 + (tid >> 6), nw = gridDim.x * 8;
    const int fr = lane & 15, fq = lane >> 4;
    if ((gw & 3) != 0) return;
    for (int job = gw >> 2; job < NTOK / 16; job += (nw >> 2)) {
        const bf16_t* ap = h + (size_t)(job * 16 + fr) * DM + fq * 8; const bf16_t* bp = wft + (size_t)fr * DM + fq * 8;
        f32x4 acc = {0.f, 0.f, 0.f, 0.f};
#pragma unroll 8
        for (int k = 0; k < DM; k += 32) { const bf16x8 a = *(const bf16x8*)(ap + k), b = *(const bf16x8*)(bp + k); acc = __builtin_amdgcn_mfma_f32_16x16x32_bf16(a, b, acc, 0, 0, 0); }
        const float bb = bfv[fr];
#pragma unroll
        for (int j = 0; j < 4; ++j) { const float u = acc[j] * pg8::rstd_of(ssc, job * 16 + fq * 4 + j) + bb; logf[(size_t)(job * 16 + fq * 4 + j) * 16 + fr] = -(fmaxf(-u, 0.f) + log1pf(__expf(-fabsf(u)))); }
    }
}

__device__ __forceinline__ void fox_prep_phase(bf16_t* __restrict__ qk  , const float* __restrict__ qg, const float* __restrict__ kg, const float* __restrict__ logf, float* __restrict__ cf) {
    const int tid = opq(threadIdx.x), lane = tid & 63, gw = blockIdx.x * 8 + (tid >> 6), nw = gridDim.x * 8;
    const int sub = lane >> 4, l16 = lane & 15;
    const int nrows = 2 * NTOK * NH;
    for (int r0 = gw * 4; r0 < nrows; r0 += nw * 4) {
        const int row = r0 + sub; const bool isk = row >= NTOK * NH;
        bf16_t* p = qk + (size_t)row * HD + l16 * 8;
        const u32x4 w = *(const u32x4*)p; float v[8] = {bflo(w.x), bfhi(w.x), bflo(w.y), bfhi(w.y), bflo(w.z), bfhi(w.z), bflo(w.w), bfhi(w.w)};
        float ss = 0.f;
#pragma unroll
        for (int i = 0; i < 8; ++i) ss += v[i] * v[i];
        ss = sum16(ss); const float rs = rsqrtf(ss * (1.f / HD) + EPS);
        const float* gp = (isk ? kg : qg) + l16 * 8; const f32x4 g0 = *(const f32x4*)gp, g1 = *(const f32x4*)(gp + 4);
        u32x4 o; o.x = cvtpk(v[0] * rs * g0[0], v[1] * rs * g0[1]); o.y = cvtpk(v[2] * rs * g0[2], v[3] * rs * g0[3]);
        o.z = cvtpk(v[4] * rs * g1[0], v[5] * rs * g1[1]); o.w = cvtpk(v[6] * rs * g1[2], v[7] * rs * g1[3]);
        *(u32x4*)p = o;
    }
    for (int bh = blockIdx.x; bh < 64; bh += gridDim.x) {
        if ((threadIdx.x >> 6) != 0) continue;
        const int b = bh >> 4, hd = bh & 15; const float* lp = logf + (size_t)(b * SEQ + lane * 32) * 16 + hd;
        float v[32]; float tot = 0.f;
#pragma unroll
        for (int i = 0; i < 32; ++i) { tot += lp[(size_t)i * 16]; v[i] = tot; }
        float inc = tot;
#pragma unroll
        for (int o = 1; o < 64; o <<= 1) { const float up = __shfl_up(inc, o); if (lane >= o) inc += up; }
        const float base = inc - tot;
        float* cp = cf + (size_t)bh * SEQ + lane * 32;
#pragma unroll
        for (int i = 0; i < 32; ++i) cp[i] = base + v[i];
    }
}

__device__ __forceinline__ void mla_prep1_phase(const bf16_t* __restrict__ down, const int* __restrict__ pos, const float* __restrict__ qn, const float* __restrict__ kvn,
                                                bf16_t* __restrict__ cq, bf16_t* __restrict__ ckv, float* __restrict__ ropet, float* __restrict__ kr) {
    const int tid = opq(threadIdx.x), lane = tid & 63, gw = blockIdx.x * 8 + (tid >> 6), nw = gridDim.x * 8;
    for (int row = gw; row < NTOK; row += nw) {
        const bf16_t* dr = down + (size_t)row * MLA_DOWN_PAD;
        {   float v[12]; float ss = 0.f;
#pragma unroll
            for (int j = 0; j < 3; ++j) { const u32x2 w = *(const u32x2*)(dr + j * 256 + lane * 4); v[4 * j] = bflo(w.x); v[4 * j + 1] = bfhi(w.x); v[4 * j + 2] = bflo(w.y); v[4 * j + 3] = bfhi(w.y); }
#pragma unroll
            for (int i = 0; i < 12; ++i) ss += v[i] * v[i];
            ss = wave_sum(ss); const float rs = rsqrtf(ss * (1.f / MLA_QR) + EPS);
#pragma unroll
            for (int j = 0; j < 3; ++j) { const f32x4 g = *(const f32x4*)(qn + j * 256 + lane * 4);
                u32x2 w; w.x = cvtpk(v[4 * j] * rs * g[0], v[4 * j + 1] * rs * g[1]); w.y = cvtpk(v[4 * j + 2] * rs * g[2], v[4 * j + 3] * rs * g[3]);
                *(u32x2*)(cq + (size_t)row * MLA_QR + j * 256 + lane * 4) = w; } }
        {   float v[8]; float ss = 0.f;
#pragma unroll
            for (int j = 0; j < 2; ++j) { const u32x2 w = *(const u32x2*)(dr + MLA_QR + j * 256 + lane * 4); v[4 * j] = bflo(w.x); v[4 * j + 1] = bfhi(w.x); v[4 * j + 2] = bflo(w.y); v[4 * j + 3] = bfhi(w.y); }
#pragma unroll
            for (int i = 0; i < 8; ++i) ss += v[i] * v[i];
            ss = wave_sum(ss); const float rs = rsqrtf(ss * (1.f / MLA_KVR) + EPS);
#pragma unroll
            for (int j = 0; j < 2; ++j) { const f32x4 g = *(const f32x4*)(kvn + j * 256 + lane * 4);
                u32x2 w; w.x = cvtpk(v[4 * j] * rs * g[0], v[4 * j + 1] * rs * g[1]); w.y = cvtpk(v[4 * j + 2] * rs * g[2], v[4 * j + 3] * rs * g[3]);
                *(u32x2*)(ckv + (size_t)row * MLA_KVR + j * 256 + lane * 4) = w; } }
        if (lane < 32) {
            const float invf = powf(10000.0f, -(float)(2 * lane) / 64.0f);
            const float ang = (float)pos[row] * invf; const float cs = cosf(ang), sn = sinf(ang);
            ropet[(size_t)row * 64 + lane] = cs; ropet[(size_t)row * 64 + 32 + lane] = sn;
            const float x1 = __uint_as_float((unsigned)dr[MLA_QR + MLA_KVR + lane] << 16), x2 = __uint_as_float((unsigned)dr[MLA_QR + MLA_KVR + 32 + lane] << 16);
            kr[(size_t)row * 64 + lane] = x1 * cs - x2 * sn; kr[(size_t)row * 64 + 32 + lane] = x1 * sn + x2 * cs;
        }
    }
}

__device__ __forceinline__ void mla_prep2_phase(const bf16_t* __restrict__ qup, const bf16_t* __restrict__ kv, const float* __restrict__ ropet, const float* __restrict__ kr,
                                                const float* __restrict__ qg, const float* __restrict__ kg, bf16_t* __restrict__ Qn, bf16_t* __restrict__ Kn) {
    const int tid = opq(threadIdx.x), lane = tid & 63, gw = blockIdx.x * 8 + (tid >> 6), nw = gridDim.x * 8;
    const int sub = lane >> 4, j = lane & 15;
    const int nrows = 2 * NTOK * NH;
    for (int r0 = gw * 4; r0 < nrows; r0 += nw * 4) {
        int row = r0 + sub; const bool isk = row >= NTOK * NH; if (isk) row -= NTOK * NH;
        const int tok = row >> 4, hd = row & 15;
        float v[8], ra[2], rb[2];
        if (!isk) {
            const bf16_t* p = qup + (size_t)tok * 3072 + hd * 192;
            const u32x4 w = *(const u32x4*)(p + j * 8);
            v[0] = bflo(w.x); v[1] = bfhi(w.x); v[2] = bflo(w.y); v[3] = bfhi(w.y); v[4] = bflo(w.z); v[5] = bfhi(w.z); v[6] = bflo(w.w); v[7] = bfhi(w.w);
            const unsigned w1 = *(const unsigned*)(p + 128 + 2 * j), w2 = *(const unsigned*)(p + 160 + 2 * j);
            const float x1a = bflo(w1), x1b = bfhi(w1), x2a = bflo(w2), x2b = bfhi(w2);
            const float* rt = ropet + (size_t)tok * 64; const float c0 = rt[2 * j], c1 = rt[2 * j + 1], s0 = rt[32 + 2 * j], s1 = rt[32 + 2 * j + 1];
            ra[0] = x1a * c0 - x2a * s0; ra[1] = x1b * c1 - x2b * s1; rb[0] = x1a * s0 + x2a * c0; rb[1] = x1b * s1 + x2b * c1;
        } else {
            const bf16_t* p = kv + (size_t)tok * 4096 + hd * 256;
            const u32x4 w = *(const u32x4*)(p + j * 8);
            v[0] = bflo(w.x); v[1] = bfhi(w.x); v[2] = bflo(w.y); v[3] = bfhi(w.y); v[4] = bflo(w.z); v[5] = bfhi(w.z); v[6] = bflo(w.w); v[7] = bfhi(w.w);
            const float* kp = kr + (size_t)tok * 64; ra[0] = kp[2 * j]; ra[1] = kp[2 * j + 1]; rb[0] = kp[32 + 2 * j]; rb[1] = kp[32 + 2 * j + 1];
        }
        float ss = ra[0] * ra[0] + ra[1] * ra[1] + rb[0] * rb[0] + rb[1] * rb[1];
#pragma unroll
        for (int i = 0; i < 8; ++i) ss += v[i] * v[i];
        ss = sum16(ss); const float rs = rsqrtf(ss * (1.f / MLA_QK) + EPS);
        const float* g = isk ? kg : qg; const f32x4 g0 = *(const f32x4*)(g + j * 8), g1 = *(const f32x4*)(g + j * 8 + 4);
        bf16_t* o = (isk ? Kn : Qn) + (size_t)tok * 3072 + hd * 192;
        u32x4 ow; ow.x = cvtpk(v[0] * rs * g0[0], v[1] * rs * g0[1]); ow.y = cvtpk(v[2] * rs * g0[2], v[3] * rs * g0[3]);
        ow.z = cvtpk(v[4] * rs * g1[0], v[5] * rs * g1[1]); ow.w = cvtpk(v[6] * rs * g1[2], v[7] * rs * g1[3]);
        *(u32x4*)(o + j * 8) = ow;
        *(unsigned*)(o + 128 + 2 * j) = cvtpk(ra[0] * rs * g[128 + 2 * j], ra[1] * rs * g[128 + 2 * j + 1]);
        *(unsigned*)(o + 160 + 2 * j) = cvtpk(rb[0] * rs * g[160 + 2 * j], rb[1] * rs * g[160 + 2 * j + 1]);
    }
}

__device__ __forceinline__ int v_st(int k, int c) { const int kk = (k & ~0xC) | ((k & 4) << 1) | ((k & 8) >> 1); return ((kk >> 3) * 4 + (c >> 5)) * 512 + ((kk & 7) * 32 + (c & 31)) * 2; }
__device__ __forceinline__ int v_rd_base(int lane) { return ((lane & 3) << 3) | (((lane >> 2) & 3) << 6) | (((lane >> 4) & 1) << 5) | (((lane >> 5) & 1) << 8); }
constexpr int v_rd_off(int d0, int ks, int half) { return d0 * 512 + ks * 4096 + half * 2048; }
__device__ __forceinline__ int crow(int r, int hi) { return (r & 3) + 8 * (r >> 2) + 4 * hi; }

constexpr int AT_SHM_V = 16384, AT_KBUF = 24576;
constexpr int AT_OFF_K = 2 * AT_SHM_V, AT_OFF_WS = AT_OFF_K + 2 * AT_KBUF, AT_OFF_CF = AT_OFF_WS + 2048;

#ifdef TESTB
#define SB_LG(y) fmaxf(1.f - 0.5f * fabsf(y), 0.f)
#else
#define SB_LG(y) __builtin_amdgcn_logf(1.f + __builtin_amdgcn_exp2f(-fabsf(y)))
#endif
#ifndef SB_BLOCK_EXIT
#define SB_BLOCK_EXIT 0
#endif
template <int DQK, int MODE>
__device__ __forceinline__ void attn_block(const bf16_t* __restrict__ Qg, int ldq, const bf16_t* __restrict__ Kg, int ldk, const bf16_t* __restrict__ Vg, int ldv,
                                           bf16_t* __restrict__ Og, int ldo, int q0, float C2, LAS unsigned char* lds) {
    constexpr int NQ = DQK / 16, ROWB = DQK * 2, SHM_K = 64 * ROWB, NCH = DQK / 8, KCH = NCH / 8;
    const int tid = opq(threadIdx.x), wid = __builtin_amdgcn_readfirstlane(tid >> 6), lane = tid & 63, r32 = lane & 31, hi = lane >> 5;
    LAS unsigned char* V_lds = lds; LAS unsigned char* K_lds = lds + AT_OFF_K;
    LAS float* li_l = (LAS float*)(lds + AT_OFF_WS) + wid * 64; LAS float* al_l = li_l + 32;
    const LAS float* cfl = (const LAS float*)(lds + AT_OFF_CF);
    const int qlo = q0 + wid * 32, trow = qlo + r32;
    bf16x8 qr[NQ];
#pragma unroll
    for (int d0 = 0; d0 < NQ; ++d0) qr[d0] = *(const bf16x8*)(Qg + (size_t)trow * ldq + d0 * 16 + hi * 8);
    const int NT = q0 / 64 + 4;
    int kso[KCH], vso[2];
#pragma unroll
    for (int i = 0; i < KCH; ++i) { const int L = (i * 8 + wid) * 1024 + lane * 16, row = L / ROWB, wi = L % ROWB; kso[i] = row * ldk + ((wi ^ ((row & 7) << 4)) >> 1); }
#pragma unroll
    for (int i = 0; i < 2; ++i) { const int L = (i * 8 + wid) * 1024 + lane * 16, sub = L >> 9, we = (L & 511) >> 1, kk = (sub >> 2) * 8 + (we >> 5), c = (sub & 3) * 32 + (we & 31);
        const int k = (kk & ~0xC) | ((kk & 4) << 1) | ((kk & 8) >> 1); vso[i] = k * ldv + c; }
#define AT_DMA(kb_, buf_) do { const bf16_t* kp_ = Kg + (size_t)(kb_) * ldk; const bf16_t* vp_ = Vg + (size_t)(kb_) * ldv; \
        _Pragma("unroll") for (int i_ = 0; i_ < KCH; ++i_) __builtin_amdgcn_global_load_lds((const unsigned*)(kp_ + kso[i_]), (LAS unsigned*)(K_lds + (buf_) * SHM_K + (i_ * 8 + wid) * 1024), 16, 0, 0); \
        _Pragma("unroll") for (int i_ = 0; i_ < 2; ++i_) __builtin_amdgcn_global_load_lds((const unsigned*)(vp_ + vso[i_]), (LAS unsigned*)(V_lds + (buf_) * AT_SHM_V + (i_ * 8 + wid) * 1024), 16, 0, 0); } while (0)
#if ATT_DMA
    AT_DMA((NT - 1) * 64, 0);
    asm volatile("s_waitcnt vmcnt(0)" ::: "memory");
    __syncthreads();
#else
    bf16x8 stk[KCH], stv[2];
    const int vk = tid >> 4, vc = (tid & 15) * 8;
#define AT_LOAD(kb_) do { _Pragma("unroll") for (int i_ = 0; i_ < KCH; ++i_) { const int c_ = tid + 512 * i_, row_ = c_ / NCH, cc_ = c_ % NCH; stk[i_] = *(const bf16x8*)(Kg + (size_t)((kb_) + row_) * ldk + cc_ * 8); } \
        _Pragma("unroll") for (int i_ = 0; i_ < 2; ++i_) stv[i_] = *(const bf16x8*)(Vg + (size_t)((kb_) + vk + 32 * i_) * ldv + vc); } while (0)
#define AT_WRITE(buf_) do { _Pragma("unroll") for (int i_ = 0; i_ < KCH; ++i_) { const int c_ = tid + 512 * i_, row_ = c_ / NCH, cc_ = c_ % NCH; \
            *(LAS bf16x8*)(K_lds + (buf_) * SHM_K + row_ * ROWB + ((cc_ * 16) ^ ((row_ & 7) << 4))) = stk[i_]; } \
        _Pragma("unroll") for (int i_ = 0; i_ < 2; ++i_) *(LAS bf16x8*)(V_lds + (buf_) * AT_SHM_V + v_st(vk + 32 * i_, vc)) = stv[i_]; } while (0)
    AT_LOAD((NT - 1) * 64); AT_WRITE(0);
    if (NT > 1) AT_LOAD((NT - 2) * 64);
    __syncthreads();
#endif
    f32x16 o[4];
#pragma unroll
    for (int d = 0; d < 4; ++d)
#pragma unroll
        for (int r = 0; r < 16; ++r) o[d][r] = 0.f;
    float m_reg = -1e30f, l_reg = 0.f, carry = (MODE == 0) ? 1.f : 0.f;
    float cft = 0.f; if (MODE == 1) cft = cfl[trow];
    int koff[4];
#pragma unroll
    for (int dd = 0; dd < 4; ++dd) koff[dd] = r32 * ROWB + ((dd * 32 + hi * 16) ^ ((r32 & 7) << 4));
    const int vbase = (int)(uintptr_t)V_lds + v_rd_base(lane);
    bool wdone = false;
    LAS unsigned* dflag = (LAS unsigned*)(lds + AT_OFF_CF);
    for (int it = 0; it < NT; ++it) {
        const int kb = (NT - 1 - it) * 64, cur = it & 1;
        bool alld = false;
        if (MODE == 0 && it > 0) {
            const LAS unsigned* fp = dflag + ((it - 1) & 1) * 8; const u32x4 f0 = *(const LAS u32x4*)fp, f1 = *(const LAS u32x4*)(fp + 4);
            alld = __builtin_amdgcn_readfirstlane(f0.x & f0.y & f0.z & f0.w & f1.x & f1.y & f1.z & f1.w) != 0u;
        }
        const bool act = (kb <= qlo + 31) && !wdone;
#if ATT_DMA
        if (it + 1 < NT && !alld) AT_DMA(kb - 64, cur ^ 1);
#endif
        if (act) {
            f32x16 p0, p1;
#pragma unroll
            for (int r = 0; r < 16; ++r) { p0[r] = 0.f; p1[r] = 0.f; }
            const LAS unsigned char* kbase = K_lds + cur * SHM_K;
#pragma unroll
            for (int dg = 0; dg < NQ / 4; ++dg) {
                bf16x8 kf0[4], kf1[4];
#pragma unroll
                for (int dd = 0; dd < 4; ++dd) { const LAS unsigned char* a = kbase + koff[dd] + dg * 128; kf0[dd] = *(const LAS bf16x8*)a; kf1[dd] = *(const LAS bf16x8*)(a + 32 * ROWB); }
#pragma unroll
                for (int dd = 0; dd < 4; ++dd) { p0 = __builtin_amdgcn_mfma_f32_32x32x16_bf16(kf0[dd], qr[dg * 4 + dd], p0, 0, 0, 0); p1 = __builtin_amdgcn_mfma_f32_32x32x16_bf16(kf1[dd], qr[dg * 4 + dd], p1, 0, 0, 0); }
                __builtin_amdgcn_sched_barrier(0);
            }
            const int dq = trow - kb - 4 * hi;
            if (MODE == 0) {
                const bool needm = kb + 63 >= qlo;
                f32x16 kA, kB;
#pragma unroll
                for (int r = 0; r < 16; ++r) { p0[r] = fminf(p0[r] * C2, 80.f); p1[r] = fminf(p1[r] * C2, 80.f); }
#pragma unroll
                for (int r = 0; r < 16; ++r) { p0[r] = __builtin_amdgcn_exp2f(p0[r]); p1[r] = __builtin_amdgcn_exp2f(p1[r]); }
                __builtin_amdgcn_sched_barrier(0);
#pragma unroll
                for (int r = 0; r < 16; ++r) { kA[r] = 1.f + p0[r]; kB[r] = 1.f + p1[r]; }
                __builtin_amdgcn_sched_barrier(0);
#pragma unroll
                for (int r = 0; r < 16; ++r) { kA[r] = __builtin_amdgcn_rcpf(kA[r]); kB[r] = __builtin_amdgcn_rcpf(kB[r]); }
                __builtin_amdgcn_sched_barrier(0);
#pragma unroll
                for (int r = 0; r < 16; ++r) { p0[r] *= kA[r]; p1[r] *= kB[r]; }
                if (needm) {
#pragma unroll
                    for (int r = 0; r < 16; ++r) { const int c = (r & 3) + 8 * (r >> 2);
                        if (!(c < dq)) { kA[r] = 1.f; p0[r] = 0.f; } if (!(c + 32 < dq)) { kB[r] = 1.f; p1[r] = 0.f; } }
                }
                __builtin_amdgcn_sched_barrier(0);
                float run = carry;
#pragma unroll
                for (int g = 7; g >= 0; --g) {
                    const float gp = (g < 4) ? (kA[4 * g] * kA[4 * g + 1]) * (kA[4 * g + 2] * kA[4 * g + 3]) : (kB[4 * (g - 4)] * kB[4 * (g - 4) + 1]) * (kB[4 * (g - 4) + 2] * kB[4 * (g - 4) + 3]);
                    auto rr = __builtin_amdgcn_permlane32_swap(__float_as_uint(gp), __float_as_uint(gp), false, false);
                    const float e = __uint_as_float(rr[0]), od = __uint_as_float(rr[1]);
                    const float base = hi ? run : run * od;
                    if (g < 4) { const int b = 4 * g; const float l3 = base, l2 = l3 * kA[b + 3], l1 = l2 * kA[b + 2], l0 = l1 * kA[b + 1];
                        p0[b] *= l0; p0[b + 1] *= l1; p0[b + 2] *= l2; p0[b + 3] *= l3; }
                    else { const int b = 4 * (g - 4); const float l3 = base, l2 = l3 * kB[b + 3], l1 = l2 * kB[b + 2], l0 = l1 * kB[b + 1];
                        p1[b] *= l0; p1[b + 1] *= l1; p1[b + 2] *= l2; p1[b + 3] *= l3; }
                    run *= e * od;
                }
                carry = run;
                __builtin_amdgcn_sched_barrier(0);
            } else {
                if (MODE == 1) {
#pragma unroll
                    for (int g = 0; g < 4; ++g) { const f32x4 c0 = *(const LAS f32x4*)(cfl + kb + 8 * g + 4 * hi), c1 = *(const LAS f32x4*)(cfl + kb + 32 + 8 * g + 4 * hi);
#pragma unroll
                        for (int i = 0; i < 4; ++i) { p0[4 * g + i] = fmaf(p0[4 * g + i], C2, cft - c0[i]); p1[4 * g + i] = fmaf(p1[4 * g + i], C2, cft - c1[i]); } }
                } else {
#pragma unroll
                    for (int r = 0; r < 16; ++r) { p0[r] *= C2; p1[r] *= C2; }
                }
                if (kb + 63 > qlo) {
#pragma unroll
                    for (int r = 0; r < 16; ++r) { const int c = (r & 3) + 8 * (r >> 2); if (!(c <= dq)) p0[r] = -__builtin_inff(); if (!(c + 32 <= dq)) p1[r] = -__builtin_inff(); }
                }
                float pmax = p0[0];
#pragma unroll
                for (int r = 1; r < 16; ++r) pmax = fmaxf(pmax, p0[r]);
#pragma unroll
                for (int r = 0; r < 16; ++r) pmax = fmaxf(pmax, p1[r]);
                { auto rr = __builtin_amdgcn_permlane32_swap(__float_as_uint(pmax), __float_as_uint(pmax), false, false); pmax = fmaxf(__uint_as_float(rr[0]), __uint_as_float(rr[1])); }
                const float mn = fmaxf(m_reg, pmax); const float alpha = __builtin_amdgcn_exp2f(m_reg - mn); m_reg = mn;
                float ps = 0.f;
#pragma unroll
                for (int r = 0; r < 16; ++r) { p0[r] = __builtin_amdgcn_exp2f(p0[r] - mn); p1[r] = __builtin_amdgcn_exp2f(p1[r] - mn); ps += p0[r] + p1[r]; }
                { auto rr = __builtin_amdgcn_permlane32_swap(__float_as_uint(ps), __float_as_uint(ps), false, false); ps = __uint_as_float(rr[0]) + __uint_as_float(rr[1]); }
                l_reg = l_reg * alpha + ps;
                if (__any(alpha < 1.f)) {
                    if (hi == 0) al_l[r32] = alpha;
                    asm volatile("s_waitcnt lgkmcnt(0)" ::: "memory");
#pragma unroll
                    for (int g = 0; g < 4; ++g) { const f32x4 av = *(const LAS f32x4*)(al_l + 8 * g + 4 * hi);
#pragma unroll
                        for (int d = 0; d < 4; ++d)
#pragma unroll
                            for (int i = 0; i < 4; ++i) o[d][4 * g + i] *= av[i]; }
                }
            }
            bf16x8 pa0, pa1, pa2, pa3;
#define PK4(P, B_, OUT) do { unsigned a0 = cvtpk(P[B_+0], P[B_+1]), a1 = cvtpk(P[B_+2], P[B_+3]); unsigned b0 = cvtpk(P[B_+4], P[B_+5]), b1 = cvtpk(P[B_+6], P[B_+7]); \
        auto r0 = __builtin_amdgcn_permlane32_swap(a0, b0, false, false); auto r1 = __builtin_amdgcn_permlane32_swap(a1, b1, false, false); \
        u32x4 w = {r0[0], r1[0], r0[1], r1[1]}; OUT = *reinterpret_cast<bf16x8*>(&w); } while (0)
            PK4(p0, 0, pa0); PK4(p0, 8, pa1); PK4(p1, 0, pa2); PK4(p1, 8, pa3);
#undef PK4
            const int vb0 = vbase + cur * AT_SHM_V;
#define TRRD(dst, off) asm volatile("ds_read_b64_tr_b16 %0, %1 offset:%2" : "=&v"(dst) : "v"(vb0), "i"(off) : "memory")
#define PV_D0(d0) do { s16x4 l0, l1, l2, l3, h0, h1, h2, h3; constexpr int b_ = v_rd_off(d0, 0, 0); \
        TRRD(l0, b_); TRRD(h0, b_ + 2048); TRRD(l1, b_ + 4096); TRRD(h1, b_ + 6144); TRRD(l2, b_ + 8192); TRRD(h2, b_ + 10240); TRRD(l3, b_ + 12288); TRRD(h3, b_ + 14336); \
        asm volatile("s_waitcnt lgkmcnt(0)" ::: "memory"); __builtin_amdgcn_sched_barrier(0); \
        o[d0] = __builtin_amdgcn_mfma_f32_32x32x16_bf16(pa0, (bf16x8){l0[0], l0[1], l0[2], l0[3], h0[0], h0[1], h0[2], h0[3]}, o[d0], 0, 0, 0); \
        o[d0] = __builtin_amdgcn_mfma_f32_32x32x16_bf16(pa1, (bf16x8){l1[0], l1[1], l1[2], l1[3], h1[0], h1[1], h1[2], h1[3]}, o[d0], 0, 0, 0); \
        o[d0] = __builtin_amdgcn_mfma_f32_32x32x16_bf16(pa2, (bf16x8){l2[0], l2[1], l2[2], l2[3], h2[0], h2[1], h2[2], h2[3]}, o[d0], 0, 0, 0); \
        o[d0] = __builtin_amdgcn_mfma_f32_32x32x16_bf16(pa3, (bf16x8){l3[0], l3[1], l3[2], l3[3], h3[0], h3[1], h3[2], h3[3]}, o[d0], 0, 0, 0); } while (0)
            PV_D0(0); PV_D0(1); PV_D0(2); PV_D0(3);
#undef PV_D0
#undef TRRD
        }
        if (MODE == 0) { if (kb <= qlo + 31) wdone = __all(carry < 1e-37f) != 0; if (lane == 0) dflag[(it & 1) * 8 + wid] = wdone ? 1u : 0u; }
#if ATT_DMA
        asm volatile("s_waitcnt vmcnt(0)" ::: "memory");
#else
        if (it + 1 < NT) { AT_WRITE(cur ^ 1); if (it + 2 < NT) AT_LOAD((NT - 3 - it) * 64); }
#endif
        __syncthreads();
    }
#undef AT_DMA
    float rli[16];
    if (MODE != 0) {
        if (hi == 0) li_l[r32] = l_reg;
        asm volatile("s_waitcnt lgkmcnt(0)" ::: "memory");
#pragma unroll
        for (int g = 0; g < 4; ++g) { const f32x4 lv = *(const LAS f32x4*)(li_l + 8 * g + 4 * hi);
#pragma unroll
            for (int i = 0; i < 4; ++i) rli[4 * g + i] = 1.0f / lv[i]; }
    } else {
#pragma unroll
        for (int r = 0; r < 16; ++r) rli[r] = 1.f;
    }
    bf16_t* Ow = Og + (size_t)qlo * ldo;
#pragma unroll
    for (int r = 0; r < 16; ++r) { const int orow = crow(r, hi);
#pragma unroll
        for (int d0 = 0; d0 < 4; ++d0) { const float v = o[d0][r] * rli[r]; const float vn = __shfl_xor(v, 1);
            if ((r32 & 1) == 0) *(unsigned*)(Ow + (size_t)orow * ldo + d0 * 32 + r32) = cvtpk(v, vn); } }
}

template <int DQK, int MODE>
__device__ __forceinline__ void attn_phase(const bf16_t* Qb, int ldq, int hq, const bf16_t* Kb, int ldk, int hk, const bf16_t* Vb, int ldv, int hv, bf16_t* Ob, const float* cf, float C2, LAS unsigned char* lds) {
#ifdef TESTCOPY
    if (MODE == 0) {
        for (size_t i = (size_t)blockIdx.x * 512 + threadIdx.x; i < (size_t)NTOK * DM; i += (size_t)gridDim.x * 512) {
            const float a = __uint_as_float((unsigned)Qb[i] << 16) + __uint_as_float((unsigned)Kb[i] << 16) + __uint_as_float((unsigned)Vb[i] << 16);
            Ob[i] = (bf16_t)(__float_as_uint(sinf(300.f * a)) >> 16); }
        return;
    }
#endif
#ifdef TESTNAN
    for (int i = threadIdx.x; i < LDS_BYTES / 4; i += 512) ((LAS unsigned*)lds)[i] = 0xFFFFFFFFu;
    __syncthreads();
#endif
    for (int w = blockIdx.x; w < 256; w += gridDim.x) {
        const int xcd = w & 7, slot = w >> 3, bh = xcd * 8 + (slot >> 2), y = slot & 3, b = bh >> 4, hd = bh & 15;
        if (MODE == 1) { LAS float* cfl = (LAS float*)(lds + AT_OFF_CF);
            for (int s = threadIdx.x; s < SEQ; s += 512) cfl[s] = cf[(size_t)bh * SEQ + s] * LOG2E;
            __syncthreads(); }
        const bf16_t* Q = Qb + (size_t)b * SEQ * ldq + hd * hq; const bf16_t* K = Kb + (size_t)b * SEQ * ldk + hd * hk; const bf16_t* V = Vb + (size_t)b * SEQ * ldv + hd * hv;
        bf16_t* O = Ob + (size_t)b * SEQ * DM + hd * HD;
        attn_block<DQK, MODE>(Q, ldq, K, ldk, V, ldv, O, DM, (7 - y) * 256, C2, lds);
        attn_block<DQK, MODE>(Q, ldq, K, ldk, V, ldv, O, DM, y * 256, C2, lds);
        __syncthreads();
    }
}

#define XB_TMO      128
#define XB_XCNT(j)  (256  + 64 * (j))
#define XB_XSUB(j)  (1280 + 64 * (j))
#define XB_XGEN(j)  (2304 + 64 * (j))
#define XB_TOP      3328
#define XB_TOPGEN   3392
#define XCD_BAR_WORDS 3456
#define XB_SPIN_CAP (1u << 18)
__device__ __forceinline__ unsigned xb_ld(unsigned* p)              { return __hip_atomic_load(p, __ATOMIC_RELAXED, __HIP_MEMORY_SCOPE_AGENT); }
__device__ __forceinline__ unsigned xb_add(unsigned* p, unsigned v) { return __hip_atomic_fetch_add(p, v, __ATOMIC_RELAXED, __HIP_MEMORY_SCOPE_AGENT); }
__device__ __forceinline__ unsigned xb_xcc_id() { return (unsigned)__builtin_amdgcn_s_getreg((3 << 11) | 20) & 0xFu; }
#define XB_SPIN(cond, bar) do { unsigned _sp = 0; while (cond) { __builtin_amdgcn_s_sleep(1); \
    if ((++_sp & 255u) == 0u) { if (xb_ld(&(bar)[XB_TMO])) break; if (_sp > XB_SPIN_CAP) { atomicAdd(&(bar)[XB_TMO], 1u); break; } } } } while (0)
struct XcdBarrier { unsigned* bar; unsigned x; volatile LAS unsigned* st; };
__device__ __forceinline__ XcdBarrier xcd_barrier_post(unsigned* bar, volatile LAS unsigned* st) {
    XcdBarrier b; b.bar = bar; b.x = xb_xcc_id(); b.st = st;
    if (threadIdx.x == 0) (void)xb_add(&bar[XB_XCNT(b.x)], 1u);
    return b;
}
__device__ __forceinline__ void xcd_barrier_complete(unsigned* bar, unsigned x, unsigned& nloc, unsigned& nx) {
    const unsigned G = gridDim.x * gridDim.y * gridDim.z;
    unsigned sum, cnt, mine, sp = 0u;
    for (;;) {
        sum = 0u; cnt = 0u; mine = 0u;
#pragma unroll
        for (unsigned j = 0; j < 16; ++j) { const unsigned c = xb_ld(&bar[XB_XCNT(j)]); sum += c; cnt += (c > 0u) ? 1u : 0u; mine = (j == x) ? c : mine; }
        if (sum == G) break;
        __builtin_amdgcn_s_sleep(1);
        if ((++sp & 255u) == 0u) { if (xb_ld(&bar[XB_TMO])) break; if (sp > XB_SPIN_CAP) { atomicAdd(&bar[XB_TMO], 1u); break; } }
    }
    nloc = mine > 0u ? mine : 1u; nx = cnt > 0u ? cnt : 1u;
}
__device__ __forceinline__ void xcd_barrier(const XcdBarrier& b) {
    asm volatile("s_waitcnt vmcnt(0)" ::: "memory");
    __syncthreads();
    if (threadIdx.x == 0) {
        unsigned* bar = b.bar;
        __builtin_amdgcn_s_waitcnt(0);
        unsigned nloc = b.st[0], nx = b.st[1];
        if (nloc == 0u) { xcd_barrier_complete(bar, b.x, nloc, nx); b.st[0] = nloc; b.st[1] = nx; }
        const unsigned old = xb_add(&bar[XB_XSUB(b.x)], 1u);
        const unsigned gen = old / nloc;
        if (old + 1u == (gen + 1u) * nloc) {
            __builtin_amdgcn_fence(__ATOMIC_RELEASE, "agent");
            asm volatile("s_waitcnt vmcnt(0)" ::: "memory");
            const unsigned og = xb_add(&bar[XB_TOP], 1u);
            const unsigned tg = og / nx;
            if (og + 1u == (tg + 1u) * nx) xb_add(&bar[XB_TOPGEN], 1u);
            else XB_SPIN(xb_ld(&bar[XB_TOPGEN]) == tg, bar);
            __builtin_amdgcn_fence(__ATOMIC_ACQUIRE, "agent");
            xb_add(&bar[XB_XGEN(b.x)], 1u);
            asm volatile("s_waitcnt vmcnt(0)" ::: "memory");
        } else {
            XB_SPIN(xb_ld(&bar[XB_XGEN(b.x)]) == gen, bar);
            __builtin_amdgcn_fence(__ATOMIC_ACQUIRE, "agent");
            asm volatile("s_waitcnt vmcnt(0)" ::: "memory");
        }
    }
    __syncthreads();
}

#ifndef NLAYERS
#define NLAYERS 4
#endif
constexpr int N_PHASES = 1 + 10 * NLAYERS;
__host__ __device__ inline bool phase_active(int ph) {
    if (ph == 0) return true;
    const int layer = (ph - 1) / 10, s = (ph - 1) % 10, kind = layer % 3;
    if (s == 0 || s == 7) return false;
    if (s == 2) return kind != 0;
    if (s == 3 || s == 4) return kind == 2;
    return true;
}

__global__ void __launch_bounds__(512, 2) fwd_megakernel(Params p) {
    extern __shared__ __attribute__((aligned(16))) unsigned char shm_raw[];
    LAS unsigned char* lds = (LAS unsigned char*)shm_raw;
    unsigned char* ws = p.ws;
    bf16_t* X = (bf16_t*)(ws + WS_X);
    bf16_t* H = (bf16_t*)(ws + WS_H); bf16_t* AO = p.alt ? (bf16_t*)(ws + WS_SCR + (size_t)NTOK * DFF * 2) : (bf16_t*)(ws + WS_AO);
    float* SS = (float*)(ws + WS_SS); float* LOGF = (float*)(ws + WS_LOGF); float* CF = (float*)(ws + WS_CF); float* ROPE = (float*)(ws + WS_ROPE); float* KR = (float*)(ws + WS_KR);
    unsigned char* scr = ws + WS_SCR;
    bool first = true;
#if COOP
    volatile LAS unsigned* st = (volatile LAS unsigned*)(lds + 131072);
    if (threadIdx.x == 0) { st[0] = 0u; st[1] = 0u; }
    __syncthreads();
    const XcdBarrier xb = xcd_barrier_post((unsigned*)(ws + WS_BAR), st);
    int nsync = 0;
#endif
    for (int ph = (int)p.ph_lo; ph < (int)p.ph_hi; ++ph) {
        if (!phase_active(ph)) continue;
#if COOP
        if (!first) { if (nsync == 0) cg::this_grid().sync(); else xcd_barrier(xb); ++nsync; }
#endif
        first = false;
#define CONV_IN(L) do { const int k_ = (L) % 3, j_ = (L) / 3; const float* gm_ = p.mix_norm + (L) * DM; \
            if (k_ == 0) conv_job(lds, p.sb_w_in + (size_t)j_ * 2048 * 6144, 6144, 0, 6144, 6144, 2048, (bf16_t*)(ws + W_SB_IN + j_ * SZ_QKVW), gm_); \
            else if (k_ == 1) { conv_job(lds, p.fox_w_in, 6160, 0, 6144, 6144, 2048, (bf16_t*)(ws + W_FOX_IN), gm_); conv_job(lds, p.fox_w_in, 6160, 6144, 16, 128, 2048, (bf16_t*)(ws + W_FOX_F), gm_); } \
            else conv_job(lds, p.mla_w_in, MLA_DOWN, 0, MLA_DOWN, MLA_DOWN_PAD, 2048, (bf16_t*)(ws + W_MLA_IN), gm_); } while (0)
        if (ph == 0) { if (EN(100)) { CONV_IN(0); xprep_phase(p.x, X, SS); } continue; }
        const int layer = (ph - 1) / 10, s = (ph - 1) % 10, kind = layer % 3, j = layer / 3;
        const void* xin = (layer == 0) ? (const void*)p.x : (const void*)X;
        const int xin_f32 = layer == 0;
        const float* ss1 = SS + (size_t)(2 * layer) * NTOK * 32; const float* ss2 = SS + (size_t)(2 * layer + 1) * NTOK * 32;
        int ng = 0; GemmJob g0{}, g1{}; bool do_fgate = false;
        g0.M = NTOK; g1.M = NTOK;
        if (s == 1) {
            ng = 1; g0.A = X; g0.K = DM;
            if (kind == 2) { g0.Bt = (const bf16_t*)(ws + W_MLA_IN); g0.N = MLA_DOWN_PAD; g0.E = pg8::EpiGen{0, (bf16_t*)(scr + SC_DOWN), MLA_DOWN_PAD, 0, 0, nullptr, nullptr, 0, 0, ss1, nullptr}; }
            else { g0.Bt = (const bf16_t*)(ws + (kind == 0 ? W_SB_IN + j * SZ_QKVW : W_FOX_IN)); g0.N = 3 * DM; g0.E = pg8::EpiGen{0, (bf16_t*)(scr + SC_Q), DM, DM, (size_t)NTOK * DM, nullptr, nullptr, 0, 0, ss1, nullptr}; do_fgate = kind == 1; }
        } else if (s == 2) {
            if (kind == 1) { if (EN(2)) fox_prep_phase((bf16_t*)(scr + SC_Q), p.fox_q_gain, p.fox_k_gain, LOGF, CF); }
            else { if (EN(100)) { conv_job(lds, p.mla_w_uq, 3072, 0, 3072, 3072, 768, (bf16_t*)(ws + W_MLA_UQ)); conv_job(lds, p.mla_w_ukv, 4096, 0, 4096, 4096, 512, (bf16_t*)(ws + W_MLA_UKV)); }
                   if (EN(2)) mla_prep1_phase((const bf16_t*)(scr + SC_DOWN), p.pos, p.mla_q_norm, p.mla_kv_norm, (bf16_t*)(scr + SC_CQ), (bf16_t*)(scr + SC_CKV), ROPE, KR); }
        } else if (s == 3) {
            ng = 2;
            g0.A = (const bf16_t*)(scr + SC_CQ); g0.Bt = (const bf16_t*)(ws + W_MLA_UQ); g0.N = 3072; g0.K = MLA_QR; g0.E = pg8::EpiGen{0, (bf16_t*)(scr + SC_QUP), 3072, 0, 0, nullptr, nullptr, 0, 0, nullptr, nullptr};
            g1.A = (const bf16_t*)(scr + SC_CKV); g1.Bt = (const bf16_t*)(ws + W_MLA_UKV); g1.N = 4096; g1.K = MLA_KVR; g1.E = pg8::EpiGen{0, (bf16_t*)(scr + SC_KV), 4096, 0, 0, nullptr, nullptr, 0, 0, nullptr, nullptr};
        } else if (s == 4) { if (EN(4)) mla_prep2_phase((const bf16_t*)(scr + SC_QUP), (const bf16_t*)(scr + SC_KV), ROPE, KR, p.mla_q_gain, p.mla_k_gain, (bf16_t*)(scr + SC_QN), (bf16_t*)(scr + SC_KN)); }
        else if (s == 5) {
            if (kind == 0) { if (EN(50)) attn_phase<128, TESTMODE2 ? 2 : 0>((const bf16_t*)(scr + SC_Q), DM, HD, (const bf16_t*)(scr + SC_K), DM, HD, (const bf16_t*)(scr + SC_V), DM, HD, AO, nullptr, 0.08838834764831845f * LOG2E, lds); }
            else if (kind == 1) { if (EN(51)) attn_phase<128, 1>((const bf16_t*)(scr + SC_Q), DM, HD, (const bf16_t*)(scr + SC_K), DM, HD, (const bf16_t*)(scr + SC_V), DM, HD, AO, CF, 0.08838834764831845f * LOG2E, lds); }
            else { if (EN(52)) attn_phase<192, 2>((const bf16_t*)(scr + SC_QN), 3072, 192, (const bf16_t*)(scr + SC_KN), 3072, 192, (const bf16_t*)(scr + SC_KV) + 128, 4096, 256, AO, nullptr, 0.07216878364870323f * LOG2E, lds); }
            if (EN(100)) {
                if (kind == 0) conv_job(lds, p.sb_w_out + (size_t)j * 2048 * 2048, 2048, 0, 2048, 2048, 2048, (bf16_t*)(ws + W_SB_OUT + j * SZ_SQW));
                else if (kind == 1) conv_job(lds, p.fox_w_out, 2048, 0, 2048, 2048, 2048, (bf16_t*)(ws + W_FOX_OUT));
                else conv_job(lds, p.mla_w_out, 2048, 0, 2048, 2048, 2048, (bf16_t*)(ws + W_MLA_OUT));
            }
        } else if (s == 6) {
            ng = 1; g0.A = AO; g0.K = DM; g0.N = DM; g0.Bt = (const bf16_t*)(ws + (kind == 0 ? W_SB_OUT + j * SZ_SQW : (kind == 1 ? W_FOX_OUT : W_MLA_OUT)));
            g0.E = pg8::EpiGen{2, nullptr, DM, 0, 0, xin, X, xin_f32, 0, nullptr, SS + (size_t)(2 * layer + 1) * NTOK * 32};
        } else if (s == 8) {
            ng = 1; g0.A = X; g0.K = DM; g0.N = DFF; g0.Bt = (const bf16_t*)(ws + W_W1 + layer * SZ_FFW); g0.E = pg8::EpiGen{1, (bf16_t*)scr, DFF, 0, 0, nullptr, nullptr, 0, 0, ss2, nullptr};
        } else {
            const bool lastl = layer == NLAYERS - 1;
            ng = 1; g0.A = (const bf16_t*)scr; g0.K = DFF; g0.N = DM; g0.Bt = (const bf16_t*)(ws + W_W2 + layer * SZ_FFW);
            g0.E = pg8::EpiGen{2, nullptr, DM, 0, 0, X, lastl ? (void*)p.out : (void*)X, 0, lastl ? 1 : 0, nullptr, lastl ? nullptr : SS + (size_t)(2 * layer + 2) * NTOK * 32};
        }
        if (EN(1)) {
#pragma nounroll
            for (int gi = 0; gi < ng; ++gi) run_gemm(lds, gi ? g1 : g0);
        }
        if (s == 8 && EN(100)) conv_job(lds, p.mlp_w2 + (size_t)layer * 8192 * 2048, 2048, 0, 2048, 2048, 8192, (bf16_t*)(ws + W_W2 + layer * SZ_FFW));
        if (s == 6 && EN(100)) conv_job(lds, p.mlp_w1 + (size_t)layer * 2048 * 8192, 8192, 0, 8192, 8192, 2048, (bf16_t*)(ws + W_W1 + layer * SZ_FFW), p.mlp_norm + layer * DM);
        if (s == 9 && layer + 1 < NLAYERS && EN(100)) CONV_IN(layer + 1);
        if (do_fgate && EN(2)) fgate_phase(X, (const bf16_t*)(ws + W_FOX_F), p.fox_b_f, ss1, LOGF);
    }
}

__global__ void k_cmp(const unsigned* a, const unsigned* b, size_t n, unsigned* cnt) {
    unsigned c = 0;
    for (size_t i = (size_t)blockIdx.x * blockDim.x + threadIdx.x; i < n; i += (size_t)gridDim.x * blockDim.x) c += (a[i] != b[i]) ? 1u : 0u;
    if (c) atomicAdd(cnt, c);
}
__global__ void k_out(float* out, size_t n, const unsigned* cnt) {
    for (size_t i = (size_t)blockIdx.x * blockDim.x + threadIdx.x; i < n; i += (size_t)gridDim.x * blockDim.x) out[i] = 0.f;
    if (blockIdx.x == 0 && threadIdx.x == 0) out[0] = cnt[0] ? 3.0e5f : 1.0e5f;
}
extern "C" void kernel_launch(void* const* d_in, const int* in_sizes, int n_in, void* d_out, int out_size, void* d_ws, size_t ws_size, hipStream_t stream) {
    static int grid = 0;
    if (grid == 0) {
        if (n_in != 21 || out_size != NTOK * DM || ws_size < WS_END) { fprintf(stderr, "kernel_launch: unexpected shapes (n_in %d out %d ws %zu need %zu)\n", n_in, out_size, ws_size, (size_t)WS_END); grid = -1; return; }
        int dev = 0, cus = 0, per_cu = 0;
        hipGetDevice(&dev); hipDeviceGetAttribute(&cus, hipDeviceAttributeMultiprocessorCount, dev);
        if (hipFuncSetAttribute((const void*)fwd_megakernel, hipFuncAttributeMaxDynamicSharedMemorySize, LDS_BYTES) != hipSuccess) { fprintf(stderr, "kernel_launch: hipFuncSetAttribute failed\n"); grid = -1; return; }
        if (hipOccupancyMaxActiveBlocksPerMultiprocessor(&per_cu, (const void*)fwd_megakernel, 512, LDS_BYTES) != hipSuccess || per_cu < 1) { fprintf(stderr, "kernel_launch: occupancy query says %d\n", per_cu); per_cu = 1; }
        (void)hipGetLastError();
        grid = cus * 1;
        if (grid > 256) grid = 256;
    }
    if (grid < 0) return;
    Params p{};
    p.x = (const float*)d_in[0]; p.pos = (const int*)d_in[1]; p.mix_norm = (const float*)d_in[2]; p.mlp_norm = (const float*)d_in[3];
    p.sb_w_in = (const float*)d_in[4]; p.sb_w_out = (const float*)d_in[5]; p.fox_w_in = (const float*)d_in[6]; p.fox_b_f = (const float*)d_in[7];
    p.fox_q_gain = (const float*)d_in[8]; p.fox_k_gain = (const float*)d_in[9]; p.fox_w_out = (const float*)d_in[10];
    p.mla_w_in = (const float*)d_in[11]; p.mla_q_norm = (const float*)d_in[12]; p.mla_kv_norm = (const float*)d_in[13]; p.mla_w_uq = (const float*)d_in[14]; p.mla_w_ukv = (const float*)d_in[15];
    p.mla_q_gain = (const float*)d_in[16]; p.mla_k_gain = (const float*)d_in[17]; p.mla_w_out = (const float*)d_in[18]; p.mlp_w1 = (const float*)d_in[19]; p.mlp_w2 = (const float*)d_in[20];
    p.out = (float*)d_out; p.ws = (unsigned char*)d_ws;
#if COOP
    hipMemsetAsync((char*)d_ws + WS_BAR, 0, 16384, stream);
    p.ph_lo = 0; p.ph_hi = N_PHASES;
    void* args[] = {&p};
    hipError_t e = hipLaunchCooperativeKernel((const void*)fwd_megakernel, dim3(grid), dim3(512), args, LDS_BYTES, stream);
    if (e != hipSuccess) fprintf(stderr, "cooperative launch failed: %s (grid %d)\n", hipGetErrorString(e), grid);
#else
    for (int ph = 0; ph < N_PHASES; ++ph) {
        if (!phase_active(ph)) continue;
        p.ph_lo = ph; p.ph_hi = ph + 1;
        hipLaunchKernelGGL(fwd_megakernel, dim3(grid), dim3(512), LDS_BYTES, stream, p);
#ifdef TESTDUP
        if (ph == 6) { p.alt = 1; hipLaunchKernelGGL(fwd_megakernel, dim3(grid), dim3(512), LDS_BYTES, stream, p); p.alt = 0; }
#endif
    }
#ifdef TESTDUP
    unsigned* cnt = (unsigned*)((char*)d_ws + WS_LOGF);
    hipMemsetAsync(cnt, 0, 4, stream);
    hipLaunchKernelGGL(k_cmp, dim3(1024), dim3(256), 0, stream, (const unsigned*)((char*)d_ws + WS_AO), (const unsigned*)((char*)d_ws + WS_SCR + (size_t)NTOK * DFF * 2), (size_t)NTOK * DM / 2, cnt);
    hipLaunchKernelGGL(k_out, dim3(1024), dim3(256), 0, stream, (float*)d_out, (size_t)NTOK * DM, (const unsigned*)cnt);
#endif
#endif
}
```
